# Optimizing an MI355X kernel written in HIP

```python
import jax
import jax.numpy as jnp
from jax import lax
import numpy as np

D_MODEL = 1024
BATCH = 8
SEQ = 8192
DEPTH = 2

GRID_W = 64
CTX_LEN = 256
HEAD_DIM = 64
N_HEADS = D_MODEL // HEAD_DIM
N_KV_HEADS = N_HEADS // 4
Q_PER_KV = N_HEADS // N_KV_HEADS
D_ATTN = N_HEADS * HEAD_DIM
D_KV = N_KV_HEADS * HEAD_DIM
WINDOW = 128
QBLK = 128
ROPE_BASE = 10000.0
ROPE_AXIS_DIM = HEAD_DIM // 2
D_RNN = D_MODEL
RG_BLOCKS = 16
RG_BW = D_RNN // RG_BLOCKS
CONV_W = 4
CONV_LEFT = 2
RG_C = 8.0
D_FOUR = D_MODEL
F_GROUPS = 4
F_GW = D_FOUR // F_GROUPS
N_BRANCH = 3
Q_OFF = 0
K_OFF = Q_OFF + D_ATTN
V_OFF = K_OFF + D_KV
XR_OFF = V_OFF + D_KV
GR_OFF = XR_OFF + D_RNN
XF_OFF = GR_OFF + D_RNN
IN_COLS = XF_OFF + D_FOUR
N_EXPERTS = 32
TOP_K = 4
D_EXPERT = D_MODEL
SWIGLU_LIMIT = 7.0
SWIGLU_ALPHA = 1.702
MOE_BLK = 128
N_MOD = 6
LN_EPS = 1e-5
DEEPNORM_ALPHA = (2 * DEPTH) ** 0.25
DEEPNORM_BETA = (8 * DEPTH) ** -0.25
NEG_INF = -1e30

kernel_name = 'hybrid_fourier_rglru_swa_moe_dit_block'


def layer_norm(x, g, b):
    xf = x.astype(jnp.float32)
    xc = xf - jnp.mean(xf, axis=-1, keepdims=True)
    var = jnp.mean(xc * xc, axis=-1, keepdims=True)
    y = xc * lax.rsqrt(var + LN_EPS) * g.astype(jnp.float32) + b.astype(jnp.float32)
    return y.astype(x.dtype)


def adaln(cond, w_mod, b_mod):
    m = jax.nn.silu(cond) @ w_mod + b_mod
    m = m.reshape(m.shape[:-1] + (N_MOD, D_MODEL))
    return tuple(jnp.expand_dims(m[..., i, :], -2) for i in range(N_MOD))


def modulate(x, shift, scale):
    return x * (1 + scale) + shift


def axial_rope_tables(rows):
    row = jnp.repeat(jnp.arange(rows, dtype=jnp.float32), GRID_W)
    col = jnp.tile(jnp.arange(GRID_W, dtype=jnp.float32), rows)
    n_freq = ROPE_AXIS_DIM // 2
    freqs = ROPE_BASE ** (-jnp.arange(n_freq, dtype=jnp.float32) / n_freq)
    ang_r = (row[:, None] * freqs)[:, None, :]
    ang_c = (col[:, None] * freqs)[:, None, :]
    return (jnp.cos(ang_r), jnp.sin(ang_r), jnp.cos(ang_c), jnp.sin(ang_c))


def rope_rotate(x, cos, sin):
    x1, x2 = jnp.split(x, 2, axis=-1)
    cos = cos.astype(x.dtype)
    sin = sin.astype(x.dtype)
    return jnp.concatenate([x1 * cos - x2 * sin, x2 * cos + x1 * sin], axis=-1)


def apply_axial_rope(x, rope):
    cos_r, sin_r, cos_c, sin_c = rope
    x_row, x_col = jnp.split(x, 2, axis=-1)
    return jnp.concatenate([rope_rotate(x_row, cos_r, sin_r), rope_rotate(x_col, cos_c, sin_c)], axis=-1)


def window_attention(q, k, v, kc, vc, sink):
    bsz, seq_len = q.shape[:2]
    nb = seq_len // QBLK
    span = QBLK + 2 * WINDOW
    scale = HEAD_DIM ** -0.5
    qb = (q * scale).reshape(bsz, nb, QBLK, N_KV_HEADS, Q_PER_KV, HEAD_DIM).swapaxes(0, 1)
    pad = ((0, 0), (WINDOW, WINDOW), (0, 0), (0, 0))
    kp = jnp.pad(k, pad)
    vp = jnp.pad(v, pad)
    sink_logit = sink.astype(jnp.float32).reshape(1, N_KV_HEADS, Q_PER_KV, 1, 1)

    def block(args):
        n, qn = args
        kn = lax.dynamic_slice_in_dim(kp, n * QBLK, span, axis=1)
        vn = lax.dynamic_slice_in_dim(vp, n * QBLK, span, axis=1)
        qpos = n * QBLK + jnp.arange(QBLK)
        kpos = n * QBLK - WINDOW + jnp.arange(span)
        valid = (jnp.abs(qpos[:, None] - kpos[None, :]) <= WINDOW) & (kpos >= 0)[None, :] & (kpos < seq_len)[None, :]
        s_loc = jnp.einsum('bqgrd,bkgd->bgrqk', qn, kn).astype(jnp.float32)
        s_loc = jnp.where(valid, s_loc, NEG_INF)
        s_ctx = jnp.einsum('bqgrd,bkgd->bgrqk', qn, kc).astype(jnp.float32)
        s_sink = jnp.broadcast_to(sink_logit, s_loc.shape[:-1] + (1,))
        prob = jax.nn.softmax(jnp.concatenate([s_loc, s_ctx, s_sink], axis=-1), axis=-1)
        p_loc = prob[..., :span].astype(v.dtype)
        p_ctx = prob[..., span:-1].astype(v.dtype)
        return jnp.einsum('bgrqk,bkgd->bqgrd', p_loc, vn) + jnp.einsum('bgrqk,bkgd->bqgrd', p_ctx, vc)

    out = lax.map(block, (jnp.arange(nb), qb))
    return out.swapaxes(0, 1).reshape(bsz, seq_len, D_ATTN)


def context_attention(qc, kc, vc, sink):
    bsz, ctx_len = qc.shape[:2]
    qg = (qc * HEAD_DIM ** -0.5).reshape(bsz, ctx_len, N_KV_HEADS, Q_PER_KV, HEAD_DIM)
    s = jnp.einsum('bqgrd,bkgd->bgrqk', qg, kc).astype(jnp.float32)
    s_sink = jnp.broadcast_to(sink.astype(jnp.float32).reshape(1, N_KV_HEADS, Q_PER_KV, 1, 1), s.shape[:-1] + (1,))
    prob = jax.nn.softmax(jnp.concatenate([s, s_sink], axis=-1), axis=-1)[..., :-1].astype(vc.dtype)
    return jnp.einsum('bgrqk,bkgd->bqgrd', prob, vc).reshape(bsz, ctx_len, D_ATTN)


def short_conv(x, w, b):
    seq_len = x.shape[1]
    xp = jnp.pad(x, ((0, 0), (CONV_LEFT, CONV_W - 1 - CONV_LEFT), (0, 0)))
    y = b
    for tap in range(CONV_W):
        y = y + xp[:, tap:tap + seq_len] * w[tap]
    return y


def rglru_coeffs(x, w_a, b_a, w_i, b_i, lam):
    bsz, seq_len, _ = x.shape
    xb = x.reshape(bsz, seq_len, RG_BLOCKS, RG_BW)
    r = jax.nn.sigmoid((jnp.einsum('blhi,hij->blhj', xb, w_a).reshape(bsz, seq_len, D_RNN) + b_a).astype(jnp.float32))
    ig = jax.nn.sigmoid((jnp.einsum('blhi,hij->blhj', xb, w_i).reshape(bsz, seq_len, D_RNN) + b_i).astype(jnp.float32))
    log_a = -RG_C * r * jax.nn.softplus(-lam.astype(jnp.float32))
    a = jnp.exp(log_a)
    b = jnp.sqrt(-jnp.expm1(2 * log_a)) * (ig * x.astype(jnp.float32))
    return a, b


def linear_scan(a, b, h0, reverse):
    first = -1 if reverse else 0
    b = b.at[:, first].add(a[:, first] * h0)

    def combine(lhs, rhs):
        a_l, b_l = lhs
        a_r, b_r = rhs
        return a_l * a_r, a_r * b_l + b_r

    _, h = lax.associative_scan(combine, (a, b), reverse=reverse, axis=1)
    return h


def rglru_bidir(x_lat, x_ctx, conv_w, conv_b, w_a, b_a, w_i, b_i, lam):
    xl = short_conv(x_lat, conv_w, conv_b)
    xc = short_conv(x_ctx, conv_w, conv_b)
    h_lat = jnp.zeros(xl.shape, jnp.float32)
    h_ctx = jnp.zeros(xc.shape, jnp.float32)
    for d, rev in ((0, False), (1, True)):
        a_c, b_c = rglru_coeffs(xc, w_a[d], b_a[d], w_i[d], b_i[d], lam[d])
        hc = linear_scan(a_c, b_c, jnp.zeros(b_c[:, 0].shape, jnp.float32), rev)
        h_end = hc[:, 0] if rev else hc[:, -1]
        a_l, b_l = rglru_coeffs(xl, w_a[d], b_a[d], w_i[d], b_i[d], lam[d])
        h_lat = h_lat + linear_scan(a_l, b_l, h_end, rev)
        h_ctx = h_ctx + hc
    return h_lat, h_ctx


def fourier_mix(xf):
    bsz, seq_len, _ = xf.shape
    xg = xf.astype(jnp.float32).reshape(bsz, seq_len, F_GROUPS, F_GW)
    y = jnp.fft.fft2(xg, axes=(1, 3), norm='ortho').real
    return y.reshape(bsz, seq_len, D_FOUR).astype(xf.dtype)


def branch_merge(u, y_attn, y_rg, y_four, w_merge, b_merge):
    g = jax.nn.sigmoid(u @ w_merge + b_merge).reshape(u.shape[:-1] + (N_BRANCH, D_MODEL))
    return g[..., 0, :] * y_attn + g[..., 1, :] * y_rg + g[..., 2, :] * y_four


def clamped_swiglu(h):
    x_glu, x_lin = jnp.split(h, 2, axis=-1)
    x_glu = jnp.minimum(x_glu, SWIGLU_LIMIT)
    x_lin = jnp.clip(x_lin, -SWIGLU_LIMIT, SWIGLU_LIMIT)
    return x_glu * jax.nn.sigmoid(SWIGLU_ALPHA * x_glu) * (x_lin + 1)


def moe_ffn(u, w_router, b_router, w_gu, b_gu, w_dn, b_dn):
    lead = u.shape[:-1]
    xt = u.reshape(-1, D_MODEL)
    n_tok = xt.shape[0]
    logits = (xt @ w_router + b_router).astype(jnp.float32)
    top_logit, top_e = lax.top_k(logits, TOP_K)
    gate = jax.nn.softmax(top_logit, axis=-1)
    n_asg = n_tok * TOP_K
    e_flat = top_e.reshape(n_asg)
    tok_flat = jnp.repeat(jnp.arange(n_tok, dtype=jnp.int32), TOP_K)
    g_flat = gate.reshape(n_asg)
    order = jnp.argsort(e_flat)
    e_s, tok_s, g_s = e_flat[order], tok_flat[order], g_flat[order]
    counts = jnp.bincount(e_flat, length=N_EXPERTS)
    padded = (counts + MOE_BLK - 1) // MOE_BLK * MOE_BLK
    start = jnp.cumsum(counts) - counts
    pend = jnp.cumsum(padded)
    pstart = pend - padded
    dest = pstart[e_s] + jnp.arange(n_asg, dtype=jnp.int32) - start[e_s]
    n_blocks = -(-n_asg // MOE_BLK) + N_EXPERTS
    n_slots = n_blocks * MOE_BLK
    slot_tok = jnp.full((n_slots,), n_tok, jnp.int32).at[dest].set(tok_s)
    slot_gate = jnp.zeros((n_slots,), jnp.float32).at[dest].set(g_s)
    block_e = jnp.minimum(jnp.searchsorted(pend, jnp.arange(n_blocks) * MOE_BLK, side='right'), N_EXPERTS - 1)
    x_pad = jnp.concatenate([xt, jnp.zeros((1, D_MODEL), xt.dtype)], axis=0)

    def expert_block(args):
        tok, e = args
        h = x_pad[tok] @ w_gu[e] + b_gu[e]
        return clamped_swiglu(h) @ w_dn[e] + b_dn[e]

    ys = lax.map(expert_block, (slot_tok.reshape(n_blocks, MOE_BLK), block_e))
    ys = ys.reshape(n_slots, D_MODEL).astype(jnp.float32) * slot_gate[:, None]
    out = jax.ops.segment_sum(ys, slot_tok, num_segments=n_tok + 1)[:n_tok]
    return out.astype(u.dtype).reshape(lead + (D_MODEL,))


def mixer_sublayer(u, u_c, rope, p, last):
    bsz, seq_len, _ = u.shape
    ctx_len = u_c.shape[1]
    w_in = p['w_in']
    z = u @ w_in
    q = apply_axial_rope(z[..., Q_OFF:K_OFF].reshape(bsz, seq_len, N_HEADS, HEAD_DIM), rope)
    k = apply_axial_rope(z[..., K_OFF:V_OFF].reshape(bsz, seq_len, N_KV_HEADS, HEAD_DIM), rope)
    v = z[..., V_OFF:XR_OFF].reshape(bsz, seq_len, N_KV_HEADS, HEAD_DIM)
    xr = z[..., XR_OFF:GR_OFF]
    gr = z[..., GR_OFF:XF_OFF]
    xf = z[..., XF_OFF:IN_COLS]
    kc = (u_c @ w_in[:, K_OFF:V_OFF]).reshape(bsz, ctx_len, N_KV_HEADS, HEAD_DIM)
    vc = (u_c @ w_in[:, V_OFF:XR_OFF]).reshape(bsz, ctx_len, N_KV_HEADS, HEAD_DIM)
    xrc = u_c @ w_in[:, XR_OFF:GR_OFF]
    h_lat, h_ctx = rglru_bidir(xr, xrc, p['conv_w'], p['conv_b'], p['rg_w_a'], p['rg_b_a'], p['rg_w_i'], p['rg_b_i'], p['rg_lambda'])
    y_attn = window_attention(q, k, v, kc, vc, p['attn_sink']) @ p['w_o_attn']
    y_rg = (jax.nn.gelu(gr) * h_lat.astype(gr.dtype)) @ p['w_o_rg']
    y_four = fourier_mix(xf) @ p['w_o_four']
    y = branch_merge(u, y_attn, y_rg, y_four, p['w_merge'], p['b_merge']) @ p['w_out']
    if last:
        return y, None
    qc = (u_c @ w_in[:, Q_OFF:K_OFF]).reshape(bsz, ctx_len, N_HEADS, HEAD_DIM)
    grc = u_c @ w_in[:, GR_OFF:XF_OFF]
    xfc = u_c @ w_in[:, XF_OFF:IN_COLS]
    yc_attn = context_attention(qc, kc, vc, p['attn_sink']) @ p['w_o_attn']
    yc_rg = (jax.nn.gelu(grc) * h_ctx.astype(grc.dtype)) @ p['w_o_rg']
    yc_four = fourier_mix(xfc) @ p['w_o_four']
    y_c = branch_merge(u_c, yc_attn, yc_rg, yc_four, p['w_merge'], p['b_merge']) @ p['w_out']
    return y, y_c


def trunk_layer(x, ctx, c, c_ctx, rope, p, last):
    sh1, sc1, g1, sh2, sc2, g2 = adaln(c, p['w_mod'], p['b_mod'])
    sh1c, sc1c, g1c, sh2c, sc2c, g2c = adaln(c_ctx, p['w_mod'], p['b_mod'])
    y, y_c = mixer_sublayer(modulate(x, sh1, sc1), modulate(ctx, sh1c, sc1c), rope, p, last)
    x = layer_norm(DEEPNORM_ALPHA * x + g1 * y, p['ln1_g'], p['ln1_b'])
    f = moe_ffn(modulate(x, sh2, sc2), p['w_router'], p['b_router'], p['w_gate_up'], p['b_gate_up'], p['w_down'], p['b_down'])
    x = layer_norm(DEEPNORM_ALPHA * x + g2 * f, p['ln2_g'], p['ln2_b'])
    if last:
        return x, None
    ctx = layer_norm(DEEPNORM_ALPHA * ctx + g1c * y_c, p['ln1_g'], p['ln1_b'])
    f_c = moe_ffn(modulate(ctx, sh2c, sc2c), p['w_router'], p['b_router'], p['w_gate_up'], p['b_gate_up'], p['w_down'], p['b_down'])
    ctx = layer_norm(DEEPNORM_ALPHA * ctx + g2c * f_c, p['ln2_g'], p['ln2_b'])
    return x, ctx


def setup_inputs(seed: int = 0) -> dict:
    key = jax.random.key(seed)
    keys = jax.random.split(key, 32)

    def nrm(i, shape, scale):
        return jax.random.normal(keys[i], shape, jnp.float32) * scale

    a_pow_c = jax.random.uniform(keys[15], (DEPTH, 2, D_RNN), jnp.float32, minval=0.9, maxval=0.999)
    a0 = a_pow_c ** (1.0 / RG_C)
    rg_lambda = jnp.log(a0) - jnp.log1p(-a0)
    return {
        'x': nrm(0, (BATCH, SEQ, D_MODEL), 1.0),
        'c': nrm(1, (BATCH, D_MODEL), 1.0),
        'ctx': nrm(2, (BATCH, CTX_LEN, D_MODEL), 1.0),
        'c_ctx': nrm(3, (D_MODEL,), 1.0),
        'w_mod': nrm(4, (DEPTH, D_MODEL, N_MOD * D_MODEL), 0.5 * D_MODEL ** -0.5),
        'b_mod': nrm(5, (DEPTH, N_MOD * D_MODEL), 0.02),
        'w_in': nrm(6, (DEPTH, D_MODEL, IN_COLS), D_MODEL ** -0.5),
        'attn_sink': nrm(7, (DEPTH, N_HEADS), 0.5),
        'w_o_attn': nrm(8, (DEPTH, D_ATTN, D_MODEL), D_ATTN ** -0.5),
        'conv_w': nrm(9, (DEPTH, CONV_W, D_RNN), CONV_W ** -0.5),
        'conv_b': nrm(10, (DEPTH, D_RNN), 0.02),
        'rg_w_a': nrm(11, (DEPTH, 2, RG_BLOCKS, RG_BW, RG_BW), RG_BW ** -0.5),
        'rg_b_a': nrm(12, (DEPTH, 2, D_RNN), 0.02),
        'rg_w_i': nrm(13, (DEPTH, 2, RG_BLOCKS, RG_BW, RG_BW), RG_BW ** -0.5),
        'rg_b_i': nrm(14, (DEPTH, 2, D_RNN), 0.02),
        'rg_lambda': rg_lambda,
        'w_o_rg': nrm(16, (DEPTH, D_RNN, D_MODEL), D_RNN ** -0.5),
        'w_o_four': nrm(17, (DEPTH, D_FOUR, D_MODEL), D_FOUR ** -0.5),
        'w_merge': nrm(18, (DEPTH, D_MODEL, N_BRANCH * D_MODEL), D_MODEL ** -0.5),
        'b_merge': nrm(19, (DEPTH, N_BRANCH * D_MODEL), 0.02),
        'w_out': nrm(20, (DEPTH, D_MODEL, D_MODEL), DEEPNORM_BETA * D_MODEL ** -0.5),
        'ln1_g': 1.0 + nrm(21, (DEPTH, D_MODEL), 0.02),
        'ln1_b': nrm(22, (DEPTH, D_MODEL), 0.02),
        'w_router': nrm(23, (DEPTH, D_MODEL, N_EXPERTS), D_MODEL ** -0.5),
        'b_router': nrm(24, (DEPTH, N_EXPERTS), 0.01),
        'w_gate_up': nrm(25, (DEPTH, N_EXPERTS, D_MODEL, 2 * D_EXPERT), D_MODEL ** -0.5),
        'b_gate_up': nrm(26, (DEPTH, N_EXPERTS, 2 * D_EXPERT), 0.02),
        'w_down': nrm(27, (DEPTH, N_EXPERTS, D_EXPERT, D_MODEL), DEEPNORM_BETA * D_EXPERT ** -0.5),
        'b_down': nrm(28, (DEPTH, N_EXPERTS, D_MODEL), 0.02),
        'ln2_g': 1.0 + nrm(29, (DEPTH, D_MODEL), 0.02),
        'ln2_b': nrm(30, (DEPTH, D_MODEL), 0.02),
    }


def reference(x, c, ctx, c_ctx, w_mod, b_mod, w_in, attn_sink, w_o_attn, conv_w, conv_b, rg_w_a, rg_b_a, rg_w_i, rg_b_i, rg_lambda, w_o_rg, w_o_four, w_merge, b_merge, w_out, ln1_g, ln1_b, w_router, b_router, w_gate_up, b_gate_up, w_down, b_down, ln2_g, ln2_b):
    ROWS = x.shape[1] // GRID_W
    rope = axial_rope_tables(ROWS)
    for l in range(DEPTH):
        p = dict(w_mod=w_mod[l], b_mod=b_mod[l], w_in=w_in[l], attn_sink=attn_sink[l], w_o_attn=w_o_attn[l],
                 conv_w=conv_w[l], conv_b=conv_b[l], rg_w_a=rg_w_a[l], rg_b_a=rg_b_a[l], rg_w_i=rg_w_i[l],
                 rg_b_i=rg_b_i[l], rg_lambda=rg_lambda[l], w_o_rg=w_o_rg[l], w_o_four=w_o_four[l],
                 w_merge=w_merge[l], b_merge=b_merge[l], w_out=w_out[l], ln1_g=ln1_g[l], ln1_b=ln1_b[l],
                 w_router=w_router[l], b_router=b_router[l], w_gate_up=w_gate_up[l], b_gate_up=b_gate_up[l],
                 w_down=w_down[l], b_down=b_down[l], ln2_g=ln2_g[l], ln2_b=ln2_b[l])
        x, ctx = trunk_layer(x, ctx, c, c_ctx, rope, p, l == DEPTH - 1)
    return x
```

```cpp
#include <hip/hip_runtime.h>
#include <cstdio>
#include <cstdint>

#ifndef MK_SINGLE
#define MK_SINGLE 1
#endif

#define GAS __attribute__((address_space(1)))
#define LAS __attribute__((address_space(3)))
typedef unsigned short bf16;
typedef short bf16x8 __attribute__((ext_vector_type(8)));
typedef short s16x4 __attribute__((ext_vector_type(4)));
typedef float f32x2 __attribute__((ext_vector_type(2)));
typedef float f32x4 __attribute__((ext_vector_type(4)));
typedef float f32x16 __attribute__((ext_vector_type(16)));
typedef unsigned u32x2 __attribute__((ext_vector_type(2)));
typedef unsigned u32x4 __attribute__((ext_vector_type(4)));
typedef LAS unsigned char* ldsp;

constexpr int NB = 8, SEQ = 8192, D = 1024, CTXL = 256, DEPTH = 2;
constexpr int NLAT = NB * SEQ, NCTX = NB * CTXL, NROW = NLAT + NCTX;
constexpr int IN_COLS = 4608;
constexpr int ZC = 5632, ZQ = 0, ZK = 1024, ZV = 1280, ZGR = 1536, ZXR = 2560, ZXC = 3584, ZXS = 4608;
constexpr int NEXP = 32, TOPK = 4, DFF = 1024;
constexpr int NSLOT = 278528;
constexpr int NCHUNK = (SEQ + CTXL) / 64;
constexpr float LN_EPS = 1e-5f, DN_ALPHA = 1.41421356237309515f;
constexpr float ATT_C2 = 0.125f * 1.4426950408889634f;
constexpr int NWAVES = 8, NTHR = 512;

constexpr size_t MiB = 1u << 20;
constexpr size_t WS_CTL = 0, CTL_ZERO_BYTES = 1 * MiB;
constexpr size_t WS_MODS = 1 * MiB;
constexpr size_t WS_ROPE = WS_MODS + 512 * 1024;
constexpr size_t WS_TW   = WS_ROPE + 16 * 1024;
constexpr size_t WS_SP   = WS_TW + 64 * 1024;
constexpr size_t WS_FC   = WS_SP + 16 * 1024;
constexpr size_t WS_F1   = WS_FC + 256 * 1024;
constexpr size_t WS_F2   = WS_F1 + 128 * 1024;
constexpr size_t WS_F256 = WS_F2 + 16 * 1024;
constexpr size_t WS_WGC  = WS_F256 + 256 * 1024;
constexpr size_t WS_ASGE = 3 * MiB;
constexpr size_t WS_ASGP = WS_ASGE + 2 * MiB;
constexpr size_t WS_ASGG = WS_ASGP + 2 * MiB;
constexpr size_t WS_ASGS = WS_ASGG + 2 * MiB;
constexpr size_t WS_SUM  = 12 * MiB;
constexpr size_t WS_X2C  = 30 * MiB;
constexpr size_t WS_WSM  = 41 * MiB;
constexpr size_t WSM_LAYER = 32 * MiB;
constexpr size_t WSM_WIN = 0;
constexpr size_t WSM_WXF = 11 * MiB;
constexpr size_t WSM_WOA = 13 * MiB, WSM_WOR = 15 * MiB, WSM_WOF = 17 * MiB, WSM_WOUT = 19 * MiB;
constexpr size_t WSM_WM  = 21 * MiB;
constexpr size_t WSM_WRH = 27 * MiB, WSM_WRL = WSM_WRH + 64 * 1024;
constexpr size_t WSM_WG  = 28 * MiB;
constexpr size_t WS_WGU  = 105 * MiB;
constexpr size_t WS_WDN  = 233 * MiB;
constexpr size_t WS_U    = 297 * MiB;
constexpr size_t WS_T    = 429 * MiB;
constexpr size_t WS_Z    = 693 * MiB;
constexpr size_t WS_Y    = 1419 * MiB;
constexpr size_t WS_M    = WS_Y + 396 * MiB;
constexpr size_t WS_END  = 1963 * MiB;
static_assert((size_t)NROW * ZC * 2 <= 726 * MiB && (size_t)NSLOT * 1024 * 2 <= 544 * MiB && (size_t)NROW * 3072 * 2 <= 396 * MiB && (size_t)NROW * 2048 * 2 <= 264 * MiB, "ws map");
constexpr int CW_TMO = 0, CW_BAR = 4096;

constexpr int RING_BYTES = 131072;
constexpr int LM_XB = RING_BYTES;
constexpr int LM_CNT = RING_BYTES + 64;
constexpr int LM_PST = LM_CNT + 128;
constexpr int LM_MYB = LM_PST + 144;
constexpr int LM_NT  = LM_MYB + 128;
constexpr int LM_TE  = LM_NT + 16;
constexpr int LDS_BYTES = 147456;

#define LDS_WAIT() asm volatile("s_waitcnt lgkmcnt(0)" ::: "memory")
#define VM_WAIT() asm volatile("s_waitcnt vmcnt(0)" ::: "memory")
__device__ __forceinline__ unsigned f2bf(float f) { unsigned u = __builtin_bit_cast(unsigned, f); return (u + 0x7fffu + ((u >> 16) & 1u)) >> 16; }
__device__ __forceinline__ float bf2f(unsigned h) { return __builtin_bit_cast(float, h << 16); }
__device__ __forceinline__ unsigned pk2(float lo, float hi) { return f2bf(lo) | (f2bf(hi) << 16); }
__device__ __forceinline__ float wave_sum(float v) {
#pragma unroll
    for (int o = 1; o < 64; o <<= 1) v += __shfl_xor(v, o);
    return v;
}
__device__ __forceinline__ float sigmoidf_(float x) { return __builtin_amdgcn_rcpf(1.0f + __expf(-x)); }
__device__ __forceinline__ float gelu_tanh(float x) { const float u = 0.7978845608028654f * (x + 0.044715f * x * x * x); return x * sigmoidf_(2.0f * u); }
__device__ __forceinline__ float silu_(float x) { return x * sigmoidf_(x); }

__device__ __forceinline__ int fresh_tid_w(int wave_sgpr) { int w = wave_sgpr; asm volatile("" : "+s"(w)); int t = w * 64 + (int)__builtin_amdgcn_mbcnt_hi(~0u, __builtin_amdgcn_mbcnt_lo(~0u, 0u)); asm volatile("" : "+v"(t)); return t; }
#define fresh_tid() fresh_tid_w(g_wave)
namespace pg8 {
#define PG8_LAS __attribute__((address_space(3)))
typedef unsigned short bf16_t;
constexpr int BM = 256, BK = 64, HALF = 128, HTB = HALF * BK * 2, STAGE_BYTES = 8 * HTB, NXCD = 8, WGM = 8;
__host__ __device__ __forceinline__ int lds_byte(int r, int c) { const int st = (r >> 4) * 2 + (c >> 5), rr = r & 15, cc = c & 31, ob = rr * 64 + cc * 2; return st * 1024 + (ob ^ (((ob >> 9) & 1) << 5)); }
__host__ __device__ __forceinline__ void stage_rc(int b, int& R, int& C) { const int st = b / 1024, sb = b % 1024, swz = sb ^ (((sb >> 9) & 1) << 5); R = (st >> 1) * 16 + swz / 64; C = (st & 1) * 32 + (swz % 64) / 2; }
__host__ __device__ __forceinline__ int perm32(int rho) { const int n = rho >> 4, i = rho & 15; return 8 * (i >> 2) + 4 * n + (i & 3); }

struct Unit { int pm, pn; };
struct Gemm { const bf16_t* A; const bf16_t* Bt; int lda, ldb, K; };

struct StaticOrder {
    int nM, nN, nwg, G, c;
    __device__ void init(int M, int N, int G_, int c_) { nM = M / BM; nN = N / BM; nwg = nM * nN; G = G_; c = c_; }
    __device__ bool next(int i, Unit& u) const {
        const long L = (long)i * G + c; if (L >= nwg) return false;
        int wgid = (int)L; { const int q = nwg / NXCD, r = nwg % NXCD, xcd = wgid % NXCD, off = wgid / NXCD; wgid = (xcd < r ? xcd * (q + 1) : r * (q + 1) + (xcd - r) * q) + off; }
        const int nig = WGM * nN, gid = wgid / nig, fm = gid * WGM, gsz = (nM - fm) < WGM ? (nM - fm) : WGM;
        u.pm = fm + ((wgid % nig) % gsz); u.pn = (wgid % nig) / gsz; return true;
    }
    __device__ __forceinline__ const char* a_ptr(const Gemm& g, const Unit& u) const { return (const char*)g.A + (size_t)u.pm * BM * g.lda * 2; }
    __device__ __forceinline__ const char* b_ptr(const Gemm& g, const Unit& u) const { return (const char*)g.Bt + (size_t)u.pn * BM * g.ldb * 2; }
};
struct MergeOrder {
    StaticOrder s;
    __device__ void init(int M, int G_, int c_) { s.init(M, 1024, G_, c_); }
    __device__ bool next(int i, Unit& u) const { const int j = i / 3, br = i - 3 * j; Unit t; if (!s.next(j, t)) return false; u.pm = t.pm; u.pn = br * 4 + t.pn; return true; }
    __device__ __forceinline__ const char* a_ptr(const Gemm& g, const Unit& u) const { return (const char*)g.A + (size_t)u.pm * BM * g.lda * 2; }
    __device__ __forceinline__ const char* b_ptr(const Gemm& g, const Unit& u) const { return (const char*)g.Bt + (size_t)u.pn * BM * g.ldb * 2; }
};
struct FoldOrder {
    int G, c;
    __device__ bool next(int i, Unit& u) const { const int L = i * G + c; if (L >= 32) return false; u.pm = L & 1; u.pn = L >> 1; return true; }
    __device__ __forceinline__ const char* a_ptr(const Gemm& g, const Unit& u) const { return (const char*)g.A + (size_t)u.pm * BM * g.lda * 2; }
    __device__ __forceinline__ const char* b_ptr(const Gemm& g, const Unit& u) const { const int grp = u.pn >> 2, dn = u.pn & 3; return (const char*)g.Bt + ((size_t)dn * BM * g.ldb + grp * 256) * 2; }
};
template <int NPN> struct MoeOrder {
    int G, c, nt; const PG8_LAS unsigned short* te;
    __device__ bool next(int i, Unit& u) const { const int L = i * G + c; if (L >= nt * NPN) return false; const int rt = L / NPN, pn = L - rt * NPN; u.pm = rt; u.pn = __builtin_amdgcn_readfirstlane((int)te[rt]) * NPN + pn; return true; }
    __device__ __forceinline__ const char* a_ptr(const Gemm& g, const Unit& u) const { return (const char*)g.A + (size_t)u.pm * BM * g.lda * 2; }
    __device__ __forceinline__ const char* b_ptr(const Gemm& g, const Unit& u) const { return (const char*)g.Bt + (size_t)u.pn * BM * g.ldb * 2; }
};

__device__ __forceinline__ unsigned cvt_pk_bf16(float lo, float hi) { unsigned r; asm volatile("v_cvt_pk_bf16_f32 %0, %1, %2" : "=v"(r) : "v"(lo), "v"(hi)); return r; }

template <class Epi, class Sched>
__device__ __forceinline__ void gemm_phase(PG8_LAS unsigned char* lds, const Gemm g, const Sched& S, const Epi& E, int g_wave) {
    const int tid = fresh_tid(), wid = __builtin_amdgcn_readfirstlane(tid >> 6), lane = tid & 63, wr = wid >> 2, wc = wid & 3, fr = lane & 15, fq = lane >> 4;
    const int K = g.K, nt = K / BK;
    unsigned voffA[2], voffB[2];
#pragma unroll
    for (int i = 0; i < 2; ++i) { int R, C; stage_rc(tid * 16 + i * 8192, R, C); const int Rb = Epi::PERM ? ((R & ~31) + perm32(R & 31)) : R;
        voffA[i] = (unsigned)(R * g.lda + C) * 2u; voffB[i] = (unsigned)(Rb * g.ldb + C) * 2u; }
    const size_t kstep = (size_t)(BK * 2);
    const size_t hstepA = (size_t)HALF * g.lda * 2, hstepB = (size_t)HALF * g.ldb * 2;
    const unsigned ldsw = (unsigned)wid * 1024u;
    const int aoff = lds_byte(wr * 64 + fr, fq * 8), boff = lds_byte(wc * 32 + fr, fq * 8);
#define PG8_SA(b, h) (((b) * 2 + (h)) * HTB)
#define PG8_SB(b, h) ((4 + (b) * 2 + (h)) * HTB)
#define PG8_STAGE(bufoff, gbase, voff) do { _Pragma("unroll") for (int _i = 0; _i < 2; ++_i) \
        __builtin_amdgcn_global_load_lds((const unsigned*)((const char*)(gbase) + (voff)[_i]), (PG8_LAS unsigned*)(lds + (bufoff) + ldsw + _i * 8192), 16, 0, 0); } while (0)
#define PG8_LDA(dst, b, h) do { _Pragma("unroll") for (int m = 0; m < 4; ++m) _Pragma("unroll") for (int k = 0; k < 2; ++k) dst[m][k] = *(const PG8_LAS bf16x8*)(lds + PG8_SA(b, h) + aoff + m * 2048 + k * 1024); } while (0)
#define PG8_LDB(dst, b, h) do { _Pragma("unroll") for (int n = 0; n < 2; ++n) _Pragma("unroll") for (int k = 0; k < 2; ++k) dst[n][k] = *(const PG8_LAS bf16x8*)(lds + PG8_SB(b, h) + boff + n * 2048 + k * 1024); } while (0)
#define PG8_MMA(ai, bj, At, Bt) do { __builtin_amdgcn_s_setprio(1); _Pragma("unroll") for (int m = 0; m < 4; ++m) _Pragma("unroll") for (int n = 0; n < 2; ++n) _Pragma("unroll") for (int k = 0; k < 2; ++k) \
        acc[ai][bj][m][n] = __builtin_amdgcn_mfma_f32_16x16x32_bf16(Bt[n][k], At[m][k], acc[ai][bj][m][n], 0, 0, 0); __builtin_amdgcn_s_setprio(0); } while (0)
#define PG8_WAIT_V(n) asm volatile("s_waitcnt vmcnt(" #n ")" ::: "memory")
#define PG8_WAIT_L(n) asm volatile("s_waitcnt lgkmcnt(" #n ")" ::: "memory")
#define PG8_BAR __builtin_amdgcn_s_barrier()
#define PG8_SCHED __builtin_amdgcn_sched_barrier(0)
    Unit cur, nxt; int ui = 0;
    if (!S.next(0, cur)) return;
    f32x4 acc[2][2][4][2];
#pragma unroll
    for (int a = 0; a < 2; ++a)
#pragma unroll
        for (int b = 0; b < 2; ++b)
#pragma unroll
            for (int m = 0; m < 4; ++m)
#pragma unroll
                for (int n = 0; n < 2; ++n) acc[a][b][m][n] = (f32x4){0.f, 0.f, 0.f, 0.f};
    bf16x8 At[4][2], B0[2][2], B1[2][2];
    const char* cA = S.a_ptr(g, cur); const char* cB = S.b_ptr(g, cur);
    PG8_STAGE(PG8_SB(0, 0), cB, voffB); PG8_STAGE(PG8_SB(0, 1), cB + hstepB, voffB); PG8_STAGE(PG8_SA(0, 0), cA, voffA); PG8_STAGE(PG8_SA(0, 1), cA + hstepA, voffA);
    if (wr == 1) PG8_BAR;
    PG8_WAIT_V(2); PG8_BAR;
    PG8_STAGE(PG8_SB(1, 0), cB + kstep, voffB); PG8_STAGE(PG8_SA(1, 0), cA + kstep, voffA); PG8_STAGE(PG8_SB(1, 1), cB + hstepB + kstep, voffB);
    PG8_WAIT_V(6); PG8_BAR;
    for (;;) {
        const bool has_next = S.next(ui + 1, nxt);
        const char* nA = has_next ? S.a_ptr(g, nxt) : cA; const char* nB = has_next ? S.b_ptr(g, nxt) : cB;
#pragma unroll 1
        for (int t = 0; t < nt; t += 2) {
            const bool last = (t == nt - 2);
            const char* a1 = cA + (size_t)(t + 1) * kstep;
            const char* a2 = last ? nA : cA + (size_t)(t + 2) * kstep; const char* b2 = last ? nB : cB + (size_t)(t + 2) * kstep;
            const char* a3 = a2 + kstep; const char* b3 = b2 + kstep;
            PG8_LDB(B0, 0, 0); PG8_LDB(B1, 0, 1); PG8_SCHED; PG8_LDA(At, 0, 0); PG8_STAGE(PG8_SA(1, 1), a1 + hstepA, voffA);
            PG8_WAIT_V(8); PG8_WAIT_L(0); PG8_BAR; PG8_MMA(0, 0, At, B0); PG8_MMA(0, 1, At, B1); PG8_BAR; PG8_SCHED;
            PG8_LDA(At, 0, 1); PG8_STAGE(PG8_SB(0, 0), b2, voffB); PG8_STAGE(PG8_SB(0, 1), b2 + hstepB, voffB); PG8_STAGE(PG8_SA(0, 0), a2, voffA);
            PG8_WAIT_V(8); PG8_WAIT_L(0); PG8_BAR; PG8_MMA(1, 0, At, B0); PG8_MMA(1, 1, At, B1); PG8_BAR; PG8_SCHED;
            PG8_LDB(B0, 1, 0); PG8_LDB(B1, 1, 1); PG8_SCHED; PG8_LDA(At, 1, 0); PG8_STAGE(PG8_SA(0, 1), a2 + hstepA, voffA);
            PG8_WAIT_V(8); PG8_WAIT_L(0); PG8_BAR; PG8_MMA(0, 0, At, B0); PG8_MMA(0, 1, At, B1); PG8_BAR; PG8_SCHED;
            PG8_LDA(At, 1, 1); PG8_STAGE(PG8_SB(1, 0), b3, voffB); PG8_STAGE(PG8_SB(1, 1), b3 + hstepB, voffB); PG8_STAGE(PG8_SA(1, 0), a3, voffA);
            PG8_WAIT_V(8); PG8_WAIT_L(0); PG8_BAR; PG8_MMA(1, 0, At, B0); PG8_MMA(1, 1, At, B1); PG8_BAR; PG8_SCHED;
        }
        if (wr == 0) PG8_BAR;
        E(acc, cur, wr, wc, fr, fq);
        if (!has_next) break;
#pragma unroll
        for (int a = 0; a < 2; ++a)
#pragma unroll
            for (int b = 0; b < 2; ++b)
#pragma unroll
                for (int m = 0; m < 4; ++m)
#pragma unroll
                    for (int n = 0; n < 2; ++n) acc[a][b][m][n] = (f32x4){0.f, 0.f, 0.f, 0.f};
        cur = nxt; cA = nA; cB = nB; ++ui;
        if (wr == 1) PG8_BAR;
    }
    PG8_WAIT_V(0);
    PG8_BAR;
#undef PG8_SA
#undef PG8_SB
#undef PG8_STAGE
#undef PG8_LDA
#undef PG8_LDB
#undef PG8_MMA
#undef PG8_WAIT_V
#undef PG8_WAIT_L
#undef PG8_BAR
#undef PG8_SCHED
}
}
namespace epi {
using pg8::Unit; using pg8::cvt_pk_bf16; constexpr int HALF = 128, BM = 256;
struct Store {
    static constexpr bool PERM = true;
    bf16* O; int ldc; const float* bias;
    int ncol_out;
    __device__ __forceinline__ void operator()(const f32x4 (&acc)[2][2][4][2], const Unit& u, int wr, int wc, int fr, int fq) const {
        const int row0 = u.pm * BM + wr * 64 + fr; const int gcol0 = u.pn * BM + wc * 32 + 8 * fq; const int col0 = gcol0 % ncol_out;
        f32x4 bv[2][2];
#pragma unroll
        for (int bj = 0; bj < 2; ++bj)
#pragma unroll
            for (int n = 0; n < 2; ++n) bv[bj][n] = bias ? *(const f32x4*)(bias + gcol0 + bj * HALF + 4 * n) : (f32x4){0.f, 0.f, 0.f, 0.f};
#pragma unroll
        for (int ai = 0; ai < 2; ++ai)
#pragma unroll
            for (int m = 0; m < 4; ++m) { bf16* rowp = O + (size_t)(row0 + ai * HALF + m * 16) * ldc + col0;
#pragma unroll
                for (int bj = 0; bj < 2; ++bj) { const f32x4 v0 = acc[ai][bj][m][0] + bv[bj][0], v1 = acc[ai][bj][m][1] + bv[bj][1];
                    u32x4 w; w.x = cvt_pk_bf16(v0[0], v0[1]); w.y = cvt_pk_bf16(v0[2], v0[3]); w.z = cvt_pk_bf16(v1[0], v1[1]); w.w = cvt_pk_bf16(v1[2], v1[3]);
                    *(u32x4*)(rowp + bj * HALF) = w; } }
    }
};
struct In {
    static constexpr bool PERM = false;
    bf16* Z; const f32x2* rope;
    __device__ __forceinline__ void operator()(const f32x4 (&acc)[2][2][4][2], const Unit& u, int wr, int wc, int fr, int fq) const {
        const int row0 = u.pm * BM + wr * 64 + fr; const int col0 = u.pn * BM + wc * 32 + 4 * fq;
        const bool isq = u.pn < 4, dorope = (u.pn <= 4) && (u.pm * BM < NLAT);
        const float sc = isq ? ATT_C2 : 1.0f;
#pragma unroll
        for (int ai = 0; ai < 2; ++ai)
#pragma unroll
            for (int m = 0; m < 4; ++m) { const int row = row0 + ai * HALF + m * 16; bf16* rowp = Z + (size_t)row * ZC + col0;
                f32x4 cs0 = {1.f, 0.f, 1.f, 0.f}, cs1 = {1.f, 0.f, 1.f, 0.f};
                if (dorope) { const int t = row & (SEQ - 1); const int pos = (wc & 1) ? (t & 63) : (t >> 6); const f32x4* rp = (const f32x4*)(rope + pos * 16 + 4 * fq); cs0 = rp[0]; cs1 = rp[1]; }
#pragma unroll
                for (int bj = 0; bj < 2; ++bj) { const f32x4 x1 = acc[ai][bj][m][0], x2 = acc[ai][bj][m][1];
                    f32x4 o1, o2;
                    o1[0] = x1[0] * cs0[0] - x2[0] * cs0[1]; o2[0] = x2[0] * cs0[0] + x1[0] * cs0[1];
                    o1[1] = x1[1] * cs0[2] - x2[1] * cs0[3]; o2[1] = x2[1] * cs0[2] + x1[1] * cs0[3];
                    o1[2] = x1[2] * cs1[0] - x2[2] * cs1[1]; o2[2] = x2[2] * cs1[0] + x1[2] * cs1[1];
                    o1[3] = x1[3] * cs1[2] - x2[3] * cs1[3]; o2[3] = x2[3] * cs1[2] + x1[3] * cs1[3];
                    o1 = o1 * sc; o2 = o2 * sc;
                    u32x2 w1, w2; w1.x = cvt_pk_bf16(o1[0], o1[1]); w1.y = cvt_pk_bf16(o1[2], o1[3]); w2.x = cvt_pk_bf16(o2[0], o2[1]); w2.y = cvt_pk_bf16(o2[2], o2[3]);
                    *(u32x2*)(rowp + bj * HALF) = w1; *(u32x2*)(rowp + bj * HALF + 16) = w2; } }
    }
};
struct Merge {
    static constexpr bool PERM = true;
    bf16* Mg; const bf16* Y; const float* bm;
    __device__ __forceinline__ void operator()(const f32x4 (&acc)[2][2][4][2], const Unit& u, int wr, int wc, int fr, int fq) const {
        const int br = u.pn >> 2, pn = u.pn & 3;
        const int row0 = u.pm * BM + wr * 64 + fr; const int col0 = pn * BM + wc * 32 + 8 * fq;
        f32x4 bv[2][2];
#pragma unroll
        for (int bj = 0; bj < 2; ++bj)
#pragma unroll
            for (int n = 0; n < 2; ++n) bv[bj][n] = *(const f32x4*)(bm + br * 1024 + col0 + bj * HALF + 4 * n);
#pragma unroll
        for (int ai = 0; ai < 2; ++ai)
#pragma unroll
            for (int m = 0; m < 4; ++m) { const size_t row = (size_t)(row0 + ai * HALF + m * 16);
#pragma unroll
                for (int bj = 0; bj < 2; ++bj) { const int col = col0 + bj * HALF;
                    const u32x4 yv = *(const u32x4*)(Y + row * 3072 + br * 1024 + col);
                    u32x4 mv = {0u, 0u, 0u, 0u}; if (br) mv = *(const u32x4*)(Mg + row * 1024 + col);
                    float o[8];
#pragma unroll
                    for (int e = 0; e < 8; ++e) { const float a = acc[ai][bj][m][e >> 2][e & 3] + bv[bj][e >> 2][e & 3];
                        const unsigned yw = yv[e >> 1], mw = mv[e >> 1];
                        const float y = (e & 1) ? bf2f(yw >> 16) : bf2f(yw & 0xffffu), mm = (e & 1) ? bf2f(mw >> 16) : bf2f(mw & 0xffffu);
                        o[e] = mm + sigmoidf_(a) * y; }
                    u32x4 w; w.x = cvt_pk_bf16(o[0], o[1]); w.y = cvt_pk_bf16(o[2], o[3]); w.z = cvt_pk_bf16(o[4], o[5]); w.w = cvt_pk_bf16(o[6], o[7]);
                    *(u32x4*)(Mg + row * 1024 + col) = w; } }
    }
};
struct Out {
    static constexpr bool PERM = true;
    float* P; const float* xlat; const float* xctx; const float* mods;
    __device__ __forceinline__ void operator()(const f32x4 (&acc)[2][2][4][2], const Unit& u, int wr, int wc, int fr, int fq) const {
        const int row0 = u.pm * BM + wr * 64 + fr; const int col0 = u.pn * BM + wc * 32 + 8 * fq;
        const int bb = (u.pm * BM < NLAT) ? (u.pm * BM) / SEQ : 8;
        const float* xb = (u.pm * BM < NLAT) ? xlat : (xctx - (size_t)NLAT * D);
        const float* g1 = mods + (size_t)(bb * 6 + 2) * D;
        f32x4 gv[2][2];
#pragma unroll
        for (int bj = 0; bj < 2; ++bj)
#pragma unroll
            for (int n = 0; n < 2; ++n) gv[bj][n] = *(const f32x4*)(g1 + col0 + bj * HALF + 4 * n);
#pragma unroll
        for (int ai = 0; ai < 2; ++ai)
#pragma unroll
            for (int m = 0; m < 4; ++m) { const size_t off = (size_t)(row0 + ai * HALF + m * 16) * D + col0;
#pragma unroll
                for (int bj = 0; bj < 2; ++bj)
#pragma unroll
                    for (int n = 0; n < 2; ++n) { const f32x4 xr = *(const f32x4*)(xb + off + bj * HALF + 4 * n);
                        *(f32x4*)(P + off + bj * HALF + 4 * n) = xr * DN_ALPHA + gv[bj][n] * acc[ai][bj][m][n]; } }
    }
};
struct Swiglu {
    static constexpr bool PERM = true;
    bf16* ACT; const float* bgu;
    __device__ __forceinline__ void operator()(const f32x4 (&acc)[2][2][4][2], const Unit& u, int wr, int wc, int fr, int fq) const {
        const int e = u.pn >> 3, pn = u.pn & 7;
        const int row0 = u.pm * BM + wr * 64 + fr; const int hc0 = wc * 32 + 8 * fq;
        const float* bg = bgu + e * 2048 + pn * 128 + hc0;
        f32x4 bgl[2], bln[2];
#pragma unroll
        for (int n = 0; n < 2; ++n) { bgl[n] = *(const f32x4*)(bg + 4 * n); bln[n] = *(const f32x4*)(bg + 1024 + 4 * n); }
#pragma unroll
        for (int ai = 0; ai < 2; ++ai)
#pragma unroll
            for (int m = 0; m < 4; ++m) { bf16* rowp = ACT + (size_t)(row0 + ai * HALF + m * 16) * DFF + pn * 128 + hc0;
                float o[8];
#pragma unroll
                for (int q = 0; q < 8; ++q) { float gl = acc[ai][0][m][q >> 2][q & 3] + bgl[q >> 2][q & 3], ln = acc[ai][1][m][q >> 2][q & 3] + bln[q >> 2][q & 3];
                    gl = fminf(gl, 7.0f); ln = fminf(fmaxf(ln, -7.0f), 7.0f);
                    o[q] = gl * sigmoidf_(1.702f * gl) * (ln + 1.0f); }
                u32x4 w; w.x = cvt_pk_bf16(o[0], o[1]); w.y = cvt_pk_bf16(o[2], o[3]); w.z = cvt_pk_bf16(o[4], o[5]); w.w = cvt_pk_bf16(o[6], o[7]);
                *(u32x4*)rowp = w; }
    }
};
}
#define XB_TMO      128
#define XB_XCNT(j)  (256  + 64 * (j))
#define XB_XSUB(j)  (1280 + 64 * (j))
#define XB_XGEN(j)  (2304 + 64 * (j))
#define XB_TOP      3328
#define XB_TOPGEN   3392
#define XCD_BAR_WORDS 3456
#define XB_SPIN_CAP (1u << 18)
__device__ __forceinline__ unsigned xb_ld(unsigned* p)              { return __hip_atomic_load(p, __ATOMIC_RELAXED, __HIP_MEMORY_SCOPE_AGENT); }
__device__ __forceinline__ unsigned xb_add(unsigned* p, unsigned v) { return __hip_atomic_fetch_add(p, v, __ATOMIC_RELAXED, __HIP_MEMORY_SCOPE_AGENT); }
__device__ __forceinline__ unsigned xb_xcc_id() { return (unsigned)__builtin_amdgcn_s_getreg((3 << 11) | 20) & 0xFu; }
#define XB_SPIN(cond, bar) do { unsigned _sp = 0; while (cond) { __builtin_amdgcn_s_sleep(1); \
    if ((++_sp & 255u) == 0u) { if (xb_ld(&(bar)[XB_TMO])) break; if (_sp > XB_SPIN_CAP) { atomicAdd(&(bar)[XB_TMO], 1u); break; } } } } while (0)
struct XcdBarrier { unsigned* bar; unsigned x; volatile LAS unsigned* st; };
__device__ __forceinline__ XcdBarrier xcd_barrier_post(unsigned* bar, volatile LAS unsigned* st) {
    XcdBarrier b; b.bar = bar; b.x = xb_xcc_id(); b.st = st;
    if (threadIdx.x == 0) (void)xb_add(&bar[XB_XCNT(b.x)], 1u);
    return b;
}
__device__ __forceinline__ void xcd_barrier_complete(unsigned* bar, unsigned x, unsigned& nloc, unsigned& nx) {
    const unsigned G = gridDim.x * gridDim.y * gridDim.z;
    unsigned sum, cnt, mine, sp = 0u;
    for (;;) {
        sum = 0u; cnt = 0u; mine = 0u;
#pragma unroll
        for (unsigned j = 0; j < 16; ++j) { const unsigned c = xb_ld(&bar[XB_XCNT(j)]); sum += c; cnt += (c > 0u) ? 1u : 0u; mine = (j == x) ? c : mine; }
        if (sum == G) break;
        __builtin_amdgcn_s_sleep(1);
        if ((++sp & 255u) == 0u) { if (xb_ld(&bar[XB_TMO])) break; if (sp > XB_SPIN_CAP) { atomicAdd(&bar[XB_TMO], 1u); break; } }
    }
    nloc = mine > 0u ? mine : 1u; nx = cnt > 0u ? cnt : 1u;
}
__device__ __forceinline__ void xcd_barrier(const XcdBarrier& b) {
    asm volatile("s_waitcnt vmcnt(0)" ::: "memory");
    __syncthreads();
    if (threadIdx.x == 0) {
        unsigned* bar = b.bar;
        __builtin_amdgcn_s_waitcnt(0);
        unsigned nloc = b.st[0], nx = b.st[1];
        if (nloc == 0u) { xcd_barrier_complete(bar, b.x, nloc, nx); b.st[0] = nloc; b.st[1] = nx; }
        const unsigned old = xb_add(&bar[XB_XSUB(b.x)], 1u);
        const unsigned gen = old / nloc;
        if (old + 1u == (gen + 1u) * nloc) {
            __builtin_amdgcn_fence(__ATOMIC_RELEASE, "agent");
            asm volatile("s_waitcnt vmcnt(0)" ::: "memory");
            const unsigned og = xb_add(&bar[XB_TOP], 1u);
            const unsigned tg = og / nx;
            if (og + 1u == (tg + 1u) * nx) xb_add(&bar[XB_TOPGEN], 1u);
            else XB_SPIN(xb_ld(&bar[XB_TOPGEN]) == tg, bar);
            __builtin_amdgcn_fence(__ATOMIC_ACQUIRE, "agent");
            xb_add(&bar[XB_XGEN(b.x)], 1u);
            asm volatile("s_waitcnt vmcnt(0)" ::: "memory");
        } else {
            XB_SPIN(xb_ld(&bar[XB_XGEN(b.x)]) == gen, bar);
            __builtin_amdgcn_fence(__ATOMIC_ACQUIRE, "agent");
            asm volatile("s_waitcnt vmcnt(0)" ::: "memory");
        }
    }
    __syncthreads();
}
struct KArgs { const float* in[31]; float* out; unsigned char* ws; int ph_lo, ph_hi; };
typedef KArgs Ptrs;
__device__ __forceinline__ void tr_item(const float* W, int ldw, int k0, int n0, bf16* WT, int ldt, int dest_row0, LAS float* scr, int lane) {
#pragma unroll 8
    for (int i = 0; i < 32; ++i) { const int kk = 2 * i + (lane >> 5); scr[kk * 33 + (lane & 31)] = W[(size_t)(k0 + kk) * ldw + n0 + (lane & 31)]; }
    LDS_WAIT();
    const int c = lane & 7;
#pragma unroll
    for (int j = 0; j < 4; ++j) { const int n = (lane >> 3) + 8 * j; const LAS float* s = scr + (8 * c) * 33 + n;
        u32x4 o; o.x = pk2(s[0 * 33], s[1 * 33]); o.y = pk2(s[2 * 33], s[3 * 33]); o.z = pk2(s[4 * 33], s[5 * 33]); o.w = pk2(s[6 * 33], s[7 * 33]);
        *(u32x4*)(WT + (size_t)(dest_row0 + n) * ldt + k0 + 8 * c) = o; }
    LDS_WAIT();
}
template <class PT> __device__ __forceinline__ void convert_moe(const PT& P, int l, ldsp lds, int gw, int NGW, int wave, int lane) {
    LAS float* scr = (LAS float*)(lds + 40960 + wave * 8448);
    const float* wgu = P.in[25] + (size_t)l * NEXP * 1024 * 2048; const float* wdn = P.in[27] + (size_t)l * NEXP * 1024 * 1024;
    bf16* WGU = (bf16*)(P.ws + WS_WGU); bf16* WDN = (bf16*)(P.ws + WS_WDN);
    constexpr int I_GU = 16 * 64, I_DN = 16 * 32, I_E = I_GU + I_DN;
    for (int it = gw; it < NEXP * I_E; it += NGW) {
        const int e = it / I_E; int r = it - e * I_E;
        if (r < I_GU) { const int kb = r >> 6, nb = r & 63, n0 = nb * 32; const int half = n0 >> 10, pn = (n0 & 1023) >> 7, j0 = n0 & 127;
            tr_item(wgu + (size_t)e * 1024 * 2048, 2048, kb * 64, n0, WGU, 1024, e * 2048 + 256 * pn + 128 * half + j0 - 0, scr, lane); }
        else { r -= I_GU; const int kb = r >> 5, nb = r & 31; tr_item(wdn + (size_t)e * 1024 * 1024, 1024, kb * 64, nb * 32, WDN, 1024, e * 1024 + nb * 32, scr, lane); }
    }
}

template <class PT> __device__ __forceinline__ void phase_pre_a(const PT& P, ldsp lds, int wg, int G, int g_wave) {
    const int tid = fresh_tid(), lane = tid & 63, wave = __builtin_amdgcn_readfirstlane(tid >> 6);
    const int gw = wg * NWAVES + wave, NGW = G * NWAVES, gt = wg * NTHR + tid, NT = G * NTHR;
    unsigned char* ws = P.ws;
    LAS float* sl = (LAS float*)lds;
    for (int i = tid; i < 9 * 1024; i += NTHR) { const int bb = i >> 10, d = i & 1023; const float c = (bb < 8) ? P.in[1][bb * 1024 + d] : P.in[3][d]; sl[i] = silu_(c); }
    __syncthreads();
    if (gw < 192) { const int l = gw / 96, jb = gw % 96, j = jb * 64 + lane; const float* wm = P.in[4] + (size_t)l * 1024 * 6144 + j;
        float acc[9];
#pragma unroll
        for (int b = 0; b < 9; ++b) acc[b] = 0.f;
        for (int d = 0; d < 1024; d += 4) { float w[4];
#pragma unroll
            for (int q = 0; q < 4; ++q) w[q] = wm[(size_t)(d + q) * 6144];
#pragma unroll
            for (int q = 0; q < 4; ++q)
#pragma unroll
                for (int b = 0; b < 9; ++b) acc[b] += sl[b * 1024 + d + q] * w[q]; }
        const float bmv = P.in[5][l * 6144 + j]; float* mo = (float*)(ws + WS_MODS) + (size_t)l * 9 * 6144 + j;
#pragma unroll
        for (int b = 0; b < 9; ++b) mo[b * 6144] = acc[b] + bmv; }
    { f32x2* rope = (f32x2*)(ws + WS_ROPE); for (int i = gt; i < 128 * 16; i += NT) { const int pos = i >> 4, k = i & 15; const float fr = powf(10000.0f, -(float)k / 16.0f); float s, c; sincosf((float)pos * fr, &s, &c); rope[i] = (f32x2){c, s}; }
      f32x2* tw = (f32x2*)(ws + WS_TW); for (int i = gt; i < 8192; i += NT) { float s, c; sincospif((float)i / 4096.0f, &s, &c); tw[i] = (f32x2){c, s}; }
      float* sp = (float*)(ws + WS_SP); for (int i = gt; i < 2 * 2 * 1024; i += NT) { const float lam = P.in[15][i]; sp[i] = log1pf(expf(-lam)); }
      bf16* fc = (bf16*)(ws + WS_FC); for (int i = gt; i < 512 * 256; i += NT) { const int r = i >> 8, c = i & 255, part = r >> 8, m = r & 255; float s, co; sincospif((float)((c * m) & 255) / 128.0f, &s, &co); fc[i] = (bf16)f2bf((part ? s : co) * 0.0625f); }
      bf16* f1 = (bf16*)(ws + WS_F1); for (int i = gt; i < 256 * 256; i += NT) { const int R = i >> 8, kk = i & 255, w = R >> 5, pq = (R >> 4) & 1, k1 = 16 * w + (R & 15), pin = kk >> 7, n1 = kk & 127;
          float s, co; sincospif((float)((n1 * k1) & 127) / 64.0f, &s, &co); const float v = pq == 0 ? (pin == 0 ? co : -s) : (pin == 0 ? s : co); f1[i] = (bf16)f2bf(v * 0.08838834764831845f); }
      bf16* f2 = (bf16*)(ws + WS_F2); for (int i = gt; i < 64 * 128; i += NT) { const int k2 = i >> 7, kk = i & 127, part = kk >> 6, n2 = kk & 63; float s, co; sincospif((float)((n2 * k2) & 63) / 32.0f, &s, &co); f2[i] = (bf16)f2bf((part ? -s : co) * 0.125f); }
      bf16* f3 = (bf16*)(ws + WS_F256); for (int i = gt; i < 256 * 512; i += NT) { const int k = i >> 9, kk = i & 511, part = kk >> 8, t = kk & 255; float s, co; sincospif((float)((k * t) & 255) / 128.0f, &s, &co); f3[i] = (bf16)f2bf((part ? -s : co) * 0.0625f); }
    }
    for (int l = 0; l < DEPTH; ++l) {
        unsigned char* wl = ws + WS_WSM + l * WSM_LAYER;
        const float* win = P.in[6] + (size_t)l * 1024 * IN_COLS;
        bf16* wxf = (bf16*)(wl + WSM_WXF); for (int i = gt; i < 1024 * 1024; i += NT) { const int d = i >> 10, c = i & 1023; wxf[i] = (bf16)f2bf(win[(size_t)d * IN_COLS + 3584 + c]); }
        bf16* wrh = (bf16*)(wl + WSM_WRH); bf16* wrl = (bf16*)(wl + WSM_WRL); const float* wr = P.in[23] + (size_t)l * 1024 * 32;
        for (int i = gt; i < 32 * 1024; i += NT) { const int e = i >> 10, k = i & 1023; const float v = wr[k * 32 + e]; const unsigned h = f2bf(v); wrh[i] = (bf16)h; wrl[i] = (bf16)f2bf(v - bf2f(h)); }
        bf16* wg = (bf16*)(wl + WSM_WG);
        for (int i = gt; i < 4 * 16 * 64 * 64; i += NT) { const int in_ = i & 63, out_ = (i >> 6) & 63, hb = (i >> 12) & 15, gm = i >> 16; const int dir = gm >> 1;
            const float* src = ((gm & 1) ? P.in[13] : P.in[11]) + (size_t)l * 2 * 16 * 4096 + (size_t)dir * 16 * 4096 + hb * 4096; wg[i] = (bf16)f2bf(src[in_ * 64 + out_]); }
    }
    LAS float* scr = (LAS float*)(lds + 40960 + wave * 8448);
    constexpr int I_IN = 16 * 112, I_SQ = 16 * 32, I_MG = 16 * 96, I_L = I_IN + 4 * I_SQ + I_MG;
    for (int it = gw; it < DEPTH * I_L; it += NGW) {
        const int l = it / I_L; int r = it - l * I_L; unsigned char* wl = ws + WS_WSM + l * WSM_LAYER;
        if (r < I_IN) { const int kb = r / 112, nb = r % 112, n0 = nb * 32; const int dr = n0 < 1536 ? n0 : (n0 < 2560 ? n0 + 1024 : n0 - 1024);
            tr_item(P.in[6] + (size_t)l * 1024 * IN_COLS, IN_COLS, kb * 64, n0, (bf16*)(wl + WSM_WIN), 1024, dr, scr, lane); continue; }
        r -= I_IN;
        if (r < 4 * I_SQ) { const int which = r / I_SQ; r -= which * I_SQ; const int kb = r >> 5, nb = r & 31;
            const float* src = (which == 0 ? P.in[8] : which == 1 ? P.in[16] : which == 2 ? P.in[17] : P.in[20]) + (size_t)l * 1024 * 1024;
            const size_t dst = which == 0 ? WSM_WOA : which == 1 ? WSM_WOR : which == 2 ? WSM_WOF : WSM_WOUT;
            tr_item(src, 1024, kb * 64, nb * 32, (bf16*)(wl + dst), 1024, nb * 32, scr, lane); continue; }
        r -= 4 * I_SQ;
        { const int kb = r / 96, nb = r % 96; tr_item(P.in[18] + (size_t)l * 1024 * 3072, 3072, kb * 64, nb * 32, (bf16*)(wl + WSM_WM), 1024, nb * 32, scr, lane); }
    }
    convert_moe(P, 0, lds, gw, NGW, wave, lane);
}

struct FoldStore {
    static constexpr bool PERM = true;
    bf16* O;
    __device__ __forceinline__ void operator()(const f32x4 (&acc)[2][2][4][2], const pg8::Unit& u, int wr, int wc, int fr, int fq) const {
        const int row0 = 3584 + u.pm * 1024 + (u.pn >> 2) * 256 + wr * 64 + fr; const int col0 = (u.pn & 3) * 256 + wc * 32 + 8 * fq;
#pragma unroll
        for (int ai = 0; ai < 2; ++ai)
#pragma unroll
            for (int m = 0; m < 4; ++m) { bf16* rowp = O + (size_t)(row0 + ai * 128 + m * 16) * 1024 + col0;
#pragma unroll
                for (int bj = 0; bj < 2; ++bj) { const f32x4 v0 = acc[ai][bj][m][0], v1 = acc[ai][bj][m][1];
                    u32x4 w; w.x = pg8::cvt_pk_bf16(v0[0], v0[1]); w.y = pg8::cvt_pk_bf16(v0[2], v0[3]); w.z = pg8::cvt_pk_bf16(v1[0], v1[1]); w.w = pg8::cvt_pk_bf16(v1[2], v1[3]);
                    *(u32x4*)(rowp + bj * 128) = w; } }
    }
};
__device__ __forceinline__ void modulate_rows(const float* xlat, const float* xctx, const float* mods  , bf16* U, int nrow, int gw, int NGW, int lane) {
    for (int r = gw; r < nrow; r += NGW) {
        const bool lat = r < NLAT; const float* xr = lat ? xlat + (size_t)r * D : xctx + (size_t)(r - NLAT) * D; const int bb = lat ? (r >> 13) : 8;
        const float* sh = mods + (size_t)(bb * 6 + 0) * D; const float* sc = mods + (size_t)(bb * 6 + 1) * D;
        u32x2* o = (u32x2*)(U + (size_t)r * D);
#pragma unroll
        for (int j = 0; j < 4; ++j) { const int c = 4 * lane + 256 * j; const f32x4 v = *(const f32x4*)(xr + c), s = *(const f32x4*)(sc + c), h = *(const f32x4*)(sh + c);
            const f32x4 uu = v * (s + 1.0f) + h; u32x2 w; w.x = pk2(uu[0], uu[1]); w.y = pk2(uu[2], uu[3]); o[lane + 64 * j] = w; }
    }
}
namespace att {
__device__ __forceinline__ int crow(int r, int hi) { return (r & 3) + 8 * (r >> 2) + 4 * hi; }
__device__ __forceinline__ void attn_unit(ldsp lds, bf16* Z, const float* sink  , int qrow0, int g, int nloc, int krow_loc0, int jlo, int krow_ctx0, int tid) {
    const int lane = tid & 63, r32 = lane & 31, hi = lane >> 5; const int wid = __builtin_amdgcn_readfirstlane(tid >> 6);
    const int hh = wid >> 1, ts = wid & 1, head = 4 * g + hh;
    const int nt = nloc + 4;
    LAS float* wsf = (LAS float*)(lds + 32768) + wid * 64;
    const int krow_l = lane, kch = wid;
    const int vrow_l = 16 * (wid & 3) + (lane >> 2), vdh = wid >> 2, vch = lane & 3;
    const unsigned kdst = (unsigned)(kch * 1024 + krow_l * 16), vdst = (unsigned)(16384 + vdh * 4096 + vrow_l * 64 + vch * 16);
#define TILE_ROW(t) ((t) < nloc ? krow_loc0 + 64 * (t) : krow_ctx0 + 64 * ((t) - nloc))
    bf16x8 qr[4];
    { const bf16* Qw = Z + (size_t)(qrow0 + 32 * ts + r32) * ZC + ZQ + head * 64;
#pragma unroll
      for (int d0 = 0; d0 < 4; ++d0) qr[d0] = *(const bf16x8*)(Qw + d0 * 16 + hi * 8); }
    u32x4 kreg, vreg;
    { const int tr = TILE_ROW(0); kreg = *(const u32x4*)(Z + (size_t)(tr + krow_l) * ZC + ZK + g * 64 + kch * 8); vreg = *(const u32x4*)(Z + (size_t)(tr + vrow_l) * ZC + ZV + g * 64 + vdh * 32 + vch * 8); }
    *(LAS u32x4*)(lds + kdst) = kreg; *(LAS u32x4*)(lds + vdst) = vreg;
    float m_run = sink[head] * 1.4426950408889634f, l_run = 1.0f;
    f32x16 o[2]; o[0] = f32x16{}; o[1] = f32x16{};
    __syncthreads();
    for (int t = 0; t < nt; ++t) {
        const unsigned boff = (unsigned)(t & 1) * 8192u;
        if (t + 1 < nt) { const int tr = TILE_ROW(t + 1); kreg = *(const u32x4*)(Z + (size_t)(tr + krow_l) * ZC + ZK + g * 64 + kch * 8); vreg = *(const u32x4*)(Z + (size_t)(tr + vrow_l) * ZC + ZV + g * 64 + vdh * 32 + vch * 8); }
        f32x16 p0 = f32x16{}, p1 = f32x16{};
        { ldsp kb = lds + boff + hi * 1024 + r32 * 16;
#pragma unroll
          for (int d0 = 0; d0 < 4; ++d0) { const bf16x8 b0 = *(const LAS bf16x8*)(kb + d0 * 2048), b1 = *(const LAS bf16x8*)(kb + d0 * 2048 + 512);
              p0 = __builtin_amdgcn_mfma_f32_32x32x16_bf16(b0, qr[d0], p0, 0, 0, 0); p1 = __builtin_amdgcn_mfma_f32_32x32x16_bf16(b1, qr[d0], p1, 0, 0, 0); } }
        if (t < nloc) { const int j = jlo + t; const int qi = 32 * ts + r32;
            if (j == 0) {
#pragma unroll
                for (int r = 0; r < 16; ++r) { const int kk = crow(r, hi); if (kk < qi) p0[r] = -INFINITY; if (kk + 32 < qi) p1[r] = -INFINITY; } }
            if (j == 4) {
#pragma unroll
                for (int r = 0; r < 16; ++r) { const int kk = crow(r, hi); if (kk > qi) p0[r] = -INFINITY; if (kk + 32 > qi) p1[r] = -INFINITY; } } }
        float rm = p0[0];
#pragma unroll
        for (int r = 1; r < 16; ++r) rm = fmaxf(rm, p0[r]);
#pragma unroll
        for (int r = 0; r < 16; ++r) rm = fmaxf(rm, p1[r]);
        rm = fmaxf(rm, __shfl_xor(rm, 32));
        const float mnew = fmaxf(m_run, rm), f = __builtin_amdgcn_exp2f(m_run - mnew); m_run = mnew;
        float s = 0.f;
#pragma unroll
        for (int r = 0; r < 16; ++r) { p0[r] = __builtin_amdgcn_exp2f(p0[r] - mnew); p1[r] = __builtin_amdgcn_exp2f(p1[r] - mnew); s += p0[r] + p1[r]; }
        s += __shfl_xor(s, 32);
        l_run = l_run * f + s;
        if (hi == 0) wsf[r32] = f;
        LDS_WAIT();
#pragma unroll
        for (int r = 0; r < 16; ++r) { const float fr_ = wsf[crow(r, hi)]; o[0][r] *= fr_; o[1][r] *= fr_; }
        u32x4 pw0, pw1, pw2, pw3;
        pw0 = (u32x4){pk2(p0[0], p0[1]), pk2(p0[2], p0[3]), pk2(p0[4], p0[5]), pk2(p0[6], p0[7])};
        pw1 = (u32x4){pk2(p0[8], p0[9]), pk2(p0[10], p0[11]), pk2(p0[12], p0[13]), pk2(p0[14], p0[15])};
        pw2 = (u32x4){pk2(p1[0], p1[1]), pk2(p1[2], p1[3]), pk2(p1[4], p1[5]), pk2(p1[6], p1[7])};
        pw3 = (u32x4){pk2(p1[8], p1[9]), pk2(p1[10], p1[11]), pk2(p1[12], p1[13]), pk2(p1[14], p1[15])};
        { const LAS unsigned char* vp = lds + 16384 + boff + ((lane >> 4) & 1) * 32 + (lane & 3) * 8 + (4 * hi + ((lane & 15) >> 2)) * 64;
#pragma unroll
          for (int d0 = 0; d0 < 2; ++d0) {
#pragma unroll
              for (int ks = 0; ks < 4; ++ks) {
                  const s16x4 lo = __builtin_bit_cast(s16x4, __builtin_amdgcn_ds_read_tr16_b64_v4i16((LAS s16x4*)(vp + d0 * 4096 + ks * 1024)));
                  const s16x4 hh_ = __builtin_bit_cast(s16x4, __builtin_amdgcn_ds_read_tr16_b64_v4i16((LAS s16x4*)(vp + d0 * 4096 + ks * 1024 + 512)));
                  const bf16x8 vf = (bf16x8){lo[0], lo[1], lo[2], lo[3], hh_[0], hh_[1], hh_[2], hh_[3]};
                  const u32x4 pw = ks == 0 ? pw0 : ks == 1 ? pw1 : ks == 2 ? pw2 : pw3;
                  o[d0] = __builtin_amdgcn_mfma_f32_32x32x16_bf16(__builtin_bit_cast(bf16x8, pw), vf, o[d0], 0, 0, 0); } } }
        if (t + 1 < nt) { *(LAS u32x4*)(lds + (boff ^ 8192u) + kdst) = kreg; *(LAS u32x4*)(lds + (boff ^ 8192u) + vdst) = vreg; }
        __syncthreads();
    }
#undef TILE_ROW
    if (hi == 0) wsf[32 + r32] = l_run;
    LDS_WAIT();
    bf16* Ow = Z + (size_t)(qrow0 + 32 * ts) * ZC + ZQ + head * 64;
#pragma unroll
    for (int r = 0; r < 16; ++r) { const int q = crow(r, hi); const float rl = __builtin_amdgcn_rcpf(wsf[32 + q]);
#pragma unroll
        for (int d0 = 0; d0 < 2; ++d0) Ow[(size_t)q * ZC + d0 * 32 + r32] = (bf16)f2bf(o[d0][r] * rl); }
    LDS_WAIT();
}
__device__ __forceinline__ void attn_phase(ldsp lds, bf16* Z, const float* sink, bool with_ctx, int wg, int G, int g_wave) {
    const int tid = fresh_tid();
    const int nlat = NB * 4 * (SEQ / 64), nctx = with_ctx ? NB * 4 * (CTXL / 64) : 0;
    for (int u = wg; u < nlat + nctx; u += G) {
        if (u < nlat) { const int qb = u & 127, g = (u >> 7) & 3, b = u >> 9; const int qpos0 = qb * 64;
            const int jlo = qpos0 == 0 ? 2 : (qpos0 == 64 ? 1 : 0); const int jhi = qpos0 == SEQ - 64 ? 2 : (qpos0 == SEQ - 128 ? 3 : 4);
            attn_unit(lds, Z, sink, b * SEQ + qpos0, g, jhi - jlo + 1, b * SEQ + qpos0 - 128 + 64 * jlo, jlo, NLAT + b * CTXL, tid);
        } else { const int v = u - nlat; const int qb = v & 3, g = (v >> 2) & 3, b = v >> 4;
            attn_unit(lds, Z, sink, NLAT + b * CTXL + qb * 64, g, 0, 0, 0, NLAT + b * CTXL, tid); }
    }
}
}
namespace fft {
constexpr int RS = 144;
template <int K>
__device__ __forceinline__ void load_b(ldsp lds, const bf16* base, size_t rstride, size_t pstride, int tid) {
    constexpr int KH = K / 2;
#pragma unroll
    for (int i = 0; i < K / 64; ++i) { const int c = tid + NTHR * i, kk = c >> 3, ch = c & 7; const int part = kk / KH, n = kk % KH;
        const u32x4 v = *(const u32x4*)(base + (size_t)n * rstride + (size_t)part * pstride + ch * 8);
        *(LAS u32x4*)(lds + kk * RS + ch * 16) = v; }
}
template <int K, int MTW, int NTW>
__device__ __forceinline__ void mma(ldsp lds, const bf16* A, int mt0, int nt0, f32x4 (&acc)[MTW][NTW], int tid) {
    const int lane = tid & 63, fr = lane & 15, kq = lane >> 4;
#pragma unroll
    for (int i = 0; i < MTW; ++i)
#pragma unroll
        for (int j = 0; j < NTW; ++j) acc[i][j] = (f32x4){0.f, 0.f, 0.f, 0.f};
    const LAS unsigned char* bp = lds + (8 * kq + (fr >> 2)) * RS + (4 * (fr & 3)) * 2;
#pragma unroll 2
    for (int ks = 0; ks < K / 32; ++ks) {
        bf16x8 af[MTW];
#pragma unroll
        for (int i = 0; i < MTW; ++i) af[i] = *(const bf16x8*)(A + (size_t)(16 * (mt0 + i) + fr) * K + 32 * ks + 8 * kq);
#pragma unroll
        for (int j = 0; j < NTW; ++j) {
            const s16x4 lo = __builtin_bit_cast(s16x4, __builtin_amdgcn_ds_read_tr16_b64_v4i16((LAS s16x4*)(bp + (32 * ks) * RS + (nt0 + j) * 32)));
            const s16x4 hi = __builtin_bit_cast(s16x4, __builtin_amdgcn_ds_read_tr16_b64_v4i16((LAS s16x4*)(bp + (32 * ks + 4) * RS + (nt0 + j) * 32)));
            const bf16x8 bfrag = (bf16x8){lo[0], lo[1], lo[2], lo[3], hi[0], hi[1], hi[2], hi[3]};
#pragma unroll
            for (int i = 0; i < MTW; ++i) acc[i][j] = __builtin_amdgcn_mfma_f32_16x16x32_bf16(af[i], bfrag, acc[i][j], 0, 0, 0);
        }
    }
}
__device__ __forceinline__ void pass1_unit(ldsp lds, const bf16* Z, bf16* T, const bf16* F1, const f32x2* TW, int b, int n2, int ct, int tid) {
    const int lane = tid & 63, fr = lane & 15, kq = lane >> 4; const int w = __builtin_amdgcn_readfirstlane(tid >> 6);
    load_b<256>(lds, Z + (size_t)(b * SEQ + n2) * ZC + ZXC + ct * 64, (size_t)64 * ZC, 1024, tid);
    __syncthreads();
    f32x4 acc[2][4];
    mma<256, 2, 4>(lds, F1, 2 * w, 0, acc, tid);
    __syncthreads();
#pragma unroll
    for (int r = 0; r < 4; ++r) { const int k1 = 16 * w + 4 * kq + r; const f32x2 cs = TW[(n2 * k1) & 8191];
        bf16* o = T + (size_t)(b * SEQ + k1 * 64 + n2) * 2048 + ct * 64 + fr;
#pragma unroll
        for (int j = 0; j < 4; ++j) { const float p = acc[0][j][r], q = acc[1][j][r];
            o[16 * j] = (bf16)f2bf(p * cs.x - q * cs.y); o[1024 + 16 * j] = (bf16)f2bf(q * cs.x + p * cs.y); } }
}
__device__ __forceinline__ void pass2_unit(ldsp lds, bf16* Z, const bf16* T, const bf16* F2, int b, int k1, int ct, int tid) {
    const int lane = tid & 63, fr = lane & 15, kq = lane >> 4; const int w = __builtin_amdgcn_readfirstlane(tid >> 6);
    load_b<128>(lds, T + (size_t)(b * SEQ + k1 * 64) * 2048 + ct * 64, 2048, 1024, tid);
    __syncthreads();
    f32x4 acc[1][2];
    mma<128, 1, 2>(lds, F2, w >> 1, 2 * (w & 1), acc, tid);
    __syncthreads();
#pragma unroll
    for (int r = 0; r < 4; ++r) { const int k2 = 16 * (w >> 1) + 4 * kq + r;
        bf16* o = Z + (size_t)(b * SEQ + k1 + 128 * k2) * ZC + ZXC + ct * 64 + 32 * (w & 1) + fr;
#pragma unroll
        for (int j = 0; j < 2; ++j) o[16 * j] = (bf16)f2bf(acc[0][j][r]); }
}
__device__ __forceinline__ void ctx_unit(ldsp lds, bf16* Z, const bf16* F3, int b, int ct, int tid) {
    const int lane = tid & 63, fr = lane & 15, kq = lane >> 4; const int w = __builtin_amdgcn_readfirstlane(tid >> 6);
    load_b<512>(lds, Z + (size_t)(NLAT + b * CTXL) * ZC + ZXC + ct * 64, ZC, 1024, tid);
    __syncthreads();
    f32x4 acc[2][4];
    mma<512, 2, 4>(lds, F3, 2 * w, 0, acc, tid);
    __syncthreads();
#pragma unroll
    for (int i = 0; i < 2; ++i)
#pragma unroll
        for (int r = 0; r < 4; ++r) { const int k = 16 * (2 * w + i) + 4 * kq + r; bf16* o = Z + (size_t)(NLAT + b * CTXL + k) * ZC + ZXC + ct * 64 + fr;
#pragma unroll
            for (int j = 0; j < 4; ++j) o[16 * j] = (bf16)f2bf(acc[i][j][r]); }
}
__device__ __forceinline__ void pass1_phase(ldsp lds, bf16* Z, bf16* T, const unsigned char* ws, bool with_ctx, int wg, int G, int g_wave) {
    const bf16* F1 = (const bf16*)(ws + WS_F1); const bf16* F3 = (const bf16*)(ws + WS_F256); const f32x2* TW = (const f32x2*)(ws + WS_TW); const int tid = fresh_tid();
    for (int u = wg; u < NB * 64 * 16; u += G) { const int ct = u & 15, n2 = (u >> 4) & 63, b = u >> 10; pass1_unit(lds, Z, T, F1, TW, b, n2, ct, tid); }
    if (with_ctx) for (int u = wg; u < NB * 16; u += G) ctx_unit(lds, Z, F3, u >> 4, u & 15, tid);
}
__device__ __forceinline__ void pass2_phase(ldsp lds, bf16* Z, const bf16* T, const unsigned char* ws, int wg, int G, int g_wave) {
    const bf16* F2 = (const bf16*)(ws + WS_F2); const int tid = fresh_tid();
    for (int u = wg; u < NB * 128 * 16; u += G) { const int ct = u & 15, k1 = (u >> 4) & 127, b = u >> 11; pass2_unit(lds, Z, T, F2, b, k1, ct, tid); }
}
}
namespace rg {
constexpr int XRS = 144;
constexpr int WAVE_LDS = 68 * XRS;
struct Args {
    bf16* Z; const float* conv_w; const float* conv_b;
    const bf16* Wg;
    const float* b_a; const float* b_i; const float* sp;
    f32x2* SUM;
};
template <bool FINAL>
__device__ __forceinline__ void wave_unit(LAS unsigned char* xt, const Args& A, int bb, int cid, int hb, int tid) {
    const int lane = tid & 63, fr = lane & 15, kq = lane >> 4;
    const bool isctx = cid < 4; const int rowbase = isctx ? NLAT + bb * CTXL : bb * SEQ, len = isctx ? CTXL : SEQ, t0 = isctx ? cid * 64 : (cid - 4) * 64;
#pragma unroll
    for (int i = 0; i < 9; ++i) { const int rr = i * 8 + (lane >> 3), ch = lane & 7, t = t0 - 2 + rr;
        u32x4 v = {0u, 0u, 0u, 0u};
        if (rr < 68 && t >= 0 && t < len) v = *(const u32x4*)(A.Z + (size_t)(rowbase + t) * ZC + ZXR + hb * 64 + ch * 8);
        if (rr < 68) *(LAS u32x4*)(xt + rr * XRS + ch * 16) = v; }
    LDS_WAIT();
    bf16x8 af[4][2];
#pragma unroll
    for (int ks = 0; ks < 2; ++ks) { const int c0 = hb * 64 + 32 * ks + 8 * kq;
        float cw[4][8], cb[8];
#pragma unroll
        for (int tap = 0; tap < 4; ++tap) { const f32x4 a = *(const f32x4*)(A.conv_w + tap * 1024 + c0), b = *(const f32x4*)(A.conv_w + tap * 1024 + c0 + 4);
#pragma unroll
            for (int j = 0; j < 4; ++j) { cw[tap][j] = a[j]; cw[tap][4 + j] = b[j]; } }
        { const f32x4 a = *(const f32x4*)(A.conv_b + c0), b = *(const f32x4*)(A.conv_b + c0 + 4);
#pragma unroll
          for (int j = 0; j < 4; ++j) { cb[j] = a[j]; cb[4 + j] = b[j]; } }
#pragma unroll
        for (int mt = 0; mt < 4; ++mt) { float xc[8];
#pragma unroll
            for (int j = 0; j < 8; ++j) xc[j] = cb[j];
#pragma unroll
            for (int tap = 0; tap < 4; ++tap) { const u32x4 xv = *(const LAS u32x4*)(xt + (16 * mt + fr + tap) * XRS + (32 * ks + 8 * kq) * 2);
#pragma unroll
                for (int j = 0; j < 8; ++j) { const unsigned w = xv[j >> 1]; const float x = (j & 1) ? bf2f(w >> 16) : bf2f(w & 0xffffu); xc[j] += cw[tap][j] * x; } }
            u32x4 p; p.x = pk2(xc[0], xc[1]); p.y = pk2(xc[2], xc[3]); p.z = pk2(xc[4], xc[5]); p.w = pk2(xc[6], xc[7]);
            af[mt][ks] = __builtin_bit_cast(bf16x8, p); } }
    const int bsum = bb * NCHUNK + cid;
#pragma unroll 1
    for (int nt = 0; nt < 4; ++nt) {
        const int cch = hb * 64 + 16 * nt + fr;
        float xd[4][4];
        { float cwd[4];
#pragma unroll
          for (int tap = 0; tap < 4; ++tap) cwd[tap] = A.conv_w[tap * 1024 + cch];
          const float cbd = A.conv_b[cch];
#pragma unroll
          for (int mt = 0; mt < 4; ++mt) { float xs[7];
#pragma unroll
              for (int q = 0; q < 7; ++q) xs[q] = bf2f(*(const LAS unsigned short*)(xt + (16 * mt + 4 * kq + q) * XRS + (16 * nt + fr) * 2));
#pragma unroll
              for (int r = 0; r < 4; ++r) xd[mt][r] = cbd + cwd[0] * xs[r] + cwd[1] * xs[r + 1] + cwd[2] * xs[r + 2] + cwd[3] * xs[r + 3]; } }
        f32x4 g[4][4];
#pragma unroll
        for (int gm = 0; gm < 4; ++gm) { bf16x8 bw[2];
#pragma unroll
            for (int ks = 0; ks < 2; ++ks) bw[ks] = *(const bf16x8*)(A.Wg + ((size_t)((gm * 16 + hb) * 64 + 16 * nt + fr)) * 64 + 32 * ks + 8 * kq);
#pragma unroll
            for (int mt = 0; mt < 4; ++mt) { f32x4 c = {0.f, 0.f, 0.f, 0.f};
                c = __builtin_amdgcn_mfma_f32_16x16x32_bf16(af[mt][0], bw[0], c, 0, 0, 0); c = __builtin_amdgcn_mfma_f32_16x16x32_bf16(af[mt][1], bw[1], c, 0, 0, 0); g[gm][mt] = c; } }
        float hsum[4][4];
#pragma unroll
        for (int dir = 0; dir < 2; ++dir) {
            const float ba = A.b_a[dir * 1024 + cch], bi = A.b_i[dir * 1024 + cch], spv = A.sp[dir * 1024 + cch];
            float carry = 0.f;
            if (FINAL) { const f32x2* S = A.SUM + ((size_t)dir * NB + bb) * NCHUNK * 1024 + cch;
                if (dir == 0) { for (int i = 0; i < cid; ++i) { const f32x2 s = S[(size_t)i * 1024]; carry = s.x * carry + s.y; } }
                else if (isctx) { for (int i = 3; i > cid; --i) { const f32x2 s = S[(size_t)i * 1024]; carry = s.x * carry + s.y; } }
                else { for (int i = 3; i >= 0; --i) { const f32x2 s = S[(size_t)i * 1024]; carry = s.x * carry + s.y; }
                       for (int i = NCHUNK - 1; i > cid; --i) { const f32x2 s = S[(size_t)i * 1024]; carry = s.x * carry + s.y; } } }
            float ptot = 1.f;
#pragma unroll
            for (int mi = 0; mi < 4; ++mi) { const int mt = dir == 0 ? mi : 3 - mi;
                float a[4], bv[4];
#pragma unroll
                for (int r = 0; r < 4; ++r) { const float rr = sigmoidf_(g[2 * dir][mt][r] + ba), ii = sigmoidf_(g[2 * dir + 1][mt][r] + bi);
                    const float la = -8.0f * rr * spv; a[r] = __expf(la); const float x2 = 2.0f * la;
                    const float om = x2 > -0.1f ? -x2 * (1.0f + x2 * (0.5f + x2 * (0.16666667f + x2 * 0.041666668f))) : 1.0f - __expf(x2);
                    bv[r] = sqrtf(fmaxf(om, 0.f)) * ii * xd[mt][r]; }
                float s[4], p[4];
                if (dir == 0) { s[0] = bv[0]; p[0] = a[0];
#pragma unroll
                    for (int r = 1; r < 4; ++r) { s[r] = a[r] * s[r - 1] + bv[r]; p[r] = a[r] * p[r - 1]; } }
                else { s[3] = bv[3]; p[3] = a[3];
#pragma unroll
                    for (int r = 2; r >= 0; --r) { s[r] = a[r] * s[r + 1] + bv[r]; p[r] = a[r] * p[r + 1]; } }
                const float pe = dir == 0 ? p[3] : p[0], se = dir == 0 ? s[3] : s[0];
                float pa[4], sa[4];
#pragma unroll
                for (int q = 0; q < 4; ++q) { pa[q] = __shfl(pe, fr + 16 * q); sa[q] = __shfl(se, fr + 16 * q); }
                float cin = carry, mine = carry;
#pragma unroll
                for (int qi = 0; qi < 4; ++qi) { const int q = dir == 0 ? qi : 3 - qi; if (q == kq) mine = cin; cin = pa[q] * cin + sa[q]; ptot *= pa[q]; }
                carry = cin;
                if (FINAL) {
#pragma unroll
                    for (int r = 0; r < 4; ++r) { const float h = s[r] + p[r] * mine; hsum[mt][r] = dir == 0 ? h : hsum[mt][r] + h; } }
            }
            if (!FINAL) { if (kq == 0) A.SUM[(((size_t)dir * NB + bb) * NCHUNK + cid) * 1024 + cch] = (f32x2){ptot, carry}; }
        }
        if (FINAL) {
#pragma unroll
            for (int mt = 0; mt < 4; ++mt)
#pragma unroll
                for (int r = 0; r < 4; ++r) { const int t = t0 + 16 * mt + 4 * kq + r; bf16* gp = A.Z + (size_t)(rowbase + t) * ZC + ZGR + cch;
                    const float gr = bf2f(*gp); *gp = (bf16)f2bf(gelu_tanh(gr) * hsum[mt][r]); }
        }
    }
    (void)bsum;
    LDS_WAIT();
}
template <bool FINAL>
__device__ __forceinline__ void phase(ldsp lds, const Args& A, bool ctx_too, int wg, int G, int g_wave) {
    const int tid = fresh_tid(); const int wave = __builtin_amdgcn_readfirstlane(tid >> 6); LAS unsigned char* xt = lds + wave * WAVE_LDS;
    const int c_lo = ctx_too ? 0 : 4, nch = NCHUNK - c_lo, total = NB * nch * 16;
    for (int u = wg * NWAVES + wave; u < total; u += G * NWAVES) { const int hb = u & 15, rest = u >> 4, cid = c_lo + rest % nch, bb = rest / nch; wave_unit<FINAL>(xt, A, bb, cid, hb, tid); }
}
}
namespace rowp {
struct LnArgs { float* X1; bf16* U2; const float* lng; const float* lnb; const float* mods; const bf16* wrh; const bf16* wrl; const float* brt; int* asg_e; int* asg_p; float* asg_g; int* wgc; };
__device__ __forceinline__ void ln_router_phase(ldsp lds, const LnArgs& A, int nrow, int wg, int G, int g_wave) {
    const int tid = fresh_tid(), lane = tid & 63, fr = lane & 15, kq = lane >> 4; const int wave = __builtin_amdgcn_readfirstlane(tid >> 6);
    LAS int* cnt = (LAS int*)(lds + LM_CNT);
    if (tid < 32) cnt[tid] = 0;
    __syncthreads();
    constexpr int ARS = 2064;
    LAS float* part = (LAS float*)(lds + 66048); LAS float* lg = (LAS float*)(lds + 82432);
    const int ngrp = nrow / 16;
    for (int grp = wg; grp < ngrp; grp += G) {
#pragma unroll
        for (int rr = 0; rr < 2; ++rr) { const int lr = 2 * wave + rr, row = grp * 16 + lr; const int bb = row < NLAT ? (row >> 13) : 8;
            float* xp = A.X1 + (size_t)row * D; f32x4 v[4]; float s = 0.f;
#pragma unroll
            for (int j = 0; j < 4; ++j) { v[j] = *(const f32x4*)(xp + 4 * lane + 256 * j); s += (v[j][0] + v[j][1]) + (v[j][2] + v[j][3]); }
            const float mean = wave_sum(s) * (1.0f / D); float s2 = 0.f;
#pragma unroll
            for (int j = 0; j < 4; ++j) { v[j] = v[j] - mean; s2 += (v[j][0] * v[j][0] + v[j][1] * v[j][1]) + (v[j][2] * v[j][2] + v[j][3] * v[j][3]); }
            const float rstd = 1.0f / sqrtf(wave_sum(s2) * (1.0f / D) + LN_EPS);
            const float* sh = A.mods + (size_t)(bb * 6 + 3) * D; const float* sc = A.mods + (size_t)(bb * 6 + 4) * D;
#pragma unroll
            for (int j = 0; j < 4; ++j) { const int c = 4 * lane + 256 * j; const f32x4 gg = *(const f32x4*)(A.lng + c), bbv = *(const f32x4*)(A.lnb + c);
                const f32x4 x1 = v[j] * rstd * gg + bbv; *(f32x4*)(xp + c) = x1;
                const f32x4 u = x1 * (*(const f32x4*)(sc + c) + 1.0f) + *(const f32x4*)(sh + c);
                unsigned h[4], lo[4];
#pragma unroll
                for (int e = 0; e < 4; ++e) { h[e] = f2bf(u[e]); lo[e] = f2bf(u[e] - bf2f(h[e])); }
                const u32x2 hw = {h[0] | (h[1] << 16), h[2] | (h[3] << 16)}, lw = {lo[0] | (lo[1] << 16), lo[2] | (lo[3] << 16)};
                *(u32x2*)(A.U2 + (size_t)row * D + c) = hw;
                *(LAS u32x2*)(lds + lr * ARS + c * 2) = hw; *(LAS u32x2*)(lds + 33024 + lr * ARS + c * 2) = lw; } }
        __syncthreads();
        { f32x4 acc[2] = {{0.f, 0.f, 0.f, 0.f}, {0.f, 0.f, 0.f, 0.f}};
#pragma unroll
          for (int ks = 0; ks < 4; ++ks) { const int k0 = 128 * wave + 32 * ks + 8 * kq;
              const bf16x8 ah = *(const LAS bf16x8*)(lds + fr * ARS + k0 * 2), al = *(const LAS bf16x8*)(lds + 33024 + fr * ARS + k0 * 2);
#pragma unroll
              for (int nt = 0; nt < 2; ++nt) { const bf16x8 bh = *(const bf16x8*)(A.wrh + (size_t)(16 * nt + fr) * D + k0), bl = *(const bf16x8*)(A.wrl + (size_t)(16 * nt + fr) * D + k0);
                  acc[nt] = __builtin_amdgcn_mfma_f32_16x16x32_bf16(ah, bh, acc[nt], 0, 0, 0);
                  acc[nt] = __builtin_amdgcn_mfma_f32_16x16x32_bf16(al, bh, acc[nt], 0, 0, 0);
                  acc[nt] = __builtin_amdgcn_mfma_f32_16x16x32_bf16(ah, bl, acc[nt], 0, 0, 0); } }
#pragma unroll
          for (int nt = 0; nt < 2; ++nt)
#pragma unroll
              for (int r = 0; r < 4; ++r) part[(wave * 16 + 4 * kq + r) * 32 + 16 * nt + fr] = acc[nt][r]; }
        __syncthreads();
        { const int row = tid >> 5, e = tid & 31; float s = A.brt[e];
#pragma unroll
          for (int w = 0; w < 8; ++w) s += part[(w * 16 + row) * 32 + e];
          lg[row * 32 + e] = s; }
        __syncthreads();
        if (tid < 16) { const int row = grp * 16 + tid; float v[32];
#pragma unroll
            for (int e = 0; e < 32; ++e) v[e] = lg[tid * 32 + e];
            int be[4]; float bv[4];
#pragma unroll
            for (int k = 0; k < 4; ++k) { float best = -INFINITY; int bi = 0;
#pragma unroll
                for (int e = 0; e < 32; ++e) { const bool taken = (k > 0 && be[0] == e) || (k > 1 && be[1] == e) || (k > 2 && be[2] == e); if (!taken && v[e] > best) { best = v[e]; bi = e; } }
                be[k] = bi; bv[k] = best; }
            float ex[4], se = 0.f;
#pragma unroll
            for (int k = 0; k < 4; ++k) { ex[k] = __expf(bv[k] - bv[0]); se += ex[k]; }
            const float inv = 1.0f / se;
#pragma unroll
            for (int k = 0; k < 4; ++k) { const int pos = __hip_atomic_fetch_add(&cnt[be[k]], 1, __ATOMIC_RELAXED, __HIP_MEMORY_SCOPE_WORKGROUP); A.asg_e[row * 4 + k] = be[k]; A.asg_p[row * 4 + k] = pos; A.asg_g[row * 4 + k] = ex[k] * inv; } }
        __syncthreads();
    }
    __syncthreads();
    if (tid < 32) A.wgc[wg * 32 + tid] = cnt[tid];
}
__device__ __forceinline__ void moe_tables(ldsp lds, const int* wgc, int wg, int G, int g_wave) {
    const int tid = fresh_tid();
    LAS int* pst = (LAS int*)(lds + LM_PST); LAS int* myb = (LAS int*)(lds + LM_MYB); LAS int* ntl = (LAS int*)(lds + LM_NT); LAS unsigned short* te = (LAS unsigned short*)(lds + LM_TE);
    LAS int* tmp = (LAS int*)lds;
    { const int e = tid & 31, p = tid >> 5; int tot = 0, below = 0;
#pragma unroll 1
      for (int w = p; w < G; w += 16) { const int c = wgc[w * 32 + e]; tot += c; if (w < wg) below += c; }
      tmp[p * 32 + e] = tot; tmp[512 + p * 32 + e] = below; }
    __syncthreads();
    if (tid < 32) { int tot = 0, below = 0;
#pragma unroll
        for (int p = 0; p < 16; ++p) { tot += tmp[p * 32 + tid]; below += tmp[512 + p * 32 + tid]; }
        myb[tid] = below; tmp[1024 + tid] = (tot + 255) & ~255; }
    __syncthreads();
    if (tid == 0) { int acc = 0;
#pragma unroll 1
        for (int e = 0; e < 32; ++e) { pst[e] = acc; const int nt_e = tmp[1024 + e] >> 8;
#pragma unroll 1
            for (int i = 0; i < nt_e; ++i) te[(acc >> 8) + i] = (unsigned short)e; acc += tmp[1024 + e]; } pst[32] = acc; ntl[0] = acc >> 8; }
    __syncthreads();
}
__device__ __forceinline__ void gather_phase(ldsp lds, const bf16* U2, bf16* XS, const int* asg_e, const int* asg_p, int* asg_s, int nrow, int wg, int G, int g_wave) {
    const int tid = fresh_tid(), lane = tid & 63; const int wave = __builtin_amdgcn_readfirstlane(tid >> 6);
    const LAS int* pst = (const LAS int*)(lds + LM_PST); const LAS int* myb = (const LAS int*)(lds + LM_MYB);
    const int ngrp = nrow / 16;
    for (int grp = wg; grp < ngrp; grp += G) {
#pragma unroll
        for (int rr = 0; rr < 2; ++rr) { const int row = grp * 16 + 2 * wave + rr;
            const u32x4 v0 = *(const u32x4*)(U2 + (size_t)row * D + lane * 8), v1 = *(const u32x4*)(U2 + (size_t)row * D + 512 + lane * 8);
#pragma unroll
            for (int k = 0; k < 4; ++k) { const int e = asg_e[row * 4 + k], slot = pst[e] + myb[e] + asg_p[row * 4 + k];
                if (lane == 0) asg_s[row * 4 + k] = slot;
                *(u32x4*)(XS + (size_t)slot * D + lane * 8) = v0; *(u32x4*)(XS + (size_t)slot * D + 512 + lane * 8) = v1; } }
    }
}
struct CombArgs { const float* X1; const bf16* YS; const int* asg_s; const float* asg_g; const float* mods; const float* lng; const float* lnb; float* out_lat; float* out_ctx; bf16* Unext; const float* mods_next; };
__device__ __forceinline__ void combine_phase(const CombArgs& A, int nrow, int gw, int NGW, int lane) {
    for (int row = gw; row < nrow; row += NGW) { const bool lat = row < NLAT; const int bb = lat ? (row >> 13) : 8;
        int sl[4]; float gt[4];
#pragma unroll
        for (int k = 0; k < 4; ++k) { sl[k] = A.asg_s[row * 4 + k]; gt[k] = A.asg_g[row * 4 + k]; }
        const float* g2 = A.mods + (size_t)(bb * 6 + 5) * D; f32x4 v[4]; float s = 0.f;
#pragma unroll
        for (int j = 0; j < 4; ++j) { const int c = 4 * lane + 256 * j; f32x4 f = {0.f, 0.f, 0.f, 0.f};
#pragma unroll
            for (int k = 0; k < 4; ++k) { const u32x2 y = *(const u32x2*)(A.YS + (size_t)sl[k] * D + c); f[0] += gt[k] * bf2f(y.x & 0xffffu); f[1] += gt[k] * bf2f(y.x >> 16); f[2] += gt[k] * bf2f(y.y & 0xffffu); f[3] += gt[k] * bf2f(y.y >> 16); }
            v[j] = *(const f32x4*)(A.X1 + (size_t)row * D + c) * DN_ALPHA + *(const f32x4*)(g2 + c) * f; s += (v[j][0] + v[j][1]) + (v[j][2] + v[j][3]); }
        const float mean = wave_sum(s) * (1.0f / D); float s2 = 0.f;
#pragma unroll
        for (int j = 0; j < 4; ++j) { v[j] = v[j] - mean; s2 += (v[j][0] * v[j][0] + v[j][1] * v[j][1]) + (v[j][2] * v[j][2] + v[j][3] * v[j][3]); }
        const float rstd = 1.0f / sqrtf(wave_sum(s2) * (1.0f / D) + LN_EPS);
        float* op = lat ? A.out_lat + (size_t)row * D : A.out_ctx + (size_t)(row - NLAT) * D;
        const float* sh = A.mods_next + (size_t)(bb * 6 + 0) * D; const float* sc = A.mods_next + (size_t)(bb * 6 + 1) * D;
#pragma unroll
        for (int j = 0; j < 4; ++j) { const int c = 4 * lane + 256 * j; const f32x4 x2 = v[j] * rstd * *(const f32x4*)(A.lng + c) + *(const f32x4*)(A.lnb + c);
            *(f32x4*)(op + c) = x2;
            if (A.Unext) { const f32x4 u = x2 * (*(const f32x4*)(sc + c) + 1.0f) + *(const f32x4*)(sh + c); u32x2 w; w.x = pk2(u[0], u[1]); w.y = pk2(u[2], u[3]); *(u32x2*)(A.Unext + (size_t)row * D + c) = w; } }
    }
}
}
constexpr int PH_PER_LAYER = 11, N_PHASES = 2 + DEPTH * PH_PER_LAYER;
static_assert(sizeof(KArgs) == 31 * 8 + 8 + 8 + 8, "no padding in the argument struct");
#ifndef PHMASK
#define PHMASK 0xffffffu
#endif
#ifndef SUBM
#define SUBM 7
#endif
typedef const __attribute__((address_space(4))) KArgs CKArgs;
__device__ __forceinline__ CKArgs* fresh_args() { CKArgs* p = (CKArgs*)__builtin_amdgcn_kernarg_segment_ptr(); asm volatile("" : "+s"(p)); return p; }

__global__ void __launch_bounds__(NTHR, 2) mega(KArgs args) {
    extern __shared__ __attribute__((aligned(16))) unsigned char lds_raw[];
    const ldsp lds = (ldsp)lds_raw;
    const int G = gridDim.x, wg = blockIdx.x; const int g_wave = __builtin_amdgcn_readfirstlane((int)threadIdx.x >> 6);
    { const int tid0 = threadIdx.x; for (int u = tid0; u < (LDS_BYTES - RING_BYTES) / 4; u += NTHR) ((LAS unsigned*)(lds + RING_BYTES))[u] = 0u; }
    __syncthreads();
    const int lo = args.ph_lo, hi = args.ph_hi;
    XcdBarrier bar; bar.bar = (unsigned*)(args.ws + WS_CTL) + CW_BAR; bar.x = 0; bar.st = nullptr;
    if (hi - lo > 1) bar = xcd_barrier_post((unsigned*)(args.ws + WS_CTL) + CW_BAR, (volatile LAS unsigned*)(lds + LM_XB));
#define PHM(k) (((PHMASK) >> ((k) < 2 ? (k) : 2 + ((k) - 2) % PH_PER_LAYER)) & 1u)
#define IN(k) (PHM(k) && lo <= (k) && (k) < hi)
#define SEAM(k) do { if (lo <= (k) && (k) + 1 < hi) xcd_barrier(bar); } while (0)
#define ENTER() CKArgs& P = *fresh_args(); unsigned char* const ws = P.ws; (void)ws

    if (IN(0)) { ENTER(); phase_pre_a(P, lds, wg, G, g_wave); }
    SEAM(0);
    if (IN(1)) { ENTER();
#pragma unroll
        for (int l = 0; l < DEPTH; ++l) { unsigned char* wl = ws + WS_WSM + l * WSM_LAYER;
            pg8::Gemm g{(const bf16*)(ws + WS_FC), (const bf16*)(wl + WSM_WXF), 256, 1024, 256}; pg8::FoldOrder S{G, wg}; FoldStore E{(bf16*)(wl + WSM_WIN)};
            pg8::gemm_phase<FoldStore, pg8::FoldOrder>(lds, g, S, E, g_wave); }
        const int tid = fresh_tid(); modulate_rows(P.in[0], P.in[2], (const float*)(ws + WS_MODS), (bf16*)(ws + WS_U), NROW, wg * NWAVES + (tid >> 6), G * NWAVES, tid & 63);
    }
    SEAM(1);
#pragma unroll 1
    for (int l = 0; l < DEPTH; ++l) {
        const int pb = 2 + PH_PER_LAYER * l; const bool last = (l == DEPTH - 1);
        const int nrow = last ? NLAT : NROW;
#define WL(off) (ws + WS_WSM + (size_t)l * WSM_LAYER + (off))
#define MODS(ll) ((const float*)(ws + WS_MODS) + (size_t)(ll) * 9 * 6144)
        if (IN(pb + 0)) { ENTER(); pg8::Gemm g{(const bf16*)(ws + WS_U), (const bf16*)WL(WSM_WIN), 1024, 1024, 1024}; pg8::StaticOrder S; S.init(NROW, ZC, G, wg); epi::In E{(bf16*)(ws + WS_Z), (const f32x2*)(ws + WS_ROPE)};
            pg8::gemm_phase<epi::In, pg8::StaticOrder>(lds, g, S, E, g_wave); }
        SEAM(pb + 0);
        if (IN(pb + 1)) {
            if (SUBM & 1) { ENTER(); rg::Args RA{(bf16*)(ws + WS_Z), P.in[9] + l * 4096, P.in[10] + l * 1024, (const bf16*)WL(WSM_WG), P.in[12] + l * 2048, P.in[14] + l * 2048, (const float*)(ws + WS_SP) + l * 2048, (f32x2*)(ws + WS_SUM)};
                rg::phase<false>(lds, RA, true, wg, G, g_wave); __syncthreads(); }
            if (SUBM & 2) { ENTER(); att::attn_phase(lds, (bf16*)(ws + WS_Z), P.in[7] + l * 16, !last, wg, G, g_wave); __syncthreads(); }
            if (SUBM & 4) { ENTER(); fft::pass1_phase(lds, (bf16*)(ws + WS_Z), (bf16*)(ws + WS_T), ws, !last, wg, G, g_wave); } }
        SEAM(pb + 1);
        if (IN(pb + 2)) {
            { ENTER(); rg::Args RA{(bf16*)(ws + WS_Z), P.in[9] + l * 4096, P.in[10] + l * 1024, (const bf16*)WL(WSM_WG), P.in[12] + l * 2048, P.in[14] + l * 2048, (const float*)(ws + WS_SP) + l * 2048, (f32x2*)(ws + WS_SUM)};
              rg::phase<true>(lds, RA, !last, wg, G, g_wave); __syncthreads(); }
            { ENTER(); fft::pass2_phase(lds, (bf16*)(ws + WS_Z), (const bf16*)(ws + WS_T), ws, wg, G, g_wave); } }
        SEAM(pb + 2);
        if (IN(pb + 3)) {
            { ENTER(); pg8::Gemm g{(const bf16*)(ws + WS_Z) + ZQ, (const bf16*)WL(WSM_WOA), ZC, 1024, 1024}; pg8::StaticOrder S; S.init(nrow, 1024, G, wg); epi::Store E{(bf16*)(ws + WS_Y), 3072, nullptr, 1024}; pg8::gemm_phase<epi::Store, pg8::StaticOrder>(lds, g, S, E, g_wave); }
            { ENTER(); pg8::Gemm g{(const bf16*)(ws + WS_Z) + ZGR, (const bf16*)WL(WSM_WOR), ZC, 1024, 1024}; pg8::StaticOrder S; S.init(nrow, 1024, G, wg); epi::Store E{(bf16*)(ws + WS_Y) + 1024, 3072, nullptr, 1024}; pg8::gemm_phase<epi::Store, pg8::StaticOrder>(lds, g, S, E, g_wave); }
            { ENTER(); pg8::Gemm g{(const bf16*)(ws + WS_Z) + ZXC, (const bf16*)WL(WSM_WOF), ZC, 1024, 1024}; pg8::StaticOrder S; S.init(nrow, 1024, G, wg); epi::Store E{(bf16*)(ws + WS_Y) + 2048, 3072, nullptr, 1024}; pg8::gemm_phase<epi::Store, pg8::StaticOrder>(lds, g, S, E, g_wave); }
        }
        SEAM(pb + 3);
        if (IN(pb + 4)) { ENTER(); pg8::Gemm g{(const bf16*)(ws + WS_U), (const bf16*)WL(WSM_WM), 1024, 1024, 1024}; pg8::MergeOrder S; S.init(nrow, G, wg); epi::Merge E{(bf16*)(ws + WS_M), (const bf16*)(ws + WS_Y), P.in[19] + l * 3072};
            pg8::gemm_phase<epi::Merge, pg8::MergeOrder>(lds, g, S, E, g_wave); }
        SEAM(pb + 4);
        if (IN(pb + 5)) { ENTER(); pg8::Gemm g{(const bf16*)(ws + WS_M), (const bf16*)WL(WSM_WOUT), 1024, 1024, 1024}; pg8::StaticOrder S; S.init(nrow, 1024, G, wg);
            epi::Out E{(float*)(ws + WS_T), l == 0 ? P.in[0] : (const float*)P.out, l == 0 ? P.in[2] : (const float*)(ws + WS_X2C), MODS(l)};
            pg8::gemm_phase<epi::Out, pg8::StaticOrder>(lds, g, S, E, g_wave); }
        SEAM(pb + 5);
        if (IN(pb + 6)) { ENTER(); rowp::LnArgs A{(float*)(ws + WS_T), (bf16*)(ws + WS_U), P.in[21] + l * 1024, P.in[22] + l * 1024, MODS(l), (const bf16*)WL(WSM_WRH), (const bf16*)WL(WSM_WRL), P.in[24] + l * 32,
                (int*)(ws + WS_ASGE), (int*)(ws + WS_ASGP), (float*)(ws + WS_ASGG), (int*)(ws + WS_WGC)};
            rowp::ln_router_phase(lds, A, nrow, wg, G, g_wave); }
        SEAM(pb + 6);
        if (IN(pb + 7)) { ENTER(); rowp::moe_tables(lds, (const int*)(ws + WS_WGC), wg, G, g_wave);
            rowp::gather_phase(lds, (const bf16*)(ws + WS_U), (bf16*)(ws + WS_Z), (const int*)(ws + WS_ASGE), (const int*)(ws + WS_ASGP), (int*)(ws + WS_ASGS), nrow, wg, G, g_wave); }
        SEAM(pb + 7);
        if (IN(pb + 8)) { ENTER(); if (!IN(pb + 7)) rowp::moe_tables(lds, (const int*)(ws + WS_WGC), wg, G, g_wave);
            pg8::Gemm g{(const bf16*)(ws + WS_Z), (const bf16*)(ws + WS_WGU), 1024, 1024, 1024}; pg8::MoeOrder<8> S{G, wg, __builtin_amdgcn_readfirstlane(*(const LAS int*)(lds + LM_NT)), (const LAS unsigned short*)(lds + LM_TE)};
            epi::Swiglu E{(bf16*)(ws + WS_Y), P.in[26] + (size_t)l * NEXP * 2048}; pg8::gemm_phase<epi::Swiglu, pg8::MoeOrder<8>>(lds, g, S, E, g_wave); }
        SEAM(pb + 8);
        if (IN(pb + 9)) { ENTER(); if (!IN(pb + 8)) rowp::moe_tables(lds, (const int*)(ws + WS_WGC), wg, G, g_wave);
            pg8::Gemm g{(const bf16*)(ws + WS_Y), (const bf16*)(ws + WS_WDN), 1024, 1024, 1024}; pg8::MoeOrder<4> S{G, wg, __builtin_amdgcn_readfirstlane(*(const LAS int*)(lds + LM_NT)), (const LAS unsigned short*)(lds + LM_TE)};
            epi::Store E{(bf16*)(ws + WS_Z), 1024, P.in[28] + (size_t)l * NEXP * 1024, 1024}; pg8::gemm_phase<epi::Store, pg8::MoeOrder<4>>(lds, g, S, E, g_wave); }
        SEAM(pb + 9);
        if (IN(pb + 10)) { ENTER(); const int tid = fresh_tid(); const int wave = __builtin_amdgcn_readfirstlane(tid >> 6);
            rowp::CombArgs A{(const float*)(ws + WS_T), (const bf16*)(ws + WS_Z), (const int*)(ws + WS_ASGS), (const float*)(ws + WS_ASGG), MODS(l), P.in[29] + l * 1024, P.in[30] + l * 1024, P.out, (float*)(ws + WS_X2C),
                last ? nullptr : (bf16*)(ws + WS_U), MODS(last ? l : l + 1)};
            rowp::combine_phase(A, nrow, wg * NWAVES + wave, G * NWAVES, tid & 63);
            if (!last) convert_moe(P, l + 1, lds, wg * NWAVES + wave, G * NWAVES, wave, tid & 63); }
        if (!last) SEAM(pb + 10);
    }
#undef IN
#undef SEAM
}

extern "C" void kernel_launch(void* const* d_in, const int* in_sizes, int n_in, void* d_out, int out_size, void* d_ws, size_t ws_size, hipStream_t stream) {
    static int grid = 0;
    if (grid == 0) {
        if (n_in != 31 || in_sizes[0] != NLAT * D || out_size != NLAT * D || ws_size < WS_END) { fprintf(stderr, "kernel_launch: unexpected shapes / workspace (n_in %d, ws %zu < %zu)\n", n_in, ws_size, (size_t)WS_END); grid = -1; return; }
        int dev = 0, cus = 0, per_cu = 0;
        if (hipGetDevice(&dev) != hipSuccess || hipDeviceGetAttribute(&cus, hipDeviceAttributeMultiprocessorCount, dev) != hipSuccess) { grid = -1; return; }
        if (hipFuncSetAttribute((const void*)mega, hipFuncAttributeMaxDynamicSharedMemorySize, LDS_BYTES) != hipSuccess) { fprintf(stderr, "kernel_launch: hipFuncSetAttribute failed\n"); grid = -1; return; }
        if (hipOccupancyMaxActiveBlocksPerMultiprocessor(&per_cu, (const void*)mega, NTHR, LDS_BYTES) != hipSuccess || per_cu < 1) fprintf(stderr, "kernel_launch: occupancy query says %d\n", per_cu);
        (void)hipGetLastError();
        grid = cus;
    }
    if (grid < 0) return;
    if (hipMemsetAsync((char*)d_ws + WS_CTL, 0, CTL_ZERO_BYTES, stream) != hipSuccess) return;
    KArgs a{};
    for (int i = 0; i < 31; ++i) a.in[i] = (const float*)d_in[i];
    a.out = (float*)d_out; a.ws = (unsigned char*)d_ws;
#if MK_SINGLE
    a.ph_lo = 0; a.ph_hi = N_PHASES;
    hipLaunchKernelGGL(mega, dim3(grid), dim3(NTHR), LDS_BYTES, stream, a);
#else
    for (int p = 0; p < N_PHASES; ++p) { a.ph_lo = p; a.ph_hi = p + 1; hipLaunchKernelGGL(mega, dim3(grid), dim3(NTHR), LDS_BYTES, stream, a); }
#endif
}
```

```cpp
#define F8_LAYERS 3u
#include <hip/hip_runtime.h>
#include <cstdio>
#include <cstdint>

#ifndef MK_SINGLE
#define MK_SINGLE 1
#endif

#define GAS __attribute__((address_space(1)))
#define LAS __attribute__((address_space(3)))
typedef unsigned short bf16;
typedef short bf16x8 __attribute__((ext_vector_type(8)));
typedef short s16x4 __attribute__((ext_vector_type(4)));
typedef float f32x2 __attribute__((ext_vector_type(2)));
typedef float f32x4 __attribute__((ext_vector_type(4)));
typedef float f32x16 __attribute__((ext_vector_type(16)));
typedef unsigned u32x2 __attribute__((ext_vector_type(2)));
typedef unsigned u32x4 __attribute__((ext_vector_type(4)));
typedef LAS unsigned char* ldsp;

constexpr int NB = 8, SEQ = 8192, D = 1024, CTXL = 256, DEPTH = 2;
constexpr int NLAT = NB * SEQ, NCTX = NB * CTXL, NROW = NLAT + NCTX;
constexpr int IN_COLS = 4608;
constexpr int ZC = 5632, ZQ = 0, ZK = 1024, ZV = 1280, ZGR = 1536, ZXR = 2560, ZXC = 3584, ZXS = 4608;
constexpr int NEXP = 32, TOPK = 4, DFF = 1024;
constexpr int NSLOT = 278528;
constexpr int NCHUNK = (SEQ + CTXL) / 64;
constexpr float LN_EPS = 1e-5f, DN_ALPHA = 1.41421356237309515f;
constexpr float ATT_C2 = 0.125f * 1.4426950408889634f;
constexpr int NWAVES = 8, NTHR = 512;
#ifndef F8_LAYERS
#define F8_LAYERS 2u
#endif
constexpr int F8_WGU_SHIFT = 6, F8_WDN_SHIFT = 7;
typedef int v8i __attribute__((ext_vector_type(8)));

constexpr size_t MiB = 1u << 20;
constexpr size_t WS_CTL = 0, CTL_ZERO_BYTES = 1 * MiB;
constexpr size_t WS_MODS = 1 * MiB;
constexpr size_t WS_ROPE = WS_MODS + 512 * 1024;
constexpr size_t WS_TW   = WS_ROPE + 16 * 1024;
constexpr size_t WS_SP   = WS_TW + 64 * 1024;
constexpr size_t WS_FC   = WS_SP + 16 * 1024;
constexpr size_t WS_F1   = WS_FC + 256 * 1024;
constexpr size_t WS_F2   = WS_F1 + 128 * 1024;
constexpr size_t WS_F256 = WS_F2 + 16 * 1024;
constexpr size_t WS_WGC  = WS_F256 + 256 * 1024;
constexpr size_t WS_ASGE = 3 * MiB;
constexpr size_t WS_ASGP = WS_ASGE + 2 * MiB;
constexpr size_t WS_ASGG = WS_ASGP + 2 * MiB;
constexpr size_t WS_ASGS = WS_ASGG + 2 * MiB;
constexpr size_t WS_SUM  = 12 * MiB;
constexpr size_t WS_X2C  = 30 * MiB;
constexpr size_t WS_CARRY = 1971 * MiB;
constexpr size_t WS_WSM  = 41 * MiB;
constexpr size_t WSM_LAYER = 32 * MiB;
constexpr size_t WSM_WIN = 0;
constexpr size_t WSM_WXF = 11 * MiB;
constexpr size_t WSM_WOA = 13 * MiB, WSM_WOR = 15 * MiB, WSM_WOF = 17 * MiB, WSM_WOUT = 19 * MiB;
constexpr size_t WSM_WM  = 21 * MiB;
constexpr size_t WSM_WRH = 27 * MiB, WSM_WRL = WSM_WRH + 64 * 1024;
constexpr size_t WSM_WG  = 28 * MiB;
constexpr size_t WS_WGU  = 105 * MiB;
constexpr size_t WS_WDN  = 233 * MiB;
constexpr size_t WS_U    = 297 * MiB;
constexpr size_t WS_T    = 429 * MiB;
constexpr size_t WS_Z    = 693 * MiB;
constexpr size_t WS_Y    = 1419 * MiB;
constexpr size_t WS_M    = WS_Y + 396 * MiB;
constexpr size_t WS_END  = 1980 * MiB;
static_assert((size_t)NROW * ZC * 2 <= 726 * MiB && (size_t)NSLOT * 1024 * 2 <= 544 * MiB && (size_t)NROW * 3072 * 2 <= 396 * MiB && (size_t)NROW * 2048 * 2 <= 264 * MiB, "ws map");
constexpr int CW_TMO = 0, CW_BAR = 4096;

constexpr int RING_BYTES = 131072;
constexpr int LM_XB = RING_BYTES;
constexpr int LM_CNT = RING_BYTES + 64;
constexpr int LM_PST = LM_CNT + 128;
constexpr int LM_MYB = LM_PST + 144;
constexpr int LM_NT  = LM_MYB + 128;
constexpr int LM_TE  = LM_NT + 16;
constexpr int LDS_BYTES = 147456;

#define LDS_WAIT() asm volatile("s_waitcnt lgkmcnt(0)" ::: "memory")
#define VM_WAIT() asm volatile("s_waitcnt vmcnt(0)" ::: "memory")
__device__ __forceinline__ unsigned f2bf(float f) { unsigned u = __builtin_bit_cast(unsigned, f); return (u + 0x7fffu + ((u >> 16) & 1u)) >> 16; }
__device__ __forceinline__ float bf2f(unsigned h) { return __builtin_bit_cast(float, h << 16); }
__device__ __forceinline__ unsigned pk2(float lo, float hi) { return f2bf(lo) | (f2bf(hi) << 16); }
__device__ __forceinline__ float wave_sum(float v) {
#pragma unroll
    for (int o = 1; o < 64; o <<= 1) v += __shfl_xor(v, o);
    return v;
}
__device__ __forceinline__ float sigmoidf_(float x) { return __builtin_amdgcn_rcpf(1.0f + __builtin_amdgcn_exp2f(-1.4426950408889634f * x)); }
__device__ __forceinline__ float gelu_tanh(float x) { const float u = 0.7978845608028654f * (x + 0.044715f * x * x * x); return x * sigmoidf_(2.0f * u); }
__device__ __forceinline__ float silu_(float x) { return x * sigmoidf_(x); }

__device__ __forceinline__ int fresh_tid_w(int wave_sgpr) { int w = wave_sgpr; asm volatile("" : "+s"(w)); int t = w * 64 + (int)__builtin_amdgcn_mbcnt_hi(~0u, __builtin_amdgcn_mbcnt_lo(~0u, 0u)); asm volatile("" : "+v"(t)); return t; }
#define fresh_tid() fresh_tid_w(g_wave)
namespace pg8 {
#define PG8_LAS __attribute__((address_space(3)))
typedef unsigned short bf16_t;
constexpr int BM = 256, BK = 64, HALF = 128, HTB = HALF * BK * 2, STAGE_BYTES = 8 * HTB, NXCD = 8, WGM = 8;
__host__ __device__ __forceinline__ int lds_byte(int r, int c) { const int st = (r >> 4) * 2 + (c >> 5), rr = r & 15, cc = c & 31, ob = rr * 64 + cc * 2; return st * 1024 + (ob ^ (((ob >> 9) & 1) << 5)); }
__host__ __device__ __forceinline__ void stage_rc(int b, int& R, int& C) { const int st = b / 1024, sb = b % 1024, swz = sb ^ (((sb >> 9) & 1) << 5); R = (st >> 1) * 16 + swz / 64; C = (st & 1) * 32 + (swz % 64) / 2; }
__host__ __device__ __forceinline__ int perm32(int rho) { const int n = rho >> 4, i = rho & 15; return 8 * (i >> 2) + 4 * n + (i & 3); }

struct Unit { int pm, pn; };
struct Gemm { const bf16_t* A; const bf16_t* Bt; int lda, ldb, K; };

struct StaticOrder {
    int nM, nN, nwg, G, c;
    __device__ void init(int M, int N, int G_, int c_) { nM = M / BM; nN = N / BM; nwg = nM * nN; G = G_; c = c_; }
    __device__ bool next(int i, Unit& u) const {
        const long L = (long)i * G + c; if (L >= nwg) return false;
        int wgid = (int)L; { const int q = nwg / NXCD, r = nwg % NXCD, xcd = wgid % NXCD, off = wgid / NXCD; wgid = (xcd < r ? xcd * (q + 1) : r * (q + 1) + (xcd - r) * q) + off; }
        const int nig = WGM * nN, gid = wgid / nig, fm = gid * WGM, gsz = (nM - fm) < WGM ? (nM - fm) : WGM;
        u.pm = fm + ((wgid % nig) % gsz); u.pn = (wgid % nig) / gsz; return true;
    }
    __device__ __forceinline__ const char* a_ptr(const Gemm& g, const Unit& u) const { return (const char*)g.A + (size_t)u.pm * BM * g.lda * 2; }
    __device__ __forceinline__ const char* b_ptr(const Gemm& g, const Unit& u) const { return (const char*)g.Bt + (size_t)u.pn * BM * g.ldb * 2; }
};
struct MergeOrder {
    StaticOrder s;
    __device__ void init(int M, int G_, int c_) { s.init(M, 1024, G_, c_); }
    __device__ bool next(int i, Unit& u) const { const int j = i / 3, br = i - 3 * j; Unit t; if (!s.next(j, t)) return false; u.pm = t.pm; u.pn = br * 4 + t.pn; return true; }
    __device__ __forceinline__ const char* a_ptr(const Gemm& g, const Unit& u) const { return (const char*)g.A + (size_t)u.pm * BM * g.lda * 2; }
    __device__ __forceinline__ const char* b_ptr(const Gemm& g, const Unit& u) const { return (const char*)g.Bt + (size_t)u.pn * BM * g.ldb * 2; }
};
struct FoldOrder {
    int G, c;
    __device__ bool next(int i, Unit& u) const { const int L = i * G + c; if (L >= 32) return false; u.pm = L & 1; u.pn = L >> 1; return true; }
    __device__ __forceinline__ const char* a_ptr(const Gemm& g, const Unit& u) const { return (const char*)g.A + (size_t)u.pm * BM * g.lda * 2; }
    __device__ __forceinline__ const char* b_ptr(const Gemm& g, const Unit& u) const { const int grp = u.pn >> 2, dn = u.pn & 3; return (const char*)g.Bt + ((size_t)dn * BM * g.ldb + grp * 256) * 2; }
};
template <int NPN> struct MoeOrder {
    int G, c, nt; const PG8_LAS unsigned short* te;
    __device__ bool next(int i, Unit& u) const { const int x = c & 7, slot = c >> 3, per = G >> 3; const int Lx = i * per + slot; const int rl = Lx / NPN, pn = Lx - rl * NPN, rt = rl * 8 + x;
        if (rt >= nt) return false; u.pm = rt; u.pn = __builtin_amdgcn_readfirstlane((int)te[rt]) * NPN + pn; return true; }
    __device__ __forceinline__ const char* a_ptr(const Gemm& g, const Unit& u) const { return (const char*)g.A + (size_t)u.pm * BM * g.lda * 2; }
    __device__ __forceinline__ const char* b_ptr(const Gemm& g, const Unit& u) const { return (const char*)g.Bt + (size_t)u.pn * BM * g.ldb * 2; }
};

__device__ __forceinline__ unsigned cvt_pk_bf16(float lo, float hi) { unsigned r; asm volatile("v_cvt_pk_bf16_f32 %0, %1, %2" : "=v"(r) : "v"(lo), "v"(hi)); return r; }

template <class Epi, class Sched, bool F8 = false>
__device__ __forceinline__ void gemm_phase(PG8_LAS unsigned char* lds, const Gemm g, const Sched& S, const Epi& E, int g_wave) {
    const int tid = fresh_tid(), wid = __builtin_amdgcn_readfirstlane(tid >> 6), lane = tid & 63, wr = wid >> 2, wc = wid & 3, fr = lane & 15, fq = lane >> 4;
    const int K = g.K, nt = K / BK;
    unsigned voffA[2], voffB[2];
#pragma unroll
    for (int i = 0; i < 2; ++i) { int R, C; stage_rc(tid * 16 + i * 8192, R, C); const int Rb = Epi::PERM ? ((R & ~31) + perm32(R & 31)) : R;
        voffA[i] = (unsigned)(R * g.lda + C) * 2u; voffB[i] = (unsigned)(Rb * g.ldb + C) * 2u; }
    const size_t kstep = (size_t)(BK * 2);
    const size_t hstepA = (size_t)HALF * g.lda * 2, hstepB = (size_t)HALF * g.ldb * 2;
    const unsigned ldsw = (unsigned)wid * 1024u; const unsigned ldsbase = (unsigned)(uintptr_t)lds;
    const int aoff = lds_byte(wr * 64 + fr, fq * 8), boff = lds_byte(wc * 32 + fr, fq * 8);
#define PG8_SA(b, h) (((b) * 2 + (h)) * HTB)
#define PG8_SB(b, h) ((4 + (b) * 2 + (h)) * HTB)
#define PG8_STAGE(bufoff, gbase, voff) do { _Pragma("unroll") for (int _i = 0; _i < 2; ++_i) { unsigned _keep; \
        asm volatile("s_mov_b32 %0, m0\n\ts_mov_b32 m0, %3\n\ts_nop 0\n\tglobal_load_lds_dwordx4 %1, %2\n\ts_mov_b32 m0, %0" : "=&s"(_keep) : "v"((voff)[_i]), "s"((const char*)(gbase)), \
                     "s"((unsigned)__builtin_amdgcn_readfirstlane((int)(ldsbase + (unsigned)(bufoff) + ldsw + _i * 8192))) : "memory"); } } while (0)
#define PG8_LDA(dst, b, h) do { _Pragma("unroll") for (int m = 0; m < 4; ++m) _Pragma("unroll") for (int k = 0; k < 2; ++k) dst[m][k] = *(const PG8_LAS bf16x8*)(lds + PG8_SA(b, h) + aoff + m * 2048 + k * 1024); } while (0)
#define PG8_LDB(dst, b, h) do { _Pragma("unroll") for (int n = 0; n < 2; ++n) _Pragma("unroll") for (int k = 0; k < 2; ++k) dst[n][k] = *(const PG8_LAS bf16x8*)(lds + PG8_SB(b, h) + boff + n * 2048 + k * 1024); } while (0)
#define PG8_MMA(ai, bj, At, Bt) do { __builtin_amdgcn_s_setprio(1); _Pragma("unroll") for (int m = 0; m < 4; ++m) _Pragma("unroll") for (int n = 0; n < 2; ++n) _Pragma("unroll") for (int k = 0; k < 2; ++k) \
        acc[ai][bj][m][n] = __builtin_amdgcn_mfma_f32_16x16x32_bf16(Bt[n][k], At[m][k], acc[ai][bj][m][n], 0, 0, 0); __builtin_amdgcn_s_setprio(0); } while (0)
#define PG8_CAT(x, y) __builtin_shufflevector(__builtin_bit_cast(u32x4, x), __builtin_bit_cast(u32x4, y), 0, 1, 2, 3, 4, 5, 6, 7)
#define PG8_MMA8(ai, bj, At, Bt) do { __builtin_amdgcn_s_setprio(1); _Pragma("unroll") for (int m = 0; m < 4; ++m) _Pragma("unroll") for (int n = 0; n < 2; ++n) { \
        const v8i _wa = __builtin_bit_cast(v8i, PG8_CAT(Bt[n][0], Bt[n][1])), _xa = __builtin_bit_cast(v8i, PG8_CAT(At[m][0], At[m][1])); \
        asm volatile("v_mfma_scale_f32_16x16x128_f8f6f4 %0, %1, %2, %0, %3, %4 op_sel_hi:[0,0,0]" : "+v"(acc[ai][bj][m][n]) : "v"(_wa), "v"(_xa), "v"(f8sw), "v"(f8s1)); } \
        __builtin_amdgcn_s_setprio(0); } while (0)
#define PG8_MM(ai, bj, At, Bt) do { if constexpr (F8) PG8_MMA8(ai, bj, At, Bt); else PG8_MMA(ai, bj, At, Bt); } while (0)
#define PG8_WAIT_V(n) asm volatile("s_waitcnt vmcnt(" #n ")" ::: "memory")
#define PG8_WAIT_L(n) asm volatile("s_waitcnt lgkmcnt(" #n ")" ::: "memory")
#define PG8_BAR __builtin_amdgcn_s_barrier()
#define PG8_SCHED __builtin_amdgcn_sched_barrier(0)
    Unit cur, nxt; int ui = 0;
    if (!S.next(0, cur)) return;
    f32x4 acc[2][2][4][2];
#pragma unroll
    for (int a = 0; a < 2; ++a)
#pragma unroll
        for (int b = 0; b < 2; ++b)
#pragma unroll
            for (int m = 0; m < 4; ++m)
#pragma unroll
                for (int n = 0; n < 2; ++n) { acc[a][b][m][n] = (f32x4){0.f, 0.f, 0.f, 0.f}; if constexpr (F8) asm volatile("" : "+v"(acc[a][b][m][n])); }
    bf16x8 At[4][2], B0[2][2], B1[2][2];
    int f8sw = 127, f8s1 = 127; if constexpr (F8) { f8sw = E.f8_scale_w; asm volatile("" : "+v"(f8sw), "+v"(f8s1)); }
    const char* cA = S.a_ptr(g, cur); const char* cB = S.b_ptr(g, cur);
    PG8_STAGE(PG8_SB(0, 0), cB, voffB); PG8_STAGE(PG8_SB(0, 1), cB + hstepB, voffB); PG8_STAGE(PG8_SA(0, 0), cA, voffA); PG8_STAGE(PG8_SA(0, 1), cA + hstepA, voffA);
    if (wr == 1) PG8_BAR;
    PG8_WAIT_V(2); PG8_BAR;
    PG8_STAGE(PG8_SB(1, 0), cB + kstep, voffB); PG8_STAGE(PG8_SA(1, 0), cA + kstep, voffA); PG8_STAGE(PG8_SB(1, 1), cB + hstepB + kstep, voffB);
    PG8_WAIT_V(6); PG8_BAR;
    for (;;) {
        const bool has_next = S.next(ui + 1, nxt);
        const char* nA = has_next ? S.a_ptr(g, nxt) : cA; const char* nB = has_next ? S.b_ptr(g, nxt) : cB;
#pragma unroll 1
        for (int t = 0; t < nt; t += 2) {
            const bool last = (t == nt - 2);
            const char* a1 = cA + (size_t)(t + 1) * kstep;
            const char* a2 = last ? nA : cA + (size_t)(t + 2) * kstep; const char* b2 = last ? nB : cB + (size_t)(t + 2) * kstep;
            const char* a3 = a2 + kstep; const char* b3 = b2 + kstep;
            PG8_LDB(B0, 0, 0); PG8_LDB(B1, 0, 1); PG8_SCHED; PG8_LDA(At, 0, 0); PG8_STAGE(PG8_SA(1, 1), a1 + hstepA, voffA);
            PG8_WAIT_V(8); PG8_WAIT_L(0); PG8_BAR; PG8_MM(0, 0, At, B0); PG8_MM(0, 1, At, B1); PG8_BAR; PG8_SCHED;
            PG8_LDA(At, 0, 1); PG8_STAGE(PG8_SB(0, 0), b2, voffB); PG8_STAGE(PG8_SB(0, 1), b2 + hstepB, voffB); PG8_STAGE(PG8_SA(0, 0), a2, voffA);
            PG8_WAIT_V(8); PG8_WAIT_L(0); PG8_BAR; PG8_MM(1, 0, At, B0); PG8_MM(1, 1, At, B1); PG8_BAR; PG8_SCHED;
            PG8_LDB(B0, 1, 0); PG8_LDB(B1, 1, 1); PG8_SCHED; PG8_LDA(At, 1, 0); PG8_STAGE(PG8_SA(0, 1), a2 + hstepA, voffA);
            PG8_WAIT_V(8); PG8_WAIT_L(0); PG8_BAR; PG8_MM(0, 0, At, B0); PG8_MM(0, 1, At, B1); PG8_BAR; PG8_SCHED;
            PG8_LDA(At, 1, 1); PG8_STAGE(PG8_SB(1, 0), b3, voffB); PG8_STAGE(PG8_SB(1, 1), b3 + hstepB, voffB); PG8_STAGE(PG8_SA(1, 0), a3, voffA);
            PG8_WAIT_V(8); PG8_WAIT_L(0); PG8_BAR; PG8_MM(1, 0, At, B0); PG8_MM(1, 1, At, B1); PG8_BAR; PG8_SCHED;
        }
        if (wr == 0) PG8_BAR;
        if constexpr (F8) {
#pragma unroll
            for (int a = 0; a < 2; ++a)
#pragma unroll
                for (int b = 0; b < 2; ++b) { if (a == 0 && b == 0) asm volatile("s_nop 15\n\ts_nop 3" : "+v"(acc[0][0][0][0]), "+v"(acc[0][0][0][1]), "+v"(acc[0][0][1][0]), "+v"(acc[0][0][1][1]), "+v"(acc[0][0][2][0]), "+v"(acc[0][0][2][1]), "+v"(acc[0][0][3][0]), "+v"(acc[0][0][3][1]));
                    else asm volatile("" : "+v"(acc[a][b][0][0]), "+v"(acc[a][b][0][1]), "+v"(acc[a][b][1][0]), "+v"(acc[a][b][1][1]), "+v"(acc[a][b][2][0]), "+v"(acc[a][b][2][1]), "+v"(acc[a][b][3][0]), "+v"(acc[a][b][3][1])); } }
        E(acc, cur, wr, wc, fr, fq);
        if (!has_next) break;
#pragma unroll
        for (int a = 0; a < 2; ++a)
#pragma unroll
            for (int b = 0; b < 2; ++b)
#pragma unroll
                for (int m = 0; m < 4; ++m)
#pragma unroll
                    for (int n = 0; n < 2; ++n) { acc[a][b][m][n] = (f32x4){0.f, 0.f, 0.f, 0.f}; if constexpr (F8) asm volatile("" : "+v"(acc[a][b][m][n])); }
        cur = nxt; cA = nA; cB = nB; ++ui;
        if (wr == 1) PG8_BAR;
    }
    PG8_WAIT_V(0);
    PG8_BAR;
#undef PG8_SA
#undef PG8_SB
#undef PG8_STAGE
#undef PG8_LDA
#undef PG8_LDB
#undef PG8_MMA
#undef PG8_MMA8
#undef PG8_MM
#undef PG8_CAT
#undef PG8_WAIT_V
#undef PG8_WAIT_L
#undef PG8_BAR
#undef PG8_SCHED
}
}
namespace epi {
using pg8::Unit; using pg8::cvt_pk_bf16; constexpr int HALF = 128, BM = 256;
struct Store {
    static constexpr bool PERM = true;
    bf16* O; int ldc; const float* bias;
    int f8_scale_w;
    int ncol_out;
    __device__ __forceinline__ void operator()(const f32x4 (&acc)[2][2][4][2], const Unit& u, int wr, int wc, int fr, int fq) const {
        const int row0 = u.pm * BM + wr * 64 + fr; const int gcol0 = u.pn * BM + wc * 32 + 8 * fq; const int col0 = gcol0 % ncol_out;
        f32x4 bv[2][2];
#pragma unroll
        for (int bj = 0; bj < 2; ++bj)
#pragma unroll
            for (int n = 0; n < 2; ++n) bv[bj][n] = bias ? *(const f32x4*)(bias + gcol0 + bj * HALF + 4 * n) : (f32x4){0.f, 0.f, 0.f, 0.f};
#pragma unroll
        for (int ai = 0; ai < 2; ++ai)
#pragma unroll
            for (int m = 0; m < 4; ++m) { bf16* rowp = O + (size_t)(row0 + ai * HALF + m * 16) * ldc + col0;
#pragma unroll
                for (int bj = 0; bj < 2; ++bj) { const f32x4 v0 = acc[ai][bj][m][0] + bv[bj][0], v1 = acc[ai][bj][m][1] + bv[bj][1];
                    u32x4 w; w.x = cvt_pk_bf16(v0[0], v0[1]); w.y = cvt_pk_bf16(v0[2], v0[3]); w.z = cvt_pk_bf16(v1[0], v1[1]); w.w = cvt_pk_bf16(v1[2], v1[3]);
                    *(u32x4*)(rowp + bj * HALF) = w; } }
    }
};
struct In {
    static constexpr bool PERM = false;
    bf16* Z; const f32x2* rope;
    __device__ __forceinline__ void operator()(const f32x4 (&acc)[2][2][4][2], const Unit& u, int wr, int wc, int fr, int fq) const {
        const int row0 = u.pm * BM + wr * 64 + fr; const int col0 = u.pn * BM + wc * 32 + 4 * fq;
        const bool isq = u.pn < 4, dorope = (u.pn <= 4) && (u.pm * BM < NLAT);
        const float sc = isq ? ATT_C2 : 1.0f;
#pragma unroll
        for (int ai = 0; ai < 2; ++ai)
#pragma unroll
            for (int m = 0; m < 4; ++m) { const int row = row0 + ai * HALF + m * 16; bf16* rowp = Z + (size_t)row * ZC + col0;
                f32x4 cs0 = {1.f, 0.f, 1.f, 0.f}, cs1 = {1.f, 0.f, 1.f, 0.f};
                if (dorope) { const int t = row & (SEQ - 1); const int pos = (wc & 1) ? (t & 63) : (t >> 6); const f32x4* rp = (const f32x4*)(rope + pos * 16 + 4 * fq); cs0 = rp[0]; cs1 = rp[1]; }
#pragma unroll
                for (int bj = 0; bj < 2; ++bj) { const f32x4 x1 = acc[ai][bj][m][0], x2 = acc[ai][bj][m][1];
                    f32x4 o1, o2;
                    o1[0] = x1[0] * cs0[0] - x2[0] * cs0[1]; o2[0] = x2[0] * cs0[0] + x1[0] * cs0[1];
                    o1[1] = x1[1] * cs0[2] - x2[1] * cs0[3]; o2[1] = x2[1] * cs0[2] + x1[1] * cs0[3];
                    o1[2] = x1[2] * cs1[0] - x2[2] * cs1[1]; o2[2] = x2[2] * cs1[0] + x1[2] * cs1[1];
                    o1[3] = x1[3] * cs1[2] - x2[3] * cs1[3]; o2[3] = x2[3] * cs1[2] + x1[3] * cs1[3];
                    o1 = o1 * sc; o2 = o2 * sc;
                    u32x2 w1, w2; w1.x = cvt_pk_bf16(o1[0], o1[1]); w1.y = cvt_pk_bf16(o1[2], o1[3]); w2.x = cvt_pk_bf16(o2[0], o2[1]); w2.y = cvt_pk_bf16(o2[2], o2[3]);
                    *(u32x2*)(rowp + bj * HALF) = w1; *(u32x2*)(rowp + bj * HALF + 16) = w2; }
                asm volatile("" ::: "memory"); }
    }
};
struct Merge {
    static constexpr bool PERM = true;
    bf16* Mg; const bf16* Y; const float* bm;
    __device__ __forceinline__ void operator()(const f32x4 (&acc)[2][2][4][2], const Unit& u, int wr, int wc, int fr, int fq) const {
        const int br = u.pn >> 2, pn = u.pn & 3;
        const int row0 = u.pm * BM + wr * 64 + fr; const int col0 = pn * BM + wc * 32 + 8 * fq;
        f32x4 bv[2][2];
#pragma unroll
        for (int bj = 0; bj < 2; ++bj)
#pragma unroll
            for (int n = 0; n < 2; ++n) bv[bj][n] = *(const f32x4*)(bm + br * 1024 + col0 + bj * HALF + 4 * n);
#pragma unroll
        for (int ai = 0; ai < 2; ++ai)
#pragma unroll
            for (int m = 0; m < 4; ++m) { const size_t row = (size_t)(row0 + ai * HALF + m * 16);
#pragma unroll
                for (int bj = 0; bj < 2; ++bj) { const int col = col0 + bj * HALF;
                    const u32x4 yv = *(const u32x4*)(Y + row * 3072 + br * 1024 + col);
                    u32x4 mv = {0u, 0u, 0u, 0u}; if (br) mv = *(const u32x4*)(Mg + row * 1024 + col);
                    float o[8];
#pragma unroll
                    for (int e = 0; e < 8; ++e) { const float a = acc[ai][bj][m][e >> 2][e & 3] + bv[bj][e >> 2][e & 3];
                        const unsigned yw = yv[e >> 1], mw = mv[e >> 1];
                        const float y = (e & 1) ? bf2f(yw >> 16) : bf2f(yw & 0xffffu), mm = (e & 1) ? bf2f(mw >> 16) : bf2f(mw & 0xffffu);
                        o[e] = mm + sigmoidf_(a) * y; }
                    u32x4 w; w.x = cvt_pk_bf16(o[0], o[1]); w.y = cvt_pk_bf16(o[2], o[3]); w.z = cvt_pk_bf16(o[4], o[5]); w.w = cvt_pk_bf16(o[6], o[7]);
                    *(u32x4*)(Mg + row * 1024 + col) = w; } }
    }
};
struct Out {
    static constexpr bool PERM = true;
    float* P; const float* xlat; const float* xctx; const float* mods;
    __device__ __forceinline__ void operator()(const f32x4 (&acc)[2][2][4][2], const Unit& u, int wr, int wc, int fr, int fq) const {
        const int row0 = u.pm * BM + wr * 64 + fr; const int col0 = u.pn * BM + wc * 32 + 8 * fq;
        const int bb = (u.pm * BM < NLAT) ? (u.pm * BM) / SEQ : 8;
        const float* xb = (u.pm * BM < NLAT) ? xlat : (xctx - (size_t)NLAT * D);
        const float* g1 = mods + (size_t)(bb * 6 + 2) * D;
        f32x4 gv[2][2];
#pragma unroll
        for (int bj = 0; bj < 2; ++bj)
#pragma unroll
            for (int n = 0; n < 2; ++n) gv[bj][n] = *(const f32x4*)(g1 + col0 + bj * HALF + 4 * n);
#pragma unroll
        for (int ai = 0; ai < 2; ++ai)
#pragma unroll
            for (int m = 0; m < 4; ++m) { const size_t off = (size_t)(row0 + ai * HALF + m * 16) * D + col0;
#pragma unroll
                for (int bj = 0; bj < 2; ++bj)
#pragma unroll
                    for (int n = 0; n < 2; ++n) { const f32x4 xr = *(const f32x4*)(xb + off + bj * HALF + 4 * n);
                        *(f32x4*)(P + off + bj * HALF + 4 * n) = xr * DN_ALPHA + gv[bj][n] * acc[ai][bj][m][n]; } }
    }
};
template <bool OUT8> struct Swiglu {
    static constexpr bool PERM = true;
    bf16* ACT; const float* bgu; int f8_scale_w;
    __device__ __forceinline__ void operator()(const f32x4 (&acc)[2][2][4][2], const Unit& u, int wr, int wc, int fr, int fq) const {
        const int e = u.pn >> 3, pn = u.pn & 7;
        const int row0 = u.pm * BM + wr * 64 + fr; const int hc0 = wc * 32 + 8 * fq;
        const float* bg = bgu + e * 2048 + pn * 128 + hc0;
        f32x4 bgl[2], bln[2];
#pragma unroll
        for (int n = 0; n < 2; ++n) { bgl[n] = *(const f32x4*)(bg + 4 * n); bln[n] = *(const f32x4*)(bg + 1024 + 4 * n); }
#pragma unroll
        for (int ai = 0; ai < 2; ++ai)
#pragma unroll
            for (int m = 0; m < 4; ++m) { const size_t eoff = (size_t)(row0 + ai * HALF + m * 16) * DFF + pn * 128 + hc0;
                float o[8];
#pragma unroll
                for (int q = 0; q < 8; ++q) { float gl = acc[ai][0][m][q >> 2][q & 3] + bgl[q >> 2][q & 3], ln = acc[ai][1][m][q >> 2][q & 3] + bln[q >> 2][q & 3];
                    gl = fminf(gl, 7.0f); ln = fminf(fmaxf(ln, -7.0f), 7.0f);
                    o[q] = gl * sigmoidf_(1.702f * gl) * (ln + 1.0f); }
                if constexpr (OUT8) { unsigned w0 = 0u, w1 = 0u;
                    w0 = __builtin_amdgcn_cvt_pk_fp8_f32(o[0], o[1], w0, false); w0 = __builtin_amdgcn_cvt_pk_fp8_f32(o[2], o[3], w0, true);
                    w1 = __builtin_amdgcn_cvt_pk_fp8_f32(o[4], o[5], w1, false); w1 = __builtin_amdgcn_cvt_pk_fp8_f32(o[6], o[7], w1, true);
                    *(u32x2*)((unsigned char*)ACT + eoff) = (u32x2){w0, w1}; }
                else { u32x4 w; w.x = cvt_pk_bf16(o[0], o[1]); w.y = cvt_pk_bf16(o[2], o[3]); w.z = cvt_pk_bf16(o[4], o[5]); w.w = cvt_pk_bf16(o[6], o[7]);
                    *(u32x4*)(ACT + eoff) = w; } }
    }
};
}
#define XB_TMO      128
#define XB_XCNT(j)  (256  + 64 * (j))
#define XB_XSUB(j)  (1280 + 64 * (j))
#define XB_XGEN(j)  (2304 + 64 * (j))
#define XB_TOP      3328
#define XB_TOPGEN   3392
#define XCD_BAR_WORDS 3456
#define XB_SPIN_CAP (1u << 18)
__device__ __forceinline__ unsigned xb_ld(unsigned* p)              { return __hip_atomic_load(p, __ATOMIC_RELAXED, __HIP_MEMORY_SCOPE_AGENT); }
__device__ __forceinline__ unsigned xb_add(unsigned* p, unsigned v) { return __hip_atomic_fetch_add(p, v, __ATOMIC_RELAXED, __HIP_MEMORY_SCOPE_AGENT); }
__device__ __forceinline__ unsigned xb_xcc_id() { return (unsigned)__builtin_amdgcn_s_getreg((3 << 11) | 20) & 0xFu; }
#define XB_SPIN(cond, bar) do { unsigned _sp = 0; while (cond) { __builtin_amdgcn_s_sleep(1); \
    if ((++_sp & 255u) == 0u) { if (xb_ld(&(bar)[XB_TMO])) break; if (_sp > XB_SPIN_CAP) { atomicAdd(&(bar)[XB_TMO], 1u); break; } } } } while (0)
struct XcdBarrier { unsigned* bar; unsigned x; volatile LAS unsigned* st; };
__device__ __forceinline__ XcdBarrier xcd_barrier_post(unsigned* bar, volatile LAS unsigned* st) {
    XcdBarrier b; b.bar = bar; b.x = xb_xcc_id(); b.st = st;
    if (threadIdx.x == 0) (void)xb_add(&bar[XB_XCNT(b.x)], 1u);
    return b;
}
__device__ __forceinline__ void xcd_barrier_complete(unsigned* bar, unsigned x, unsigned& nloc, unsigned& nx) {
    const unsigned G = gridDim.x * gridDim.y * gridDim.z;
    unsigned sum, cnt, mine, sp = 0u;
    for (;;) {
        sum = 0u; cnt = 0u; mine = 0u;
#pragma unroll
        for (unsigned j = 0; j < 16; ++j) { const unsigned c = xb_ld(&bar[XB_XCNT(j)]); sum += c; cnt += (c > 0u) ? 1u : 0u; mine = (j == x) ? c : mine; }
        if (sum == G) break;
        __builtin_amdgcn_s_sleep(1);
        if ((++sp & 255u) == 0u) { if (xb_ld(&bar[XB_TMO])) break; if (sp > XB_SPIN_CAP) { atomicAdd(&bar[XB_TMO], 1u); break; } }
    }
    nloc = mine > 0u ? mine : 1u; nx = cnt > 0u ? cnt : 1u;
}
__device__ __forceinline__ void xcd_barrier(const XcdBarrier& b) {
    asm volatile("s_waitcnt vmcnt(0)" ::: "memory");
    __syncthreads();
    if (threadIdx.x == 0) {
        unsigned* bar = b.bar;
        __builtin_amdgcn_s_waitcnt(0);
        unsigned nloc = b.st[0], nx = b.st[1];
        if (nloc == 0u) { xcd_barrier_complete(bar, b.x, nloc, nx); b.st[0] = nloc; b.st[1] = nx; }
        const unsigned old = xb_add(&bar[XB_XSUB(b.x)], 1u);
        const unsigned gen = old / nloc;
        if (old + 1u == (gen + 1u) * nloc) {
            __builtin_amdgcn_fence(__ATOMIC_RELEASE, "agent");
            asm volatile("s_waitcnt vmcnt(0)" ::: "memory");
            const unsigned og = xb_add(&bar[XB_TOP], 1u);
            const unsigned tg = og / nx;
            if (og + 1u == (tg + 1u) * nx) xb_add(&bar[XB_TOPGEN], 1u);
            else XB_SPIN(xb_ld(&bar[XB_TOPGEN]) == tg, bar);
            __builtin_amdgcn_fence(__ATOMIC_ACQUIRE, "agent");
            xb_add(&bar[XB_XGEN(b.x)], 1u);
            asm volatile("s_waitcnt vmcnt(0)" ::: "memory");
        } else {
            XB_SPIN(xb_ld(&bar[XB_XGEN(b.x)]) == gen, bar);
            __builtin_amdgcn_fence(__ATOMIC_ACQUIRE, "agent");
            asm volatile("s_waitcnt vmcnt(0)" ::: "memory");
        }
    }
    __syncthreads();
}
struct KArgs { const float* in[31]; float* out; unsigned char* ws; int ph_lo, ph_hi; };
typedef KArgs Ptrs;
__device__ __forceinline__ void tr_item(const float* W, int ldw, int k0, int n0, bf16* WT, int ldt, int dest_row0, LAS float* scr, int lane) {
#pragma unroll 8
    for (int i = 0; i < 32; ++i) { const int kk = 2 * i + (lane >> 5); scr[kk * 33 + (lane & 31)] = W[(size_t)(k0 + kk) * ldw + n0 + (lane & 31)]; }
    LDS_WAIT();
    const int c = lane & 7;
#pragma unroll
    for (int j = 0; j < 4; ++j) { const int n = (lane >> 3) + 8 * j; const LAS float* s = scr + (8 * c) * 33 + n;
        u32x4 o; o.x = pk2(s[0 * 33], s[1 * 33]); o.y = pk2(s[2 * 33], s[3 * 33]); o.z = pk2(s[4 * 33], s[5 * 33]); o.w = pk2(s[6 * 33], s[7 * 33]);
        *(u32x4*)(WT + (size_t)(dest_row0 + n) * ldt + k0 + 8 * c) = o; }
    LDS_WAIT();
}
__device__ __forceinline__ void tr_item8(const float* W, int ldw, int k0, int n0, unsigned char* WT8, int ldt, int dest_row0, float scale, LAS float* scr, int lane) {
#pragma unroll 8
    for (int i = 0; i < 32; ++i) { const int kk = 2 * i + (lane >> 5); scr[kk * 33 + (lane & 31)] = W[(size_t)(k0 + kk) * ldw + n0 + (lane & 31)] * scale; }
    LDS_WAIT();
    const int c = lane & 7;
#pragma unroll
    for (int j = 0; j < 4; ++j) { const int n = (lane >> 3) + 8 * j; const LAS float* s = scr + (8 * c) * 33 + n; unsigned w0 = 0u, w1 = 0u;
        w0 = __builtin_amdgcn_cvt_pk_fp8_f32(s[0 * 33], s[1 * 33], w0, false); w0 = __builtin_amdgcn_cvt_pk_fp8_f32(s[2 * 33], s[3 * 33], w0, true);
        w1 = __builtin_amdgcn_cvt_pk_fp8_f32(s[4 * 33], s[5 * 33], w1, false); w1 = __builtin_amdgcn_cvt_pk_fp8_f32(s[6 * 33], s[7 * 33], w1, true);
        *(u32x2*)(WT8 + (size_t)(dest_row0 + n) * ldt + k0 + 8 * c) = (u32x2){w0, w1}; }
    LDS_WAIT();
}
template <class PT> __device__ __forceinline__ void convert_moe(const PT& P, int l, ldsp lds, int gw, int NGW, int wave, int lane) {
    LAS float* scr = (LAS float*)(lds + 40960 + wave * 8448);
    const float* wgu = P.in[25] + (size_t)l * NEXP * 1024 * 2048; const float* wdn = P.in[27] + (size_t)l * NEXP * 1024 * 1024;
    bf16* WGU = (bf16*)(P.ws + WS_WGU); bf16* WDN = (bf16*)(P.ws + WS_WDN);
    constexpr int I_GU = 16 * 64, I_DN = 16 * 32, I_E = I_GU + I_DN;
    const bool f8 = (F8_LAYERS >> l) & 1u;
    for (int it = gw; it < NEXP * I_E; it += NGW) {
        const int e = it / I_E; int r = it - e * I_E;
        if (f8) {
            if (r < I_GU) { const int kb = r >> 6, nb = r & 63, n0 = nb * 32; const int half = n0 >> 10, pn = (n0 & 1023) >> 7, j0 = n0 & 127;
                tr_item8(wgu + (size_t)e * 1024 * 2048, 2048, kb * 64, n0, (unsigned char*)WGU, 1024, e * 2048 + 256 * pn + 128 * half + j0, (float)(1 << F8_WGU_SHIFT), scr, lane); }
            else { r -= I_GU; const int kb = r >> 5, nb = r & 31; tr_item8(wdn + (size_t)e * 1024 * 1024, 1024, kb * 64, nb * 32, (unsigned char*)WDN, 1024, e * 1024 + nb * 32, (float)(1 << F8_WDN_SHIFT), scr, lane); }
            continue; }
        if (r < I_GU) { const int kb = r >> 6, nb = r & 63, n0 = nb * 32; const int half = n0 >> 10, pn = (n0 & 1023) >> 7, j0 = n0 & 127;
            tr_item(wgu + (size_t)e * 1024 * 2048, 2048, kb * 64, n0, WGU, 1024, e * 2048 + 256 * pn + 128 * half + j0 - 0, scr, lane); }
        else { r -= I_GU; const int kb = r >> 5, nb = r & 31; tr_item(wdn + (size_t)e * 1024 * 1024, 1024, kb * 64, nb * 32, WDN, 1024, e * 1024 + nb * 32, scr, lane); }
    }
}

template <class PT> __device__ __forceinline__ void phase_pre_a(const PT& P, ldsp lds, int wg, int G, int g_wave) {
    const int tid = fresh_tid(), lane = tid & 63, wave = __builtin_amdgcn_readfirstlane(tid >> 6);
    const int gw = wg * NWAVES + wave, NGW = G * NWAVES, gt = wg * NTHR + tid, NT = G * NTHR;
    unsigned char* ws = P.ws;
    LAS float* sl = (LAS float*)lds;
    for (int i = tid; i < 9 * 1024; i += NTHR) { const int bb = i >> 10, d = i & 1023; const float c = (bb < 8) ? P.in[1][bb * 1024 + d] : P.in[3][d]; sl[i] = silu_(c); }
    __syncthreads();
    if (gw < 192) { const int l = gw / 96, jb = gw % 96, j = jb * 64 + lane; const float* wm = P.in[4] + (size_t)l * 1024 * 6144 + j;
        float acc[9];
#pragma unroll
        for (int b = 0; b < 9; ++b) acc[b] = 0.f;
        for (int d = 0; d < 1024; d += 4) { float w[4];
#pragma unroll
            for (int q = 0; q < 4; ++q) w[q] = wm[(size_t)(d + q) * 6144];
#pragma unroll
            for (int q = 0; q < 4; ++q)
#pragma unroll
                for (int b = 0; b < 9; ++b) acc[b] += sl[b * 1024 + d + q] * w[q]; }
        const float bmv = P.in[5][l * 6144 + j]; float* mo = (float*)(ws + WS_MODS) + (size_t)l * 9 * 6144 + j;
#pragma unroll
        for (int b = 0; b < 9; ++b) mo[b * 6144] = acc[b] + bmv; }
    { f32x2* rope = (f32x2*)(ws + WS_ROPE); for (int i = gt; i < 128 * 16; i += NT) { const int pos = i >> 4, k = i & 15; const float fr = powf(10000.0f, -(float)k / 16.0f); float s, c; sincosf((float)pos * fr, &s, &c); rope[i] = (f32x2){c, s}; }
      f32x2* tw = (f32x2*)(ws + WS_TW); for (int i = gt; i < 8192; i += NT) { float s, c; sincospif((float)i / 4096.0f, &s, &c); tw[i] = (f32x2){c, s}; }
      float* sp = (float*)(ws + WS_SP); for (int i = gt; i < 2 * 2 * 1024; i += NT) { const float lam = P.in[15][i]; sp[i] = log1pf(expf(-lam)); }
      bf16* fc = (bf16*)(ws + WS_FC); for (int i = gt; i < 512 * 256; i += NT) { const int r = i >> 8, c = i & 255, part = r >> 8, m = r & 255; float s, co; sincospif((float)((c * m) & 255) / 128.0f, &s, &co); fc[i] = (bf16)f2bf((part ? s : co) * 0.0625f); }
      bf16* f1 = (bf16*)(ws + WS_F1); for (int i = gt; i < 256 * 256; i += NT) { const int R = i >> 8, kk = i & 255, w = R >> 5, pq = (R >> 4) & 1, k1 = 16 * w + (R & 15), pin = kk >> 7, n1 = kk & 127;
          float s, co; sincospif((float)((n1 * k1) & 127) / 64.0f, &s, &co); const float v = pq == 0 ? (pin == 0 ? co : -s) : (pin == 0 ? s : co); f1[i] = (bf16)f2bf(v * 0.08838834764831845f); }
      bf16* f2 = (bf16*)(ws + WS_F2); for (int i = gt; i < 64 * 128; i += NT) { const int k2 = i >> 7, kk = i & 127, part = kk >> 6, n2 = kk & 63; float s, co; sincospif((float)((n2 * k2) & 63) / 32.0f, &s, &co); f2[i] = (bf16)f2bf((part ? -s : co) * 0.125f); }
      bf16* f3 = (bf16*)(ws + WS_F256); for (int i = gt; i < 256 * 512; i += NT) { const int k = i >> 9, kk = i & 511, part = kk >> 8, t = kk & 255; float s, co; sincospif((float)((k * t) & 255) / 128.0f, &s, &co); f3[i] = (bf16)f2bf((part ? -s : co) * 0.0625f); }
    }
    for (int l = 0; l < DEPTH; ++l) {
        unsigned char* wl = ws + WS_WSM + l * WSM_LAYER;
        const float* win = P.in[6] + (size_t)l * 1024 * IN_COLS;
        bf16* wxf = (bf16*)(wl + WSM_WXF); for (int i = gt; i < 1024 * 1024; i += NT) { const int d = i >> 10, c = i & 1023; wxf[i] = (bf16)f2bf(win[(size_t)d * IN_COLS + 3584 + c]); }
        bf16* wrh = (bf16*)(wl + WSM_WRH); bf16* wrl = (bf16*)(wl + WSM_WRL); const float* wr = P.in[23] + (size_t)l * 1024 * 32;
        for (int i = gt; i < 32 * 1024; i += NT) { const int e = i >> 10, k = i & 1023; const float v = wr[k * 32 + e]; const unsigned h = f2bf(v); wrh[i] = (bf16)h; wrl[i] = (bf16)f2bf(v - bf2f(h)); }
        bf16* wg = (bf16*)(wl + WSM_WG);
        for (int i = gt; i < 4 * 16 * 64 * 64; i += NT) { const int in_ = i & 63, out_ = (i >> 6) & 63, hb = (i >> 12) & 15, gm = i >> 16; const int dir = gm >> 1;
            const float* src = ((gm & 1) ? P.in[13] : P.in[11]) + (size_t)l * 2 * 16 * 4096 + (size_t)dir * 16 * 4096 + hb * 4096; wg[i] = (bf16)f2bf(src[in_ * 64 + out_]); }
    }
    LAS float* scr = (LAS float*)(lds + 40960 + wave * 8448);
    constexpr int I_IN = 16 * 112, I_SQ = 16 * 32, I_MG = 16 * 96, I_L = I_IN + 4 * I_SQ + I_MG;
    for (int it = gw; it < DEPTH * I_L; it += NGW) {
        const int l = it / I_L; int r = it - l * I_L; unsigned char* wl = ws + WS_WSM + l * WSM_LAYER;
        if (r < I_IN) { const int kb = r / 112, nb = r % 112, n0 = nb * 32; const int dr = n0 < 1536 ? n0 : (n0 < 2560 ? n0 + 1024 : n0 - 1024);
            tr_item(P.in[6] + (size_t)l * 1024 * IN_COLS, IN_COLS, kb * 64, n0, (bf16*)(wl + WSM_WIN), 1024, dr, scr, lane); continue; }
        r -= I_IN;
        if (r < 4 * I_SQ) { const int which = r / I_SQ; r -= which * I_SQ; const int kb = r >> 5, nb = r & 31;
            const float* src = (which == 0 ? P.in[8] : which == 1 ? P.in[16] : which == 2 ? P.in[17] : P.in[20]) + (size_t)l * 1024 * 1024;
            const size_t dst = which == 0 ? WSM_WOA : which == 1 ? WSM_WOR : which == 2 ? WSM_WOF : WSM_WOUT;
            tr_item(src, 1024, kb * 64, nb * 32, (bf16*)(wl + dst), 1024, nb * 32, scr, lane); continue; }
        r -= 4 * I_SQ;
        { const int kb = r / 96, nb = r % 96; tr_item(P.in[18] + (size_t)l * 1024 * 3072, 3072, kb * 64, nb * 32, (bf16*)(wl + WSM_WM), 1024, nb * 32, scr, lane); }
    }
    convert_moe(P, 0, lds, gw, NGW, wave, lane);
}

struct FoldStore {
    static constexpr bool PERM = true;
    bf16* O;
    __device__ __forceinline__ void operator()(const f32x4 (&acc)[2][2][4][2], const pg8::Unit& u, int wr, int wc, int fr, int fq) const {
        const int row0 = 3584 + u.pm * 1024 + (u.pn >> 2) * 256 + wr * 64 + fr; const int col0 = (u.pn & 3) * 256 + wc * 32 + 8 * fq;
#pragma unroll
        for (int ai = 0; ai < 2; ++ai)
#pragma unroll
            for (int m = 0; m < 4; ++m) { bf16* rowp = O + (size_t)(row0 + ai * 128 + m * 16) * 1024 + col0;
#pragma unroll
                for (int bj = 0; bj < 2; ++bj) { const f32x4 v0 = acc[ai][bj][m][0], v1 = acc[ai][bj][m][1];
                    u32x4 w; w.x = pg8::cvt_pk_bf16(v0[0], v0[1]); w.y = pg8::cvt_pk_bf16(v0[2], v0[3]); w.z = pg8::cvt_pk_bf16(v1[0], v1[1]); w.w = pg8::cvt_pk_bf16(v1[2], v1[3]);
                    *(u32x4*)(rowp + bj * 128) = w; } }
    }
};
__device__ __forceinline__ void modulate_rows(const float* xlat, const float* xctx, const float* mods  , bf16* U, int nrow, int gw, int NGW, int lane) {
    for (int r = gw; r < nrow; r += NGW) {
        const bool lat = r < NLAT; const float* xr = lat ? xlat + (size_t)r * D : xctx + (size_t)(r - NLAT) * D; const int bb = lat ? (r >> 13) : 8;
        const float* sh = mods + (size_t)(bb * 6 + 0) * D; const float* sc = mods + (size_t)(bb * 6 + 1) * D;
        u32x2* o = (u32x2*)(U + (size_t)r * D);
#pragma unroll
        for (int j = 0; j < 4; ++j) { const int c = 4 * lane + 256 * j; const f32x4 v = *(const f32x4*)(xr + c), s = *(const f32x4*)(sc + c), h = *(const f32x4*)(sh + c);
            const f32x4 uu = v * (s + 1.0f) + h; u32x2 w; w.x = pk2(uu[0], uu[1]); w.y = pk2(uu[2], uu[3]); o[lane + 64 * j] = w; }
    }
}
namespace att {
__device__ __forceinline__ int crow(int r, int hi) { return (r & 3) + 8 * (r >> 2) + 4 * hi; }
__device__ __forceinline__ void attn_unit(ldsp lds, bf16* Z, const float* sink  , int qrow0, int g, int nloc, int krow_loc0, int jlo, int krow_ctx0, int tid, bf16* Ob, int opitch) {
    const int lane = tid & 63, r32 = lane & 31, hi = lane >> 5; const int wid = __builtin_amdgcn_readfirstlane(tid >> 6);
    const int hh = wid >> 1, ts = wid & 1, head = 4 * g + hh;
    const int nt = nloc + 4;
    LAS float* wsf = (LAS float*)(lds + 32768) + wid * 64;
    const int krow_l = lane, kch = wid;
    const int vrow_l = 16 * (wid & 3) + (lane >> 2), vdh = wid >> 2, vch = lane & 3;
    const unsigned kdst = (unsigned)(kch * 1024 + krow_l * 16), vdst = (unsigned)(16384 + vdh * 4096 + vrow_l * 64 + vch * 16);
#define TILE_ROW(t) ((t) < nloc ? krow_loc0 + 64 * (t) : krow_ctx0 + 64 * ((t) - nloc))
    bf16x8 qr[4];
    { const bf16* Qw = Z + (size_t)(qrow0 + 32 * ts + r32) * ZC + ZQ + head * 64;
#pragma unroll
      for (int d0 = 0; d0 < 4; ++d0) qr[d0] = *(const bf16x8*)(Qw + d0 * 16 + hi * 8); }
    u32x4 kreg, vreg;
    { const int tr = TILE_ROW(0); kreg = *(const u32x4*)(Z + (size_t)(tr + krow_l) * ZC + ZK + g * 64 + kch * 8); vreg = *(const u32x4*)(Z + (size_t)(tr + vrow_l) * ZC + ZV + g * 64 + vdh * 32 + vch * 8); }
    *(LAS u32x4*)(lds + kdst) = kreg; *(LAS u32x4*)(lds + vdst) = vreg;
    float m_run = sink[head] * 1.4426950408889634f, l_run = 1.0f;
    f32x16 o[2]; o[0] = f32x16{}; o[1] = f32x16{};
    __syncthreads();
    for (int t = 0; t < nt; ++t) {
        const unsigned boff = (unsigned)(t & 1) * 8192u;
        if (t + 1 < nt) { const int tr = TILE_ROW(t + 1); kreg = *(const u32x4*)(Z + (size_t)(tr + krow_l) * ZC + ZK + g * 64 + kch * 8); vreg = *(const u32x4*)(Z + (size_t)(tr + vrow_l) * ZC + ZV + g * 64 + vdh * 32 + vch * 8); }
        f32x16 p0 = f32x16{}, p1 = f32x16{};
        { ldsp kb = lds + boff + hi * 1024 + r32 * 16;
#pragma unroll
          for (int d0 = 0; d0 < 4; ++d0) { const bf16x8 b0 = *(const LAS bf16x8*)(kb + d0 * 2048), b1 = *(const LAS bf16x8*)(kb + d0 * 2048 + 512);
              p0 = __builtin_amdgcn_mfma_f32_32x32x16_bf16(b0, qr[d0], p0, 0, 0, 0); p1 = __builtin_amdgcn_mfma_f32_32x32x16_bf16(b1, qr[d0], p1, 0, 0, 0); } }
        if (t < nloc) { const int j = jlo + t; const int qi = 32 * ts + r32;
            if (j == 0) {
#pragma unroll
                for (int r = 0; r < 16; ++r) { const int kk = crow(r, hi); if (kk < qi) p0[r] = -INFINITY; if (kk + 32 < qi) p1[r] = -INFINITY; } }
            if (j == 4) {
#pragma unroll
                for (int r = 0; r < 16; ++r) { const int kk = crow(r, hi); if (kk > qi) p0[r] = -INFINITY; if (kk + 32 > qi) p1[r] = -INFINITY; } } }
        float rm = p0[0];
#pragma unroll
        for (int r = 1; r < 16; ++r) rm = fmaxf(rm, p0[r]);
#pragma unroll
        for (int r = 0; r < 16; ++r) rm = fmaxf(rm, p1[r]);
        rm = fmaxf(rm, __shfl_xor(rm, 32));
        const float mnew = fmaxf(m_run, rm), f = __builtin_amdgcn_exp2f(m_run - mnew); m_run = mnew;
        float s = 0.f;
#pragma unroll
        for (int r = 0; r < 16; ++r) { p0[r] = __builtin_amdgcn_exp2f(p0[r] - mnew); p1[r] = __builtin_amdgcn_exp2f(p1[r] - mnew); s += p0[r] + p1[r]; }
        s += __shfl_xor(s, 32);
        l_run = l_run * f + s;
        if (hi == 0) wsf[r32] = f;
        LDS_WAIT();
#pragma unroll
        for (int r = 0; r < 16; ++r) { const float fr_ = wsf[crow(r, hi)]; o[0][r] *= fr_; o[1][r] *= fr_; }
        u32x4 pw0, pw1, pw2, pw3;
        pw0 = (u32x4){pk2(p0[0], p0[1]), pk2(p0[2], p0[3]), pk2(p0[4], p0[5]), pk2(p0[6], p0[7])};
        pw1 = (u32x4){pk2(p0[8], p0[9]), pk2(p0[10], p0[11]), pk2(p0[12], p0[13]), pk2(p0[14], p0[15])};
        pw2 = (u32x4){pk2(p1[0], p1[1]), pk2(p1[2], p1[3]), pk2(p1[4], p1[5]), pk2(p1[6], p1[7])};
        pw3 = (u32x4){pk2(p1[8], p1[9]), pk2(p1[10], p1[11]), pk2(p1[12], p1[13]), pk2(p1[14], p1[15])};
        { const LAS unsigned char* vp = lds + 16384 + boff + ((lane >> 4) & 1) * 32 + (lane & 3) * 8 + (4 * hi + ((lane & 15) >> 2)) * 64;
#pragma unroll
          for (int d0 = 0; d0 < 2; ++d0) {
#pragma unroll
              for (int ks = 0; ks < 4; ++ks) {
                  const s16x4 lo = __builtin_bit_cast(s16x4, __builtin_amdgcn_ds_read_tr16_b64_v4i16((LAS s16x4*)(vp + d0 * 4096 + ks * 1024)));
                  const s16x4 hh_ = __builtin_bit_cast(s16x4, __builtin_amdgcn_ds_read_tr16_b64_v4i16((LAS s16x4*)(vp + d0 * 4096 + ks * 1024 + 512)));
                  const bf16x8 vf = (bf16x8){lo[0], lo[1], lo[2], lo[3], hh_[0], hh_[1], hh_[2], hh_[3]};
                  const u32x4 pw = ks == 0 ? pw0 : ks == 1 ? pw1 : ks == 2 ? pw2 : pw3;
                  o[d0] = __builtin_amdgcn_mfma_f32_32x32x16_bf16(__builtin_bit_cast(bf16x8, pw), vf, o[d0], 0, 0, 0); } } }
        if (t + 1 < nt) { *(LAS u32x4*)(lds + (boff ^ 8192u) + kdst) = kreg; *(LAS u32x4*)(lds + (boff ^ 8192u) + vdst) = vreg; }
        __syncthreads();
    }
#undef TILE_ROW
    if (hi == 0) wsf[32 + r32] = l_run;
    LDS_WAIT();
    bf16* Ow = Ob + (size_t)(qrow0 + 32 * ts) * opitch + head * 64;
#pragma unroll
    for (int r = 0; r < 16; ++r) { const int q = crow(r, hi); const float rl = __builtin_amdgcn_rcpf(wsf[32 + q]);
#pragma unroll
        for (int d0 = 0; d0 < 2; ++d0) Ow[(size_t)q * opitch + d0 * 32 + r32] = (bf16)f2bf(o[d0][r] * rl); }
    LDS_WAIT();
}
__device__ __forceinline__ void attn_phase(ldsp lds, bf16* Z, const float* sink, bool with_ctx, int wg, int G, int g_wave, bf16* Ob, int opitch) {
    const int tid = fresh_tid();
    const int nlat = NB * 4 * (SEQ / 64), nctx = with_ctx ? NB * 4 * (CTXL / 64) : 0;
    for (int u = wg; u < nlat + nctx; u += G) {
        if (u < nlat) { const int qb = u & 127, g = (u >> 7) & 3, b = u >> 9; const int qpos0 = qb * 64;
            const int jlo = qpos0 == 0 ? 2 : (qpos0 == 64 ? 1 : 0); const int jhi = qpos0 == SEQ - 64 ? 2 : (qpos0 == SEQ - 128 ? 3 : 4);
            attn_unit(lds, Z, sink, b * SEQ + qpos0, g, jhi - jlo + 1, b * SEQ + qpos0 - 128 + 64 * jlo, jlo, NLAT + b * CTXL, tid, Ob, opitch);
        } else { const int v = u - nlat; const int qb = v & 3, g = (v >> 2) & 3, b = v >> 4;
            attn_unit(lds, Z, sink, NLAT + b * CTXL + qb * 64, g, 0, 0, 0, NLAT + b * CTXL, tid, Ob, opitch); }
    }
}
}
namespace fft {
constexpr int RS = 144;
template <int K>
__device__ __forceinline__ void load_b(ldsp lds, const bf16* base, size_t rstride, size_t pstride, int tid) {
    constexpr int KH = K / 2;
#pragma unroll
    for (int i = 0; i < K / 64; ++i) { const int c = tid + NTHR * i, kk = c >> 3, ch = c & 7; const int part = kk / KH, n = kk % KH;
        const u32x4 v = *(const u32x4*)(base + (size_t)n * rstride + (size_t)part * pstride + ch * 8);
        *(LAS u32x4*)(lds + kk * RS + ch * 16) = v; }
}
template <int K, int MTW, int NTW>
__device__ __forceinline__ void mma(ldsp lds, const bf16* A, int mt0, int nt0, f32x4 (&acc)[MTW][NTW], int tid) {
    const int lane = tid & 63, fr = lane & 15, kq = lane >> 4;
#pragma unroll
    for (int i = 0; i < MTW; ++i)
#pragma unroll
        for (int j = 0; j < NTW; ++j) acc[i][j] = (f32x4){0.f, 0.f, 0.f, 0.f};
    const LAS unsigned char* bp = lds + (8 * kq + (fr >> 2)) * RS + (4 * (fr & 3)) * 2;
#pragma unroll 2
    for (int ks = 0; ks < K / 32; ++ks) {
        bf16x8 af[MTW];
#pragma unroll
        for (int i = 0; i < MTW; ++i) af[i] = *(const bf16x8*)(A + (size_t)(16 * (mt0 + i) + fr) * K + 32 * ks + 8 * kq);
#pragma unroll
        for (int j = 0; j < NTW; ++j) {
            const s16x4 lo = __builtin_bit_cast(s16x4, __builtin_amdgcn_ds_read_tr16_b64_v4i16((LAS s16x4*)(bp + (32 * ks) * RS + (nt0 + j) * 32)));
            const s16x4 hi = __builtin_bit_cast(s16x4, __builtin_amdgcn_ds_read_tr16_b64_v4i16((LAS s16x4*)(bp + (32 * ks + 4) * RS + (nt0 + j) * 32)));
            const bf16x8 bfrag = (bf16x8){lo[0], lo[1], lo[2], lo[3], hi[0], hi[1], hi[2], hi[3]};
#pragma unroll
            for (int i = 0; i < MTW; ++i) acc[i][j] = __builtin_amdgcn_mfma_f32_16x16x32_bf16(af[i], bfrag, acc[i][j], 0, 0, 0);
        }
    }
}
__device__ __forceinline__ void pass1_unit(ldsp lds, const bf16* Z, bf16* T, const bf16* F1, const f32x2* TW, int b, int n2, int ct, int tid) {
    const int lane = tid & 63, fr = lane & 15, kq = lane >> 4; const int w = __builtin_amdgcn_readfirstlane(tid >> 6);
    load_b<256>(lds, Z + (size_t)(b * SEQ + n2) * ZC + ZXC + ct * 64, (size_t)64 * ZC, 1024, tid);
    __syncthreads();
    f32x4 acc[2][4];
    mma<256, 2, 4>(lds, F1, 2 * w, 0, acc, tid);
    __syncthreads();
#pragma unroll
    for (int r = 0; r < 4; ++r) { const int k1 = 16 * w + 4 * kq + r; const f32x2 cs = TW[(n2 * k1) & 8191];
        bf16* o = T + (size_t)(b * SEQ + k1 * 64 + n2) * 2048 + ct * 64 + fr;
#pragma unroll
        for (int j = 0; j < 4; ++j) { const float p = acc[0][j][r], q = acc[1][j][r];
            o[16 * j] = (bf16)f2bf(p * cs.x - q * cs.y); o[1024 + 16 * j] = (bf16)f2bf(q * cs.x + p * cs.y); } }
}
__device__ __forceinline__ void pass2_unit(ldsp lds, bf16* Z, const bf16* T, const bf16* F2, int b, int k1, int ct, int tid) {
    const int lane = tid & 63, fr = lane & 15, kq = lane >> 4; const int w = __builtin_amdgcn_readfirstlane(tid >> 6);
    load_b<128>(lds, T + (size_t)(b * SEQ + k1 * 64) * 2048 + ct * 64, 2048, 1024, tid);
    __syncthreads();
    f32x4 acc[1][2];
    mma<128, 1, 2>(lds, F2, w >> 1, 2 * (w & 1), acc, tid);
    __syncthreads();
#pragma unroll
    for (int r = 0; r < 4; ++r) { const int k2 = 16 * (w >> 1) + 4 * kq + r;
        bf16* o = Z + (size_t)(b * SEQ + k1 + 128 * k2) * ZC + ZXC + ct * 64 + 32 * (w & 1) + fr;
#pragma unroll
        for (int j = 0; j < 2; ++j) o[16 * j] = (bf16)f2bf(acc[0][j][r]); }
}
__device__ __forceinline__ void ctx_unit(ldsp lds, bf16* Z, const bf16* F3, int b, int ct, int tid) {
    const int lane = tid & 63, fr = lane & 15, kq = lane >> 4; const int w = __builtin_amdgcn_readfirstlane(tid >> 6);
    load_b<512>(lds, Z + (size_t)(NLAT + b * CTXL) * ZC + ZXC + ct * 64, ZC, 1024, tid);
    __syncthreads();
    f32x4 acc[2][4];
    mma<512, 2, 4>(lds, F3, 2 * w, 0, acc, tid);
    __syncthreads();
#pragma unroll
    for (int i = 0; i < 2; ++i)
#pragma unroll
        for (int r = 0; r < 4; ++r) { const int k = 16 * (2 * w + i) + 4 * kq + r; bf16* o = Z + (size_t)(NLAT + b * CTXL + k) * ZC + ZXC + ct * 64 + fr;
#pragma unroll
            for (int j = 0; j < 4; ++j) o[16 * j] = (bf16)f2bf(acc[i][j][r]); }
}
__device__ __forceinline__ void pass1_phase(ldsp lds, bf16* Z, bf16* T, const unsigned char* ws, bool with_ctx, int wg, int G, int g_wave) {
    const bf16* F1 = (const bf16*)(ws + WS_F1); const bf16* F3 = (const bf16*)(ws + WS_F256); const f32x2* TW = (const f32x2*)(ws + WS_TW); const int tid = fresh_tid();
    for (int u = wg; u < NB * 64 * 16; u += G) { const int ct = u & 15, n2 = (u >> 4) & 63, b = u >> 10; pass1_unit(lds, Z, T, F1, TW, b, n2, ct, tid); }
    if (with_ctx) for (int u = wg; u < NB * 16; u += G) ctx_unit(lds, Z, F3, u >> 4, u & 15, tid);
}
__device__ __forceinline__ void pass2_phase(ldsp lds, bf16* Z, const bf16* T, const unsigned char* ws, int wg, int G, int g_wave) {
    const bf16* F2 = (const bf16*)(ws + WS_F2); const int tid = fresh_tid();
    for (int u = wg; u < NB * 128 * 16; u += G) { const int ct = u & 15, k1 = (u >> 4) & 127, b = u >> 11; pass2_unit(lds, Z, T, F2, b, k1, ct, tid); }
}
}
namespace rg {
constexpr int XRS = 144;
constexpr int WAVE_LDS = 68 * XRS;
struct Args {
    bf16* Z; const float* conv_w; const float* conv_b;
    const bf16* Wg;
    const float* b_a; const float* b_i; const float* sp;
    f32x2* SUM;
    const float* CARRY;
    bf16* Gout; int gpitch;
};
template <bool FINAL>
__device__ __forceinline__ void wave_unit(LAS unsigned char* xt, const LAS unsigned char* wgl, const LAS float* cst, const Args& A, int bb, int cid, int hb, int tid) {
    const int lane = tid & 63, fr = lane & 15, kq = lane >> 4;
    const bool isctx = cid < 4; const int rowbase = isctx ? NLAT + bb * CTXL : bb * SEQ, len = isctx ? CTXL : SEQ, t0 = isctx ? cid * 64 : (cid - 4) * 64;
#pragma unroll
    for (int i = 0; i < 9; ++i) { const int rr = i * 8 + (lane >> 3), ch = lane & 7, t = t0 - 2 + rr;
        u32x4 v = {0u, 0u, 0u, 0u};
        if (rr < 68 && t >= 0 && t < len) v = *(const u32x4*)(A.Z + (size_t)(rowbase + t) * ZC + ZXR + hb * 64 + ch * 8);
        if (rr < 68) *(LAS u32x4*)(xt + rr * XRS + ch * 16) = v; }
    LDS_WAIT();
    bf16x8 af[4][2];
#pragma unroll
    for (int ks = 0; ks < 2; ++ks) { const int c0 = 32 * ks + 8 * kq;
        float cw[4][8], cb[8];
#pragma unroll
        for (int tap = 0; tap < 4; ++tap) { const f32x4 a = *(const LAS f32x4*)(cst + tap * 64 + c0), b = *(const LAS f32x4*)(cst + tap * 64 + c0 + 4);
#pragma unroll
            for (int j = 0; j < 4; ++j) { cw[tap][j] = a[j]; cw[tap][4 + j] = b[j]; } }
        { const f32x4 a = *(const LAS f32x4*)(cst + 256 + c0), b = *(const LAS f32x4*)(cst + 256 + c0 + 4);
#pragma unroll
          for (int j = 0; j < 4; ++j) { cb[j] = a[j]; cb[4 + j] = b[j]; } }
#pragma unroll
        for (int mt = 0; mt < 4; ++mt) { float xc[8];
#pragma unroll
            for (int j = 0; j < 8; ++j) xc[j] = cb[j];
#pragma unroll
            for (int tap = 0; tap < 4; ++tap) { const u32x4 xv = *(const LAS u32x4*)(xt + (16 * mt + fr + tap) * XRS + (32 * ks + 8 * kq) * 2);
#pragma unroll
                for (int j = 0; j < 8; ++j) { const unsigned w = xv[j >> 1]; const float x = (j & 1) ? bf2f(w >> 16) : bf2f(w & 0xffffu); xc[j] += cw[tap][j] * x; } }
            u32x4 p; p.x = pg8::cvt_pk_bf16(xc[0], xc[1]); p.y = pg8::cvt_pk_bf16(xc[2], xc[3]); p.z = pg8::cvt_pk_bf16(xc[4], xc[5]); p.w = pg8::cvt_pk_bf16(xc[6], xc[7]);
            af[mt][ks] = __builtin_bit_cast(bf16x8, p); } }
    const int bsum = bb * NCHUNK + cid;
#pragma unroll 1
    for (int nt = 0; nt < 4; ++nt) {
        const int cch = hb * 64 + 16 * nt + fr;
        float xd[4][4];
        { float cwd[4];
#pragma unroll
          for (int tap = 0; tap < 4; ++tap) cwd[tap] = cst[tap * 64 + 16 * nt + fr];
          const float cbd = cst[256 + 16 * nt + fr];
#pragma unroll
          for (int mt = 0; mt < 4; ++mt) { float xs[7];
#pragma unroll
              for (int q = 0; q < 7; ++q) xs[q] = bf2f(*(const LAS unsigned short*)(xt + (16 * mt + 4 * kq + q) * XRS + (16 * nt + fr) * 2));
#pragma unroll
              for (int r = 0; r < 4; ++r) xd[mt][r] = cbd + cwd[0] * xs[r] + cwd[1] * xs[r + 1] + cwd[2] * xs[r + 2] + cwd[3] * xs[r + 3]; } }
        float hsum[4][4];
#pragma unroll
        for (int dir = 0; dir < 2; ++dir) {
            f32x4 g[2][4];
#pragma unroll
            for (int gi = 0; gi < 2; ++gi) { const int gm = 2 * dir + gi; bf16x8 bw[2];
#pragma unroll
                for (int ks = 0; ks < 2; ++ks) bw[ks] = *(const LAS bf16x8*)(wgl + (gm * 64 + 16 * nt + fr) * 144 + (32 * ks + 8 * kq) * 2);
#pragma unroll
                for (int mt = 0; mt < 4; ++mt) { f32x4 c = {0.f, 0.f, 0.f, 0.f};
                    c = __builtin_amdgcn_mfma_f32_16x16x32_bf16(af[mt][0], bw[0], c, 0, 0, 0); c = __builtin_amdgcn_mfma_f32_16x16x32_bf16(af[mt][1], bw[1], c, 0, 0, 0); g[gi][mt] = c; } }
            const float ba = cst[(5 + dir) * 64 + 16 * nt + fr], bi = cst[(7 + dir) * 64 + 16 * nt + fr], spv = cst[(9 + dir) * 64 + 16 * nt + fr];
            float carry = 0.f;
            if (FINAL) carry = A.CARRY[(((size_t)dir * NB + bb) * NCHUNK + cid) * 1024 + cch];
            float ptot = 1.f;
#pragma unroll
            for (int mi = 0; mi < 4; ++mi) { const int mt = dir == 0 ? mi : 3 - mi;
                float a[4], bv[4];
#pragma unroll
                for (int r = 0; r < 4; ++r) {
                    const float rr = __builtin_amdgcn_rcpf(1.0f + __builtin_amdgcn_exp2f(__builtin_fmaf(g[0][mt][r], -1.4426950408889634f, ba)));
                    const float ii = __builtin_amdgcn_rcpf(1.0f + __builtin_amdgcn_exp2f(__builtin_fmaf(g[1][mt][r], -1.4426950408889634f, bi)));
                    a[r] = __builtin_amdgcn_exp2f(-rr * spv);
                    const float om = __builtin_fmaf(-a[r], a[r], 1.0f);
                    bv[r] = __builtin_amdgcn_sqrtf(om) * ii * xd[mt][r]; }
                float s[4], p[4];
                if (dir == 0) { s[0] = bv[0]; p[0] = a[0];
#pragma unroll
                    for (int r = 1; r < 4; ++r) { s[r] = a[r] * s[r - 1] + bv[r]; p[r] = a[r] * p[r - 1]; } }
                else { s[3] = bv[3]; p[3] = a[3];
#pragma unroll
                    for (int r = 2; r >= 0; --r) { s[r] = a[r] * s[r + 1] + bv[r]; p[r] = a[r] * p[r + 1]; } }
                const float pe = dir == 0 ? p[3] : p[0], se = dir == 0 ? s[3] : s[0];
                float pa[4], sa[4];
#pragma unroll
                for (int q = 0; q < 4; ++q) { pa[q] = __shfl(pe, fr + 16 * q); sa[q] = __shfl(se, fr + 16 * q); }
                float cin = carry, mine = carry;
#pragma unroll
                for (int qi = 0; qi < 4; ++qi) { const int q = dir == 0 ? qi : 3 - qi; if (q == kq) mine = cin; cin = pa[q] * cin + sa[q]; ptot *= pa[q]; }
                carry = cin;
                if (FINAL) {
#pragma unroll
                    for (int r = 0; r < 4; ++r) { const float h = s[r] + p[r] * mine; hsum[mt][r] = dir == 0 ? h : hsum[mt][r] + h; } }
                __builtin_amdgcn_sched_barrier(0);
            }
            if (!FINAL) { if (kq == 0) A.SUM[(((size_t)dir * NB + bb) * NCHUNK + cid) * 1024 + cch] = (f32x2){ptot, carry}; }
        }
        if (FINAL) {
#pragma unroll
            for (int mt = 0; mt < 4; ++mt)
#pragma unroll
                for (int r = 0; r < 4; ++r) { const int t = t0 + 16 * mt + 4 * kq + r; const bf16* gp = A.Z + (size_t)(rowbase + t) * ZC + ZGR + cch;
                    const float gr = bf2f(*gp); A.Gout[(size_t)(rowbase + t) * A.gpitch + cch] = (bf16)f2bf(gelu_tanh(gr) * hsum[mt][r]); }
        }
    }
    (void)bsum;
    LDS_WAIT();
}
template <bool FINAL>
__device__ __forceinline__ void phase(ldsp lds, const Args& A, bool ctx_too, int wg, int G, int g_wave) {
    const int tid = fresh_tid(); const int wave = __builtin_amdgcn_readfirstlane(tid >> 6); LAS unsigned char* xt = lds + wave * WAVE_LDS;
    LAS unsigned char* wgl = lds + NWAVES * WAVE_LDS; LAS float* cst = (LAS float*)(lds + NWAVES * WAVE_LDS + 4 * 64 * 144);
    const int hb = wg & 15;
    for (int c = tid; c < 4 * 64 * 8; c += NTHR) { const int row = c >> 3, ch = c & 7, gm = row >> 6, o = row & 63;
        *(LAS u32x4*)(wgl + row * 144 + ch * 16) = *(const u32x4*)(A.Wg + ((size_t)((gm * 16 + hb) * 64 + o)) * 64 + ch * 8); }
    for (int c = tid; c < 11 * 64; c += NTHR) { const int k = c >> 6, ch = hb * 64 + (c & 63);
        cst[c] = k < 4 ? A.conv_w[k * 1024 + ch] : k == 4 ? A.conv_b[ch] : k < 7 ? -1.4426950408889634f * A.b_a[(k - 5) * 1024 + ch] : k < 9 ? -1.4426950408889634f * A.b_i[(k - 7) * 1024 + ch] : 8.0f * 1.4426950408889634f * A.sp[(k - 9) * 1024 + ch]; }
    __syncthreads();
    const int c_lo = ctx_too ? 0 : 4, nch = NCHUNK - c_lo, total = NB * nch;
    const int per = G >> 4;
    for (int u = (wg >> 4) * NWAVES + wave; u < total; u += per * NWAVES) { const int cid = c_lo + u % nch, bb = u / nch; wave_unit<FINAL>(xt, wgl, cst, A, bb, cid, hb, tid); }
    __syncthreads();
}
__device__ __forceinline__ void carry_phase(const f32x2* SUM, float* CARRY, int wg, int G, int g_wave) {
    const int tid = fresh_tid(); const int lane = tid & 63, wave = __builtin_amdgcn_readfirstlane(tid >> 6);
    for (int u = wg + G * wave; u < 2 * NB * 16; u += G * NWAVES) { const int cb = u & 15, bb = (u >> 4) & 7, dir = u >> 7;
        const f32x2* S = SUM + ((size_t)dir * NB + bb) * NCHUNK * 1024 + cb * 64 + lane; float* C = CARRY + ((size_t)dir * NB + bb) * NCHUNK * 1024 + cb * 64 + lane;
        float state = 0.f;
        for (int i0 = 0; i0 < NCHUNK; i0 += 12) { f32x2 v[12]; int id[12];
#pragma unroll
            for (int j = 0; j < 12; ++j) { const int i = i0 + j; id[j] = dir == 0 ? i : (i < 4 ? 3 - i : NCHUNK + 3 - i); v[j] = S[(size_t)id[j] * 1024]; }
#pragma unroll
            for (int j = 0; j < 12; ++j) { C[(size_t)id[j] * 1024] = state; state = v[j].x * state + v[j].y; } }
    }
}
}
namespace rowp {
struct LnArgs { bool f8; float* X1; bf16* U2; const float* lng; const float* lnb; const float* mods; const bf16* wrh; const bf16* wrl; const float* brt; int* asg_e; int* asg_p; float* asg_g; int* wgc; };
__device__ __forceinline__ void ln_router_phase(ldsp lds, const LnArgs& A, int nrow, int wg, int G, int g_wave) {
    const int tid = fresh_tid(), lane = tid & 63, fr = lane & 15, kq = lane >> 4; const int wave = __builtin_amdgcn_readfirstlane(tid >> 6);
    LAS int* cnt = (LAS int*)(lds + LM_CNT);
    if (tid < 32) cnt[tid] = 0;
    __syncthreads();
    constexpr int ARS = 2064;
    LAS float* part = (LAS float*)(lds + 66048); LAS float* lg = (LAS float*)(lds + 82432);
    const int ngrp = nrow / 16;
    for (int grp = wg; grp < ngrp; grp += G) {
#pragma unroll
        for (int rr = 0; rr < 2; ++rr) { const int lr = 2 * wave + rr, row = grp * 16 + lr; const int bb = row < NLAT ? (row >> 13) : 8;
            float* xp = A.X1 + (size_t)row * D; f32x4 v[4]; float s = 0.f;
#pragma unroll
            for (int j = 0; j < 4; ++j) { v[j] = *(const f32x4*)(xp + 4 * lane + 256 * j); s += (v[j][0] + v[j][1]) + (v[j][2] + v[j][3]); }
            const float mean = wave_sum(s) * (1.0f / D); float s2 = 0.f;
#pragma unroll
            for (int j = 0; j < 4; ++j) { v[j] = v[j] - mean; s2 += (v[j][0] * v[j][0] + v[j][1] * v[j][1]) + (v[j][2] * v[j][2] + v[j][3] * v[j][3]); }
            const float rstd = 1.0f / sqrtf(wave_sum(s2) * (1.0f / D) + LN_EPS);
            const float* sh = A.mods + (size_t)(bb * 6 + 3) * D; const float* sc = A.mods + (size_t)(bb * 6 + 4) * D;
#pragma unroll
            for (int j = 0; j < 4; ++j) { const int c = 4 * lane + 256 * j; const f32x4 gg = *(const f32x4*)(A.lng + c), bbv = *(const f32x4*)(A.lnb + c);
                const f32x4 x1 = v[j] * rstd * gg + bbv; *(f32x4*)(xp + c) = x1;
                const f32x4 u = x1 * (*(const f32x4*)(sc + c) + 1.0f) + *(const f32x4*)(sh + c);
                unsigned h[4], lo[4];
#pragma unroll
                for (int e = 0; e < 4; ++e) { h[e] = f2bf(u[e]); lo[e] = f2bf(u[e] - bf2f(h[e])); }
                const u32x2 hw = {h[0] | (h[1] << 16), h[2] | (h[3] << 16)}, lw = {lo[0] | (lo[1] << 16), lo[2] | (lo[3] << 16)};
                if (A.f8) { unsigned w8 = 0u; w8 = __builtin_amdgcn_cvt_pk_fp8_f32(u[0], u[1], w8, false); w8 = __builtin_amdgcn_cvt_pk_fp8_f32(u[2], u[3], w8, true); *(unsigned*)((unsigned char*)A.U2 + (size_t)row * D + c) = w8; }
                else *(u32x2*)(A.U2 + (size_t)row * D + c) = hw;
                *(LAS u32x2*)(lds + lr * ARS + c * 2) = hw; *(LAS u32x2*)(lds + 33024 + lr * ARS + c * 2) = lw; } }
        __syncthreads();
        { f32x4 acc[2] = {{0.f, 0.f, 0.f, 0.f}, {0.f, 0.f, 0.f, 0.f}};
#pragma unroll
          for (int ks = 0; ks < 4; ++ks) { const int k0 = 128 * wave + 32 * ks + 8 * kq;
              const bf16x8 ah = *(const LAS bf16x8*)(lds + fr * ARS + k0 * 2), al = *(const LAS bf16x8*)(lds + 33024 + fr * ARS + k0 * 2);
#pragma unroll
              for (int nt = 0; nt < 2; ++nt) { const bf16x8 bh = *(const bf16x8*)(A.wrh + (size_t)(16 * nt + fr) * D + k0), bl = *(const bf16x8*)(A.wrl + (size_t)(16 * nt + fr) * D + k0);
                  acc[nt] = __builtin_amdgcn_mfma_f32_16x16x32_bf16(ah, bh, acc[nt], 0, 0, 0);
                  acc[nt] = __builtin_amdgcn_mfma_f32_16x16x32_bf16(al, bh, acc[nt], 0, 0, 0);
                  acc[nt] = __builtin_amdgcn_mfma_f32_16x16x32_bf16(ah, bl, acc[nt], 0, 0, 0); } }
#pragma unroll
          for (int nt = 0; nt < 2; ++nt)
#pragma unroll
              for (int r = 0; r < 4; ++r) part[(wave * 16 + 4 * kq + r) * 32 + 16 * nt + fr] = acc[nt][r]; }
        __syncthreads();
        { const int row = tid >> 5, e = tid & 31; float s = A.brt[e];
#pragma unroll
          for (int w = 0; w < 8; ++w) s += part[(w * 16 + row) * 32 + e];
          lg[row * 32 + e] = s; }
        __syncthreads();
        if (tid < 16) { const int row = grp * 16 + tid; float v[32];
#pragma unroll
            for (int e = 0; e < 32; ++e) v[e] = lg[tid * 32 + e];
            int be[4]; float bv[4];
#pragma unroll
            for (int k = 0; k < 4; ++k) { float best = -INFINITY; int bi = 0;
#pragma unroll
                for (int e = 0; e < 32; ++e) { const bool taken = (k > 0 && be[0] == e) || (k > 1 && be[1] == e) || (k > 2 && be[2] == e); if (!taken && v[e] > best) { best = v[e]; bi = e; } }
                be[k] = bi; bv[k] = best; }
            float ex[4], se = 0.f;
#pragma unroll
            for (int k = 0; k < 4; ++k) { ex[k] = __expf(bv[k] - bv[0]); se += ex[k]; }
            const float inv = 1.0f / se;
#pragma unroll
            for (int k = 0; k < 4; ++k) { const int pos = __hip_atomic_fetch_add(&cnt[be[k]], 1, __ATOMIC_RELAXED, __HIP_MEMORY_SCOPE_WORKGROUP); A.asg_e[row * 4 + k] = be[k]; A.asg_p[row * 4 + k] = pos; A.asg_g[row * 4 + k] = ex[k] * inv; } }
        __syncthreads();
    }
    __syncthreads();
    if (tid < 32) A.wgc[wg * 32 + tid] = cnt[tid];
}
__device__ __forceinline__ void moe_tables(ldsp lds, const int* wgc, int wg, int G, int g_wave) {
    const int tid = fresh_tid();
    LAS int* pst = (LAS int*)(lds + LM_PST); LAS int* myb = (LAS int*)(lds + LM_MYB); LAS int* ntl = (LAS int*)(lds + LM_NT); LAS unsigned short* te = (LAS unsigned short*)(lds + LM_TE);
    LAS int* tmp = (LAS int*)lds;
    { const int e = tid & 31, p = tid >> 5; int tot = 0, below = 0;
#pragma unroll 1
      for (int w = p; w < G; w += 16) { const int c = wgc[w * 32 + e]; tot += c; if (w < wg) below += c; }
      tmp[p * 32 + e] = tot; tmp[512 + p * 32 + e] = below; }
    __syncthreads();
    if (tid < 32) { int tot = 0, below = 0;
#pragma unroll
        for (int p = 0; p < 16; ++p) { tot += tmp[p * 32 + tid]; below += tmp[512 + p * 32 + tid]; }
        myb[tid] = below; tmp[1024 + tid] = (tot + 255) & ~255; }
    __syncthreads();
    if (tid == 0) { int acc = 0;
#pragma unroll 1
        for (int e = 0; e < 32; ++e) { pst[e] = acc; const int nt_e = tmp[1024 + e] >> 8;
#pragma unroll 1
            for (int i = 0; i < nt_e; ++i) te[(acc >> 8) + i] = (unsigned short)e; acc += tmp[1024 + e]; } pst[32] = acc; ntl[0] = acc >> 8; }
    __syncthreads();
}
__device__ __forceinline__ void gather_phase(ldsp lds, bool f8, const bf16* U2, bf16* XS, const int* asg_e, const int* asg_p, int* asg_s, int nrow, int wg, int G, int g_wave) {
    const int tid = fresh_tid(), lane = tid & 63; const int wave = __builtin_amdgcn_readfirstlane(tid >> 6);
    const LAS int* pst = (const LAS int*)(lds + LM_PST); const LAS int* myb = (const LAS int*)(lds + LM_MYB);
    const int ngrp = nrow / 16;
    for (int grp = wg; grp < ngrp; grp += G) {
#pragma unroll
        for (int rr = 0; rr < 2; ++rr) { const int row = grp * 16 + 2 * wave + rr;
            if (f8) { const unsigned char* u8 = (const unsigned char*)U2; unsigned char* x8 = (unsigned char*)XS;
                const u32x4 v0 = *(const u32x4*)(u8 + (size_t)row * D + lane * 16);
#pragma unroll
                for (int k = 0; k < 4; ++k) { const int e = asg_e[row * 4 + k], slot = pst[e] + myb[e] + asg_p[row * 4 + k];
                    if (lane == 0) asg_s[row * 4 + k] = slot;
                    *(u32x4*)(x8 + (size_t)slot * D + lane * 16) = v0; } }
            else {
            const u32x4 v0 = *(const u32x4*)(U2 + (size_t)row * D + lane * 8), v1 = *(const u32x4*)(U2 + (size_t)row * D + 512 + lane * 8);
#pragma unroll
            for (int k = 0; k < 4; ++k) { const int e = asg_e[row * 4 + k], slot = pst[e] + myb[e] + asg_p[row * 4 + k];
                if (lane == 0) asg_s[row * 4 + k] = slot;
                *(u32x4*)(XS + (size_t)slot * D + lane * 8) = v0; *(u32x4*)(XS + (size_t)slot * D + 512 + lane * 8) = v1; } } }
    }
}
struct CombArgs { const float* X1; const bf16* YS; const int* asg_s; const float* asg_g; const float* mods; const float* lng; const float* lnb; float* out_lat; float* out_ctx; bf16* Unext; const float* mods_next; };
__device__ __forceinline__ void combine_phase(const CombArgs& A, int nrow, int gw, int NGW, int lane) {
    for (int row = gw; row < nrow; row += NGW) { const bool lat = row < NLAT; const int bb = lat ? (row >> 13) : 8;
        int sl[4]; float gt[4];
#pragma unroll
        for (int k = 0; k < 4; ++k) { sl[k] = A.asg_s[row * 4 + k]; gt[k] = A.asg_g[row * 4 + k]; }
        const float* g2 = A.mods + (size_t)(bb * 6 + 5) * D; f32x4 v[4]; float s = 0.f;
#pragma unroll
        for (int j = 0; j < 4; ++j) { const int c = 4 * lane + 256 * j; f32x4 f = {0.f, 0.f, 0.f, 0.f};
#pragma unroll
            for (int k = 0; k < 4; ++k) { const u32x2 y = *(const u32x2*)(A.YS + (size_t)sl[k] * D + c); f[0] += gt[k] * bf2f(y.x & 0xffffu); f[1] += gt[k] * bf2f(y.x >> 16); f[2] += gt[k] * bf2f(y.y & 0xffffu); f[3] += gt[k] * bf2f(y.y >> 16); }
            v[j] = *(const f32x4*)(A.X1 + (size_t)row * D + c) * DN_ALPHA + *(const f32x4*)(g2 + c) * f; s += (v[j][0] + v[j][1]) + (v[j][2] + v[j][3]); }
        const float mean = wave_sum(s) * (1.0f / D); float s2 = 0.f;
#pragma unroll
        for (int j = 0; j < 4; ++j) { v[j] = v[j] - mean; s2 += (v[j][0] * v[j][0] + v[j][1] * v[j][1]) + (v[j][2] * v[j][2] + v[j][3] * v[j][3]); }
        const float rstd = 1.0f / sqrtf(wave_sum(s2) * (1.0f / D) + LN_EPS);
        float* op = lat ? A.out_lat + (size_t)row * D : A.out_ctx + (size_t)(row - NLAT) * D;
        const float* sh = A.mods_next + (size_t)(bb * 6 + 0) * D; const float* sc = A.mods_next + (size_t)(bb * 6 + 1) * D;
#pragma unroll
        for (int j = 0; j < 4; ++j) { const int c = 4 * lane + 256 * j; const f32x4 x2 = v[j] * rstd * *(const f32x4*)(A.lng + c) + *(const f32x4*)(A.lnb + c);
            *(f32x4*)(op + c) = x2;
            if (A.Unext) { const f32x4 u = x2 * (*(const f32x4*)(sc + c) + 1.0f) + *(const f32x4*)(sh + c); u32x2 w; w.x = pk2(u[0], u[1]); w.y = pk2(u[2], u[3]); *(u32x2*)(A.Unext + (size_t)row * D + c) = w; } }
    }
}
}
constexpr int PH_PER_LAYER = 12, N_PHASES = 2 + DEPTH * PH_PER_LAYER;
static_assert(sizeof(KArgs) == 31 * 8 + 8 + 8 + 8, "no padding in the argument struct");
#ifndef PHMASK
#define PHMASK 0xffffffu
#endif
#ifndef SUBM
#define SUBM 7
#endif
#ifndef SUB3
#define SUB3 3
#endif
#ifndef REPMASK
#define REPMASK 0
#endif
#ifndef REP2
#define REP2 0
#endif
#ifndef REP3
#define REP3 0
#endif
#define NREP(slot) ((((REPMASK) >> (slot)) & 1) ? 2 : 1)
#define FORREP(n) for (int rep = 0; rep < (n); ++rep)
typedef const __attribute__((address_space(4))) KArgs CKArgs;
__device__ __forceinline__ CKArgs* fresh_args() { CKArgs* p = (CKArgs*)__builtin_amdgcn_kernarg_segment_ptr(); asm volatile("" : "+s"(p)); return p; }

__global__ void __launch_bounds__(NTHR, 2) mega(KArgs args) {
    extern __shared__ __attribute__((aligned(16))) unsigned char lds_raw[];
    const ldsp lds = (ldsp)lds_raw;
    const int G = gridDim.x, wg = blockIdx.x; const int g_wave = __builtin_amdgcn_readfirstlane((int)threadIdx.x >> 6);
    { const int tid0 = threadIdx.x; for (int u = tid0; u < (LDS_BYTES - RING_BYTES) / 4; u += NTHR) ((LAS unsigned*)(lds + RING_BYTES))[u] = 0u; }
    __syncthreads();
    const int lo = args.ph_lo, hi = args.ph_hi;
    XcdBarrier bar; bar.bar = (unsigned*)(args.ws + WS_CTL) + CW_BAR; bar.x = 0; bar.st = nullptr;
    if (hi - lo > 1) bar = xcd_barrier_post((unsigned*)(args.ws + WS_CTL) + CW_BAR, (volatile LAS unsigned*)(lds + LM_XB));
#define PHM(k) (((PHMASK) >> ((k) < 2 ? (k) : 2 + ((k) - 2) % PH_PER_LAYER)) & 1u)
#define IN(k) (PHM(k) && lo <= (k) && (k) < hi)
#define SEAM(k) do { if (lo <= (k) && (k) + 1 < hi) xcd_barrier(bar); } while (0)
#define ENTER() CKArgs& P = *fresh_args(); unsigned char* const ws = P.ws; (void)ws

    if (IN(0)) FORREP(NREP(0)) { ENTER(); phase_pre_a(P, lds, wg, G, g_wave); __syncthreads(); }
    SEAM(0);
    if (IN(1)) FORREP(NREP(1)) { ENTER();
#pragma unroll
        for (int l = 0; l < DEPTH; ++l) { unsigned char* wl = ws + WS_WSM + l * WSM_LAYER;
            pg8::Gemm g{(const bf16*)(ws + WS_FC), (const bf16*)(wl + WSM_WXF), 256, 1024, 256}; pg8::FoldOrder S{G, wg}; FoldStore E{(bf16*)(wl + WSM_WIN)};
            pg8::gemm_phase<FoldStore, pg8::FoldOrder>(lds, g, S, E, g_wave); }
        const int tid = fresh_tid(); modulate_rows(P.in[0], P.in[2], (const float*)(ws + WS_MODS), (bf16*)(ws + WS_U), NROW, wg * NWAVES + (tid >> 6), G * NWAVES, tid & 63);
    }
    SEAM(1);
#pragma unroll 1
    for (int l = 0; l < DEPTH; ++l) {
        const int pb = 2 + PH_PER_LAYER * l; const bool last = (l == DEPTH - 1);
        const int nrow = last ? NLAT : NROW;
#define WL(off) (ws + WS_WSM + (size_t)l * WSM_LAYER + (off))
#define MODS(ll) ((const float*)(ws + WS_MODS) + (size_t)(ll) * 9 * 6144)
        if (IN(pb + 0)) FORREP(NREP(2)) { ENTER(); pg8::Gemm g{(const bf16*)(ws + WS_U), (const bf16*)WL(WSM_WIN), 1024, 1024, 1024}; pg8::StaticOrder S; S.init(NROW, ZC, G, wg); epi::In E{(bf16*)(ws + WS_Z), (const f32x2*)(ws + WS_ROPE)};
            pg8::gemm_phase<epi::In, pg8::StaticOrder>(lds, g, S, E, g_wave); }
        SEAM(pb + 0);
        if (IN(pb + 1)) {
            if (SUBM & 1) FORREP((REP2 & 1) ? 2 : 1) { ENTER(); rg::Args RA{(bf16*)(ws + WS_Z), P.in[9] + l * 4096, P.in[10] + l * 1024, (const bf16*)WL(WSM_WG), P.in[12] + l * 2048, P.in[14] + l * 2048, (const float*)(ws + WS_SP) + l * 2048, (f32x2*)(ws + WS_SUM), nullptr, nullptr, 0};
                rg::phase<false>(lds, RA, true, wg, G, g_wave); __syncthreads(); }
            if (SUBM & 2) FORREP((REP2 & 2) ? 2 : 1) { ENTER(); att::attn_phase(lds, (bf16*)(ws + WS_Z), P.in[7] + l * 16, !last, wg, G, g_wave, rep ? (bf16*)(ws + WS_Y) : (bf16*)(ws + WS_Z) + ZQ, rep ? 1024 : ZC); __syncthreads(); }
            if (SUBM & 4) FORREP((REP2 & 4) ? 2 : 1) { ENTER(); fft::pass1_phase(lds, (bf16*)(ws + WS_Z), (bf16*)(ws + WS_T), ws, !last, wg, G, g_wave); } }
        SEAM(pb + 1);
        if (IN(pb + 2)) { ENTER(); rg::carry_phase((const f32x2*)(ws + WS_SUM), (float*)(ws + WS_CARRY), wg, G, g_wave); }
        SEAM(pb + 2);
        if (IN(pb + 3)) {
            if (SUB3 & 1) FORREP((REP3 & 1) ? 2 : 1) { ENTER(); rg::Args RA{(bf16*)(ws + WS_Z), P.in[9] + l * 4096, P.in[10] + l * 1024, (const bf16*)WL(WSM_WG), P.in[12] + l * 2048, P.in[14] + l * 2048, (const float*)(ws + WS_SP) + l * 2048, (f32x2*)(ws + WS_SUM), (const float*)(ws + WS_CARRY),
                  rep ? (bf16*)(ws + WS_Y) : (bf16*)(ws + WS_Z) + ZGR, rep ? 1024 : ZC};
              rg::phase<true>(lds, RA, !last, wg, G, g_wave); __syncthreads(); }
            if (SUB3 & 2) FORREP((REP3 & 2) ? 2 : 1) { ENTER(); fft::pass2_phase(lds, (bf16*)(ws + WS_Z), (const bf16*)(ws + WS_T), ws, wg, G, g_wave); } }
        SEAM(pb + 3);
        if (IN(pb + 4)) FORREP(NREP(5)) {
            { ENTER(); pg8::Gemm g{(const bf16*)(ws + WS_Z) + ZQ, (const bf16*)WL(WSM_WOA), ZC, 1024, 1024}; pg8::StaticOrder S; S.init(nrow, 1024, G, wg); epi::Store E{(bf16*)(ws + WS_Y), 3072, nullptr, 0, 1024}; pg8::gemm_phase<epi::Store, pg8::StaticOrder>(lds, g, S, E, g_wave); }
            { ENTER(); pg8::Gemm g{(const bf16*)(ws + WS_Z) + ZGR, (const bf16*)WL(WSM_WOR), ZC, 1024, 1024}; pg8::StaticOrder S; S.init(nrow, 1024, G, wg); epi::Store E{(bf16*)(ws + WS_Y) + 1024, 3072, nullptr, 0, 1024}; pg8::gemm_phase<epi::Store, pg8::StaticOrder>(lds, g, S, E, g_wave); }
            { ENTER(); pg8::Gemm g{(const bf16*)(ws + WS_Z) + ZXC, (const bf16*)WL(WSM_WOF), ZC, 1024, 1024}; pg8::StaticOrder S; S.init(nrow, 1024, G, wg); epi::Store E{(bf16*)(ws + WS_Y) + 2048, 3072, nullptr, 0, 1024}; pg8::gemm_phase<epi::Store, pg8::StaticOrder>(lds, g, S, E, g_wave); }
        }
        SEAM(pb + 4);
        if (IN(pb + 5)) FORREP(NREP(6)) { ENTER(); pg8::Gemm g{(const bf16*)(ws + WS_U), (const bf16*)WL(WSM_WM), 1024, 1024, 1024}; pg8::MergeOrder S; S.init(nrow, G, wg); epi::Merge E{(bf16*)(ws + WS_M), (const bf16*)(ws + WS_Y), P.in[19] + l * 3072};
            pg8::gemm_phase<epi::Merge, pg8::MergeOrder>(lds, g, S, E, g_wave); }
        SEAM(pb + 5);
        if (IN(pb + 6)) FORREP(NREP(7)) { ENTER(); pg8::Gemm g{(const bf16*)(ws + WS_M), (const bf16*)WL(WSM_WOUT), 1024, 1024, 1024}; pg8::StaticOrder S; S.init(nrow, 1024, G, wg);
            epi::Out E{(float*)(ws + WS_T), l == 0 ? P.in[0] : (const float*)P.out, l == 0 ? P.in[2] : (const float*)(ws + WS_X2C), MODS(l)};
            pg8::gemm_phase<epi::Out, pg8::StaticOrder>(lds, g, S, E, g_wave); }
        SEAM(pb + 6);
        if (IN(pb + 7)) { ENTER(); rowp::LnArgs A{(bool)((F8_LAYERS >> l) & 1u), (float*)(ws + WS_T), (bf16*)(ws + WS_U), P.in[21] + l * 1024, P.in[22] + l * 1024, MODS(l), (const bf16*)WL(WSM_WRH), (const bf16*)WL(WSM_WRL), P.in[24] + l * 32,
                (int*)(ws + WS_ASGE), (int*)(ws + WS_ASGP), (float*)(ws + WS_ASGG), (int*)(ws + WS_WGC)};
            rowp::ln_router_phase(lds, A, nrow, wg, G, g_wave); }
        SEAM(pb + 7);
        if (IN(pb + 8)) FORREP(NREP(9)) { ENTER(); rowp::moe_tables(lds, (const int*)(ws + WS_WGC), wg, G, g_wave);
            rowp::gather_phase(lds, (bool)((F8_LAYERS >> l) & 1u), (const bf16*)(ws + WS_U), (bf16*)(ws + WS_Z), (const int*)(ws + WS_ASGE), (const int*)(ws + WS_ASGP), (int*)(ws + WS_ASGS), nrow, wg, G, g_wave); }
        SEAM(pb + 8);
        if (IN(pb + 9)) FORREP(NREP(10)) { ENTER(); if (!IN(pb + 8)) rowp::moe_tables(lds, (const int*)(ws + WS_WGC), wg, G, g_wave);
            pg8::MoeOrder<8> S{G, wg, __builtin_amdgcn_readfirstlane(*(const LAS int*)(lds + LM_NT)), (const LAS unsigned short*)(lds + LM_TE)};
            if ((F8_LAYERS >> l) & 1u) { pg8::Gemm g{(const bf16*)(ws + WS_Z), (const bf16*)(ws + WS_WGU), 512, 512, 512};
                epi::Swiglu<true> E{(bf16*)(ws + WS_Y), P.in[26] + (size_t)l * NEXP * 2048, 127 - F8_WGU_SHIFT}; pg8::gemm_phase<epi::Swiglu<true>, pg8::MoeOrder<8>, true>(lds, g, S, E, g_wave); }
            else { pg8::Gemm g{(const bf16*)(ws + WS_Z), (const bf16*)(ws + WS_WGU), 1024, 1024, 1024};
                epi::Swiglu<false> E{(bf16*)(ws + WS_Y), P.in[26] + (size_t)l * NEXP * 2048, 0}; pg8::gemm_phase<epi::Swiglu<false>, pg8::MoeOrder<8>, false>(lds, g, S, E, g_wave); } }
        SEAM(pb + 9);
        if (IN(pb + 10)) FORREP(NREP(11)) { ENTER(); if (!IN(pb + 9)) rowp::moe_tables(lds, (const int*)(ws + WS_WGC), wg, G, g_wave);
            pg8::MoeOrder<4> S{G, wg, __builtin_amdgcn_readfirstlane(*(const LAS int*)(lds + LM_NT)), (const LAS unsigned short*)(lds + LM_TE)};
            if ((F8_LAYERS >> l) & 1u) { pg8::Gemm g{(const bf16*)(ws + WS_Y), (const bf16*)(ws + WS_WDN), 512, 512, 512};
                epi::Store E{(bf16*)(ws + WS_Z), 1024, P.in[28] + (size_t)l * NEXP * 1024, 127 - F8_WDN_SHIFT, 1024}; pg8::gemm_phase<epi::Store, pg8::MoeOrder<4>, true>(lds, g, S, E, g_wave); }
            else { pg8::Gemm g{(const bf16*)(ws + WS_Y), (const bf16*)(ws + WS_WDN), 1024, 1024, 1024};
                epi::Store E{(bf16*)(ws + WS_Z), 1024, P.in[28] + (size_t)l * NEXP * 1024, 0, 1024}; pg8::gemm_phase<epi::Store, pg8::MoeOrder<4>, false>(lds, g, S, E, g_wave); } }
        SEAM(pb + 10);
        if (IN(pb + 11)) FORREP(NREP(12)) { ENTER(); const int tid = fresh_tid(); const int wave = __builtin_amdgcn_readfirstlane(tid >> 6);
            rowp::CombArgs A{(const float*)(ws + WS_T), (const bf16*)(ws + WS_Z), (const int*)(ws + WS_ASGS), (const float*)(ws + WS_ASGG), MODS(l), P.in[29] + l * 1024, P.in[30] + l * 1024, P.out, (float*)(ws + WS_X2C),
                last ? nullptr : (bf16*)(ws + WS_U), MODS(last ? l : l + 1)};
            rowp::combine_phase(A, nrow, wg * NWAVES + wave, G * NWAVES, tid & 63);
            if (!last) convert_moe(P, l + 1, lds, wg * NWAVES + wave, G * NWAVES, wave, tid & 63); }
        if (!last) SEAM(pb + 11);
    }
#undef IN
#undef SEAM
}

extern "C" void kernel_launch(void* const* d_in, const int* in_sizes, int n_in, void* d_out, int out_size, void* d_ws, size_t ws_size, hipStream_t stream) {
    static int grid = 0;
    if (grid == 0) {
        if (n_in != 31 || in_sizes[0] != NLAT * D || out_size != NLAT * D || ws_size < WS_END) { fprintf(stderr, "kernel_launch: unexpected shapes / workspace (n_in %d, ws %zu < %zu)\n", n_in, ws_size, (size_t)WS_END); grid = -1; return; }
        int dev = 0, cus = 0, per_cu = 0;
        if (hipGetDevice(&dev) != hipSuccess || hipDeviceGetAttribute(&cus, hipDeviceAttributeMultiprocessorCount, dev) != hipSuccess) { grid = -1; return; }
        if (hipFuncSetAttribute((const void*)mega, hipFuncAttributeMaxDynamicSharedMemorySize, LDS_BYTES) != hipSuccess) { fprintf(stderr, "kernel_launch: hipFuncSetAttribute failed\n"); grid = -1; return; }
        if (hipOccupancyMaxActiveBlocksPerMultiprocessor(&per_cu, (const void*)mega, NTHR, LDS_BYTES) != hipSuccess || per_cu < 1) fprintf(stderr, "kernel_launch: occupancy query says %d\n", per_cu);
        (void)hipGetLastError();
        grid = cus;
    }
    if (grid < 0) return;
    if (hipMemsetAsync((char*)d_ws + WS_CTL, 0, CTL_ZERO_BYTES, stream) != hipSuccess) return;
    KArgs a{};
    for (int i = 0; i < 31; ++i) a.in[i] = (const float*)d_in[i];
    a.out = (float*)d_out; a.ws = (unsigned char*)d_ws;
#if MK_SINGLE
    a.ph_lo = 0; a.ph_hi = N_PHASES;
    hipLaunchKernelGGL(mega, dim3(grid), dim3(NTHR), LDS_BYTES, stream, a);
#else
    for (int p = 0; p < N_PHASES; ++p) { a.ph_lo = p; a.ph_hi = p + 1; hipLaunchKernelGGL(mega, dim3(grid), dim3(NTHR), LDS_BYTES, stream, a); }
#endif
}
```

```cpp
#define F8_LAYERS 3u
#include <hip/hip_runtime.h>
#include <cstdio>
#include <cstdint>

#ifndef MK_SINGLE
#define MK_SINGLE 1
#endif

#define GAS __attribute__((address_space(1)))
#define LAS __attribute__((address_space(3)))
typedef unsigned short bf16;
typedef short bf16x8 __attribute__((ext_vector_type(8)));
typedef short s16x4 __attribute__((ext_vector_type(4)));
typedef float f32x2 __attribute__((ext_vector_type(2)));
typedef float f32x4 __attribute__((ext_vector_type(4)));
typedef float f32x16 __attribute__((ext_vector_type(16)));
typedef unsigned u32x2 __attribute__((ext_vector_type(2)));
typedef unsigned u32x4 __attribute__((ext_vector_type(4)));
typedef LAS unsigned char* ldsp;

constexpr int NB = 8, SEQ = 8192, D = 1024, CTXL = 256, DEPTH = 2;
constexpr int NLAT = NB * SEQ, NCTX = NB * CTXL, NROW = NLAT + NCTX;
constexpr int IN_COLS = 4608;
constexpr int ZC = 5632, ZQ = 0, ZK = 1024, ZV = 1280, ZGR = 1536, ZXR = 2560, ZXC = 3584, ZXS = 4608;
constexpr int NEXP = 32, TOPK = 4, DFF = 1024;
constexpr int NSLOT = 278528;
constexpr int NCHUNK = (SEQ + CTXL) / 64;
constexpr float LN_EPS = 1e-5f, DN_ALPHA = 1.41421356237309515f;
constexpr float ATT_C2 = 0.125f * 1.4426950408889634f;
constexpr int NWAVES = 8, NTHR = 512;
#ifndef F8_LAYERS
#define F8_LAYERS 2u
#endif
constexpr int F8_WGU_SHIFT = 6, F8_WDN_SHIFT = 7;
typedef int v8i __attribute__((ext_vector_type(8)));

constexpr size_t MiB = 1u << 20;
constexpr size_t WS_CTL = 0, CTL_ZERO_BYTES = 1 * MiB;
constexpr size_t WS_MODS = 1 * MiB;
constexpr size_t WS_ROPE = WS_MODS + 512 * 1024;
constexpr size_t WS_TW   = WS_ROPE + 16 * 1024;
constexpr size_t WS_SP   = WS_TW + 64 * 1024;
constexpr size_t WS_FC   = WS_SP + 16 * 1024;
constexpr size_t WS_F1   = WS_FC + 256 * 1024;
constexpr size_t WS_F2   = WS_F1 + 128 * 1024;
constexpr size_t WS_F256 = WS_F2 + 16 * 1024;
constexpr size_t WS_WGC  = WS_F256 + 256 * 1024;
constexpr size_t WS_ASGE = 3 * MiB;
constexpr size_t WS_ASGP = WS_ASGE + 2 * MiB;
constexpr size_t WS_ASGG = WS_ASGP + 2 * MiB;
constexpr size_t WS_ASGS = WS_ASGG + 2 * MiB;
constexpr size_t WS_SUM  = 12 * MiB;
constexpr size_t WS_X2C  = 30 * MiB;
constexpr size_t WS_CARRY = 1971 * MiB;
constexpr size_t WS_WSM  = 41 * MiB;
constexpr size_t WSM_LAYER = 32 * MiB;
constexpr size_t WSM_WIN = 0;
constexpr size_t WSM_WXF = 11 * MiB;
constexpr size_t WSM_WOA = 13 * MiB, WSM_WOR = 15 * MiB, WSM_WOF = 17 * MiB, WSM_WOUT = 19 * MiB;
constexpr size_t WSM_WM  = 21 * MiB;
constexpr size_t WSM_WRH = 27 * MiB, WSM_WRL = WSM_WRH + 64 * 1024;
constexpr size_t WSM_WG  = 28 * MiB;
constexpr size_t WS_WGU  = 105 * MiB;
constexpr size_t WS_WDN  = 233 * MiB;
constexpr size_t WS_U    = 297 * MiB;
constexpr size_t WS_T    = 429 * MiB;
constexpr size_t WS_Z    = 693 * MiB;
constexpr size_t WS_Y    = 1419 * MiB;
constexpr size_t WS_M    = WS_Y + 396 * MiB;
constexpr size_t WS_END  = 1980 * MiB;
static_assert((size_t)NROW * ZC * 2 <= 726 * MiB && (size_t)NSLOT * 1024 * 2 <= 544 * MiB && (size_t)NROW * 3072 * 2 <= 396 * MiB && (size_t)NROW * 2048 * 2 <= 264 * MiB, "ws map");
constexpr int CW_TMO = 0, CW_BAR = 4096;

constexpr int RING_BYTES = 131072;
constexpr int LM_XB = RING_BYTES;
constexpr int LM_CNT = RING_BYTES + 64;
constexpr int LM_PST = LM_CNT + 128;
constexpr int LM_MYB = LM_PST + 144;
constexpr int LM_NT  = LM_MYB + 128;
constexpr int LM_TE  = LM_NT + 16;
constexpr int LDS_BYTES = 147456;

#define LDS_WAIT() asm volatile("s_waitcnt lgkmcnt(0)" ::: "memory")
#define VM_WAIT() asm volatile("s_waitcnt vmcnt(0)" ::: "memory")
__device__ __forceinline__ unsigned f2bf(float f) { unsigned u = __builtin_bit_cast(unsigned, f); return (u + 0x7fffu + ((u >> 16) & 1u)) >> 16; }
__device__ __forceinline__ float bf2f(unsigned h) { return __builtin_bit_cast(float, h << 16); }
__device__ __forceinline__ unsigned pk2(float lo, float hi) { return f2bf(lo) | (f2bf(hi) << 16); }
__device__ __forceinline__ float wave_sum(float v) {
#pragma unroll
    for (int o = 1; o < 64; o <<= 1) v += __shfl_xor(v, o);
    return v;
}
__device__ __forceinline__ float sigmoidf_(float x) { return __builtin_amdgcn_rcpf(1.0f + __builtin_amdgcn_exp2f(-1.4426950408889634f * x)); }
__device__ __forceinline__ float gelu_tanh(float x) { const float u = 0.7978845608028654f * (x + 0.044715f * x * x * x); return x * sigmoidf_(2.0f * u); }
__device__ __forceinline__ float silu_(float x) { return x * sigmoidf_(x); }

__device__ __forceinline__ int fresh_tid_w(int wave_sgpr) { int w = wave_sgpr; asm volatile("" : "+s"(w)); int t = w * 64 + (int)__builtin_amdgcn_mbcnt_hi(~0u, __builtin_amdgcn_mbcnt_lo(~0u, 0u)); asm volatile("" : "+v"(t)); return t; }
#define fresh_tid() fresh_tid_w(g_wave)
namespace pg8 {
#define PG8_LAS __attribute__((address_space(3)))
typedef unsigned short bf16_t;
constexpr int BM = 256, BK = 64, HALF = 128, HTB = HALF * BK * 2, STAGE_BYTES = 8 * HTB, NXCD = 8, WGM = 8;
__host__ __device__ __forceinline__ int lds_byte(int r, int c) { const int st = (r >> 4) * 2 + (c >> 5), rr = r & 15, cc = c & 31, ob = rr * 64 + cc * 2; return st * 1024 + (ob ^ (((ob >> 9) & 1) << 5)); }
__host__ __device__ __forceinline__ void stage_rc(int b, int& R, int& C) { const int st = b / 1024, sb = b % 1024, swz = sb ^ (((sb >> 9) & 1) << 5); R = (st >> 1) * 16 + swz / 64; C = (st & 1) * 32 + (swz % 64) / 2; }
__host__ __device__ __forceinline__ int perm32(int rho) { const int n = rho >> 4, i = rho & 15; return 8 * (i >> 2) + 4 * n + (i & 3); }

struct Unit { int pm, pn; };
struct Gemm { const bf16_t* A; const bf16_t* Bt; int lda, ldb, K; };

struct StaticOrder {
    int nM, nN, nwg, G, c;
    __device__ void init(int M, int N, int G_, int c_) { nM = M / BM; nN = N / BM; nwg = nM * nN; G = G_; c = c_; }
    __device__ bool next(int i, Unit& u) const {
        const long L = (long)i * G + c; if (L >= nwg) return false;
        int wgid = (int)L; { const int q = nwg / NXCD, r = nwg % NXCD, xcd = wgid % NXCD, off = wgid / NXCD; wgid = (xcd < r ? xcd * (q + 1) : r * (q + 1) + (xcd - r) * q) + off; }
        const int nig = WGM * nN, gid = wgid / nig, fm = gid * WGM, gsz = (nM - fm) < WGM ? (nM - fm) : WGM;
        u.pm = fm + ((wgid % nig) % gsz); u.pn = (wgid % nig) / gsz; return true;
    }
    __device__ __forceinline__ const char* a_ptr(const Gemm& g, const Unit& u) const { return (const char*)g.A + (size_t)u.pm * BM * g.lda * 2; }
    __device__ __forceinline__ const char* b_ptr(const Gemm& g, const Unit& u) const { return (const char*)g.Bt + (size_t)u.pn * BM * g.ldb * 2; }
};
struct MergeOrder {
    StaticOrder s;
    __device__ void init(int M, int G_, int c_) { s.init(M, 1024, G_, c_); }
    __device__ bool next(int i, Unit& u) const { const int j = i / 3, br = i - 3 * j; Unit t; if (!s.next(j, t)) return false; u.pm = t.pm; u.pn = br * 4 + t.pn; return true; }
    __device__ __forceinline__ const char* a_ptr(const Gemm& g, const Unit& u) const { return (const char*)g.A + (size_t)u.pm * BM * g.lda * 2; }
    __device__ __forceinline__ const char* b_ptr(const Gemm& g, const Unit& u) const { return (const char*)g.Bt + (size_t)u.pn * BM * g.ldb * 2; }
};
struct FoldOrder {
    int G, c;
    __device__ bool next(int i, Unit& u) const { const int L = i * G + c; if (L >= 32) return false; u.pm = L & 1; u.pn = L >> 1; return true; }
    __device__ __forceinline__ const char* a_ptr(const Gemm& g, const Unit& u) const { return (const char*)g.A + (size_t)u.pm * BM * g.lda * 2; }
    __device__ __forceinline__ const char* b_ptr(const Gemm& g, const Unit& u) const { const int grp = u.pn >> 2, dn = u.pn & 3; return (const char*)g.Bt + ((size_t)dn * BM * g.ldb + grp * 256) * 2; }
};
template <int NPN> struct MoeOrder {
    int G, c, nt; const PG8_LAS unsigned short* te;
    __device__ bool next(int i, Unit& u) const { const int x = c & 7, slot = c >> 3, per = G >> 3; const int Lx = i * per + slot; const int rl = Lx / NPN, pn = Lx - rl * NPN, rt = rl * 8 + x;
        if (rt >= nt) return false; u.pm = rt; u.pn = __builtin_amdgcn_readfirstlane((int)te[rt]) * NPN + pn; return true; }
    __device__ __forceinline__ const char* a_ptr(const Gemm& g, const Unit& u) const { return (const char*)g.A + (size_t)u.pm * BM * g.lda * 2; }
    __device__ __forceinline__ const char* b_ptr(const Gemm& g, const Unit& u) const { return (const char*)g.Bt + (size_t)u.pn * BM * g.ldb * 2; }
};

typedef float f32x2_c __attribute__((ext_vector_type(2))); typedef __bf16 bf16x2_c __attribute__((ext_vector_type(2)));
__device__ __forceinline__ unsigned cvt_pk_bf16(float lo, float hi) { const f32x2_c v = {lo, hi}; const bf16x2_c b = __builtin_convertvector(v, bf16x2_c); return __builtin_bit_cast(unsigned, b); }

template <class Epi, class Sched, bool F8 = false>
__device__ __forceinline__ void gemm_phase(PG8_LAS unsigned char* lds, const Gemm g, const Sched& S, const Epi& E, int g_wave) {
    const int tid = fresh_tid(), wid = __builtin_amdgcn_readfirstlane(tid >> 6), lane = tid & 63, wr = wid >> 2, wc = wid & 3, fr = lane & 15, fq = lane >> 4;
    const int K = g.K, nt = K / BK;
    unsigned voffA[2], voffB[2];
#pragma unroll
    for (int i = 0; i < 2; ++i) { int R, C; stage_rc(tid * 16 + i * 8192, R, C); const int Rb = Epi::PERM ? ((R & ~31) + perm32(R & 31)) : R;
        voffA[i] = (unsigned)(R * g.lda + C) * 2u; voffB[i] = (unsigned)(Rb * g.ldb + C) * 2u; }
    const size_t kstep = (size_t)(BK * 2);
    const size_t hstepA = (size_t)HALF * g.lda * 2, hstepB = (size_t)HALF * g.ldb * 2;
    const unsigned ldsw = (unsigned)wid * 1024u; const unsigned ldsbase = (unsigned)(uintptr_t)lds;
    const int aoff = lds_byte(wr * 64 + fr, fq * 8), boff = lds_byte(wc * 32 + fr, fq * 8);
#define PG8_SA(b, h) (((b) * 2 + (h)) * HTB)
#define PG8_SB(b, h) ((4 + (b) * 2 + (h)) * HTB)
#define PG8_STAGE(bufoff, gbase, voff) do { _Pragma("unroll") for (int _i = 0; _i < 2; ++_i) { unsigned _keep; \
        asm volatile("s_mov_b32 %0, m0\n\ts_mov_b32 m0, %3\n\ts_nop 0\n\tglobal_load_lds_dwordx4 %1, %2\n\ts_mov_b32 m0, %0" : "=&s"(_keep) : "v"((voff)[_i]), "s"((const char*)(gbase)), \
                     "s"((unsigned)__builtin_amdgcn_readfirstlane((int)(ldsbase + (unsigned)(bufoff) + ldsw + _i * 8192))) : "memory"); } } while (0)
#define PG8_LDA(dst, b, h) do { _Pragma("unroll") for (int m = 0; m < 4; ++m) _Pragma("unroll") for (int k = 0; k < 2; ++k) dst[m][k] = *(const PG8_LAS bf16x8*)(lds + PG8_SA(b, h) + aoff + m * 2048 + k * 1024); } while (0)
#define PG8_LDB(dst, b, h) do { _Pragma("unroll") for (int n = 0; n < 2; ++n) _Pragma("unroll") for (int k = 0; k < 2; ++k) dst[n][k] = *(const PG8_LAS bf16x8*)(lds + PG8_SB(b, h) + boff + n * 2048 + k * 1024); } while (0)
#define PG8_MMA(ai, bj, At, Bt) do { __builtin_amdgcn_s_setprio(1); _Pragma("unroll") for (int m = 0; m < 4; ++m) _Pragma("unroll") for (int n = 0; n < 2; ++n) _Pragma("unroll") for (int k = 0; k < 2; ++k) \
        acc[ai][bj][m][n] = __builtin_amdgcn_mfma_f32_16x16x32_bf16(Bt[n][k], At[m][k], acc[ai][bj][m][n], 0, 0, 0); __builtin_amdgcn_s_setprio(0); } while (0)
#define PG8_CAT(x, y) __builtin_shufflevector(__builtin_bit_cast(u32x4, x), __builtin_bit_cast(u32x4, y), 0, 1, 2, 3, 4, 5, 6, 7)
#define PG8_MMA8(ai, bj, At, Bt) do { __builtin_amdgcn_s_setprio(1); _Pragma("unroll") for (int m = 0; m < 4; ++m) _Pragma("unroll") for (int n = 0; n < 2; ++n) { \
        const v8i _wa = __builtin_bit_cast(v8i, PG8_CAT(Bt[n][0], Bt[n][1])), _xa = __builtin_bit_cast(v8i, PG8_CAT(At[m][0], At[m][1])); \
        asm volatile("v_mfma_scale_f32_16x16x128_f8f6f4 %0, %1, %2, %0, %3, %4 op_sel_hi:[0,0,0]" : "+v"(acc[ai][bj][m][n]) : "v"(_wa), "v"(_xa), "v"(f8sw), "v"(f8s1)); } \
        __builtin_amdgcn_s_setprio(0); } while (0)
#define PG8_MM(ai, bj, At, Bt) do { if constexpr (F8) PG8_MMA8(ai, bj, At, Bt); else PG8_MMA(ai, bj, At, Bt); } while (0)
#define PG8_WAIT_V(n) asm volatile("s_waitcnt vmcnt(" #n ")" ::: "memory")
#define PG8_WAIT_L(n) asm volatile("s_waitcnt lgkmcnt(" #n ")" ::: "memory")
#define PG8_BAR __builtin_amdgcn_s_barrier()
#define PG8_SCHED __builtin_amdgcn_sched_barrier(0)
    Unit cur, nxt; int ui = 0;
    if (!S.next(0, cur)) return;
    f32x4 acc[2][2][4][2];
#pragma unroll
    for (int a = 0; a < 2; ++a)
#pragma unroll
        for (int b = 0; b < 2; ++b)
#pragma unroll
            for (int m = 0; m < 4; ++m)
#pragma unroll
                for (int n = 0; n < 2; ++n) { acc[a][b][m][n] = (f32x4){0.f, 0.f, 0.f, 0.f}; if constexpr (F8) asm volatile("" : "+v"(acc[a][b][m][n])); }
    bf16x8 At[4][2], B0[2][2], B1[2][2];
    int f8sw = 127, f8s1 = 127; if constexpr (F8) { f8sw = E.f8_scale_w; asm volatile("" : "+v"(f8sw), "+v"(f8s1)); }
    const char* cA = S.a_ptr(g, cur); const char* cB = S.b_ptr(g, cur);
    PG8_STAGE(PG8_SB(0, 0), cB, voffB); PG8_STAGE(PG8_SB(0, 1), cB + hstepB, voffB); PG8_STAGE(PG8_SA(0, 0), cA, voffA); PG8_STAGE(PG8_SA(0, 1), cA + hstepA, voffA);
    if (wr == 1) PG8_BAR;
    PG8_WAIT_V(2); PG8_BAR;
    PG8_STAGE(PG8_SB(1, 0), cB + kstep, voffB); PG8_STAGE(PG8_SA(1, 0), cA + kstep, voffA); PG8_STAGE(PG8_SB(1, 1), cB + hstepB + kstep, voffB);
    PG8_WAIT_V(6); PG8_BAR;
    for (;;) {
        const bool has_next = S.next(ui + 1, nxt);
        const char* nA = has_next ? S.a_ptr(g, nxt) : cA; const char* nB = has_next ? S.b_ptr(g, nxt) : cB;
#pragma unroll 1
        for (int t = 0; t < nt; t += 2) {
            const bool last = (t == nt - 2);
            const char* a1 = cA + (size_t)(t + 1) * kstep;
            const char* a2 = last ? nA : cA + (size_t)(t + 2) * kstep; const char* b2 = last ? nB : cB + (size_t)(t + 2) * kstep;
            const char* a3 = a2 + kstep; const char* b3 = b2 + kstep;
            PG8_LDB(B0, 0, 0); PG8_LDB(B1, 0, 1); PG8_SCHED; PG8_LDA(At, 0, 0); PG8_STAGE(PG8_SA(1, 1), a1 + hstepA, voffA);
            PG8_WAIT_V(8); PG8_WAIT_L(0); PG8_BAR; PG8_MM(0, 0, At, B0); PG8_MM(0, 1, At, B1); PG8_BAR; PG8_SCHED;
            PG8_LDA(At, 0, 1); PG8_STAGE(PG8_SB(0, 0), b2, voffB); PG8_STAGE(PG8_SB(0, 1), b2 + hstepB, voffB); PG8_STAGE(PG8_SA(0, 0), a2, voffA);
            PG8_WAIT_V(8); PG8_WAIT_L(0); PG8_BAR; PG8_MM(1, 0, At, B0); PG8_MM(1, 1, At, B1); PG8_BAR; PG8_SCHED;
            PG8_LDB(B0, 1, 0); PG8_LDB(B1, 1, 1); PG8_SCHED; PG8_LDA(At, 1, 0); PG8_STAGE(PG8_SA(0, 1), a2 + hstepA, voffA);
            PG8_WAIT_V(8); PG8_WAIT_L(0); PG8_BAR; PG8_MM(0, 0, At, B0); PG8_MM(0, 1, At, B1); PG8_BAR; PG8_SCHED;
            PG8_LDA(At, 1, 1); PG8_STAGE(PG8_SB(1, 0), b3, voffB); PG8_STAGE(PG8_SB(1, 1), b3 + hstepB, voffB); PG8_STAGE(PG8_SA(1, 0), a3, voffA);
            PG8_WAIT_V(8); PG8_WAIT_L(0); PG8_BAR; PG8_MM(1, 0, At, B0); PG8_MM(1, 1, At, B1); PG8_BAR; PG8_SCHED;
        }
        if (wr == 0) PG8_BAR;
        if constexpr (F8) {
#pragma unroll
            for (int a = 0; a < 2; ++a)
#pragma unroll
                for (int b = 0; b < 2; ++b) { if (a == 0 && b == 0) asm volatile("s_nop 15\n\ts_nop 3" : "+v"(acc[0][0][0][0]), "+v"(acc[0][0][0][1]), "+v"(acc[0][0][1][0]), "+v"(acc[0][0][1][1]), "+v"(acc[0][0][2][0]), "+v"(acc[0][0][2][1]), "+v"(acc[0][0][3][0]), "+v"(acc[0][0][3][1]));
                    else asm volatile("" : "+v"(acc[a][b][0][0]), "+v"(acc[a][b][0][1]), "+v"(acc[a][b][1][0]), "+v"(acc[a][b][1][1]), "+v"(acc[a][b][2][0]), "+v"(acc[a][b][2][1]), "+v"(acc[a][b][3][0]), "+v"(acc[a][b][3][1])); } }
        E(acc, cur, wr, wc, fr, fq);
        if (!has_next) break;
#pragma unroll
        for (int a = 0; a < 2; ++a)
#pragma unroll
            for (int b = 0; b < 2; ++b)
#pragma unroll
                for (int m = 0; m < 4; ++m)
#pragma unroll
                    for (int n = 0; n < 2; ++n) { acc[a][b][m][n] = (f32x4){0.f, 0.f, 0.f, 0.f}; if constexpr (F8) asm volatile("" : "+v"(acc[a][b][m][n])); }
        cur = nxt; cA = nA; cB = nB; ++ui;
        if (wr == 1) PG8_BAR;
    }
    PG8_WAIT_V(0);
    PG8_BAR;
#undef PG8_SA
#undef PG8_SB
#undef PG8_STAGE
#undef PG8_LDA
#undef PG8_LDB
#undef PG8_MMA
#undef PG8_MMA8
#undef PG8_MM
#undef PG8_CAT
#undef PG8_WAIT_V
#undef PG8_WAIT_L
#undef PG8_BAR
#undef PG8_SCHED
}
}
namespace epi {
using pg8::Unit; using pg8::cvt_pk_bf16; constexpr int HALF = 128, BM = 256;
struct Store {
    static constexpr bool PERM = true;
    bf16* O; int ldc; const float* bias;
    int f8_scale_w;
    int ncol_out;
    __device__ __forceinline__ void operator()(const f32x4 (&acc)[2][2][4][2], const Unit& u, int wr, int wc, int fr, int fq) const {
        const int row0 = u.pm * BM + wr * 64 + fr; const int gcol0 = u.pn * BM + wc * 32 + 8 * fq; const int col0 = gcol0 % ncol_out;
        f32x4 bv[2][2];
#pragma unroll
        for (int bj = 0; bj < 2; ++bj)
#pragma unroll
            for (int n = 0; n < 2; ++n) bv[bj][n] = bias ? *(const f32x4*)(bias + gcol0 + bj * HALF + 4 * n) : (f32x4){0.f, 0.f, 0.f, 0.f};
#pragma unroll
        for (int ai = 0; ai < 2; ++ai)
#pragma unroll
            for (int m = 0; m < 4; ++m) { bf16* rowp = O + (size_t)(row0 + ai * HALF + m * 16) * ldc + col0;
#pragma unroll
                for (int bj = 0; bj < 2; ++bj) { const f32x4 v0 = acc[ai][bj][m][0] + bv[bj][0], v1 = acc[ai][bj][m][1] + bv[bj][1];
                    u32x4 w; w.x = cvt_pk_bf16(v0[0], v0[1]); w.y = cvt_pk_bf16(v0[2], v0[3]); w.z = cvt_pk_bf16(v1[0], v1[1]); w.w = cvt_pk_bf16(v1[2], v1[3]);
                    *(u32x4*)(rowp + bj * HALF) = w; } }
    }
};
struct In {
    static constexpr bool PERM = false;
    bf16* Z; const f32x2* rope;
    __device__ __forceinline__ void operator()(const f32x4 (&acc)[2][2][4][2], const Unit& u, int wr, int wc, int fr, int fq) const {
        const int row0 = u.pm * BM + wr * 64 + fr; const int col0 = u.pn * BM + wc * 32 + 4 * fq;
        const bool isq = u.pn < 4, dorope = (u.pn <= 4) && (u.pm * BM < NLAT);
        const float sc = isq ? ATT_C2 : 1.0f;
#pragma unroll
        for (int ai = 0; ai < 2; ++ai)
#pragma unroll
            for (int m = 0; m < 4; ++m) { const int row = row0 + ai * HALF + m * 16; bf16* rowp = Z + (size_t)row * ZC + col0;
                f32x4 cs0 = {1.f, 0.f, 1.f, 0.f}, cs1 = {1.f, 0.f, 1.f, 0.f};
                if (dorope) { const int t = row & (SEQ - 1); const int pos = (wc & 1) ? (t & 63) : (t >> 6); const f32x4* rp = (const f32x4*)(rope + pos * 16 + 4 * fq); cs0 = rp[0]; cs1 = rp[1]; }
#pragma unroll
                for (int bj = 0; bj < 2; ++bj) { const f32x4 x1 = acc[ai][bj][m][0], x2 = acc[ai][bj][m][1];
                    f32x4 o1, o2;
                    o1[0] = x1[0] * cs0[0] - x2[0] * cs0[1]; o2[0] = x2[0] * cs0[0] + x1[0] * cs0[1];
                    o1[1] = x1[1] * cs0[2] - x2[1] * cs0[3]; o2[1] = x2[1] * cs0[2] + x1[1] * cs0[3];
                    o1[2] = x1[2] * cs1[0] - x2[2] * cs1[1]; o2[2] = x2[2] * cs1[0] + x1[2] * cs1[1];
                    o1[3] = x1[3] * cs1[2] - x2[3] * cs1[3]; o2[3] = x2[3] * cs1[2] + x1[3] * cs1[3];
                    o1 = o1 * sc; o2 = o2 * sc;
                    u32x2 w1, w2; w1.x = cvt_pk_bf16(o1[0], o1[1]); w1.y = cvt_pk_bf16(o1[2], o1[3]); w2.x = cvt_pk_bf16(o2[0], o2[1]); w2.y = cvt_pk_bf16(o2[2], o2[3]);
                    *(u32x2*)(rowp + bj * HALF) = w1; *(u32x2*)(rowp + bj * HALF + 16) = w2; }
                asm volatile("" ::: "memory"); }
    }
};
struct Merge {
    static constexpr bool PERM = true;
    bf16* Mg; const bf16* Y; const float* bm;
    __device__ __forceinline__ void operator()(const f32x4 (&acc)[2][2][4][2], const Unit& u, int wr, int wc, int fr, int fq) const {
        const int br = u.pn >> 2, pn = u.pn & 3;
        const int row0 = u.pm * BM + wr * 64 + fr; const int col0 = pn * BM + wc * 32 + 8 * fq;
        f32x4 bv[2][2];
#pragma unroll
        for (int bj = 0; bj < 2; ++bj)
#pragma unroll
            for (int n = 0; n < 2; ++n) bv[bj][n] = *(const f32x4*)(bm + br * 1024 + col0 + bj * HALF + 4 * n);
#pragma unroll
        for (int ai = 0; ai < 2; ++ai)
#pragma unroll
            for (int m = 0; m < 4; ++m) { const size_t row = (size_t)(row0 + ai * HALF + m * 16);
#pragma unroll
                for (int bj = 0; bj < 2; ++bj) { const int col = col0 + bj * HALF;
                    const u32x4 yv = *(const u32x4*)(Y + row * 3072 + br * 1024 + col);
                    u32x4 mv = {0u, 0u, 0u, 0u}; if (br) mv = *(const u32x4*)(Mg + row * 1024 + col);
                    float o[8];
#pragma unroll
                    for (int e = 0; e < 8; ++e) { const float a = acc[ai][bj][m][e >> 2][e & 3] + bv[bj][e >> 2][e & 3];
                        const unsigned yw = yv[e >> 1], mw = mv[e >> 1];
                        const float y = (e & 1) ? bf2f(yw >> 16) : bf2f(yw & 0xffffu), mm = (e & 1) ? bf2f(mw >> 16) : bf2f(mw & 0xffffu);
                        o[e] = mm + sigmoidf_(a) * y; }
                    u32x4 w; w.x = cvt_pk_bf16(o[0], o[1]); w.y = cvt_pk_bf16(o[2], o[3]); w.z = cvt_pk_bf16(o[4], o[5]); w.w = cvt_pk_bf16(o[6], o[7]);
                    *(u32x4*)(Mg + row * 1024 + col) = w; } }
    }
};
struct Out {
    static constexpr bool PERM = true;
    float* P; const float* xlat; const float* xctx; const float* mods;
    __device__ __forceinline__ void operator()(const f32x4 (&acc)[2][2][4][2], const Unit& u, int wr, int wc, int fr, int fq) const {
        const int row0 = u.pm * BM + wr * 64 + fr; const int col0 = u.pn * BM + wc * 32 + 8 * fq;
        const int bb = (u.pm * BM < NLAT) ? (u.pm * BM) / SEQ : 8;
        const float* xb = (u.pm * BM < NLAT) ? xlat : (xctx - (size_t)NLAT * D);
        const float* g1 = mods + (size_t)(bb * 6 + 2) * D;
        f32x4 gv[2][2];
#pragma unroll
        for (int bj = 0; bj < 2; ++bj)
#pragma unroll
            for (int n = 0; n < 2; ++n) gv[bj][n] = *(const f32x4*)(g1 + col0 + bj * HALF + 4 * n);
#pragma unroll
        for (int ai = 0; ai < 2; ++ai)
#pragma unroll
            for (int m = 0; m < 4; ++m) { const size_t off = (size_t)(row0 + ai * HALF + m * 16) * D + col0;
#pragma unroll
                for (int bj = 0; bj < 2; ++bj)
#pragma unroll
                    for (int n = 0; n < 2; ++n) { const f32x4 xr = *(const f32x4*)(xb + off + bj * HALF + 4 * n);
                        *(f32x4*)(P + off + bj * HALF + 4 * n) = xr * DN_ALPHA + gv[bj][n] * acc[ai][bj][m][n]; } }
    }
};
template <bool OUT8> struct Swiglu {
    static constexpr bool PERM = true;
    bf16* ACT; const float* bgu; int f8_scale_w;
    __device__ __forceinline__ void operator()(const f32x4 (&acc)[2][2][4][2], const Unit& u, int wr, int wc, int fr, int fq) const {
        const int e = u.pn >> 3, pn = u.pn & 7;
        const int row0 = u.pm * BM + wr * 64 + fr; const int hc0 = wc * 32 + 8 * fq;
        const float* bg = bgu + e * 2048 + pn * 128 + hc0;
        f32x4 bgl[2], bln[2];
#pragma unroll
        for (int n = 0; n < 2; ++n) { bgl[n] = *(const f32x4*)(bg + 4 * n); bln[n] = *(const f32x4*)(bg + 1024 + 4 * n); }
#pragma unroll
        for (int ai = 0; ai < 2; ++ai)
#pragma unroll
            for (int m = 0; m < 4; ++m) { const size_t eoff = (size_t)(row0 + ai * HALF + m * 16) * DFF + pn * 128 + hc0;
                float o[8];
#pragma unroll
                for (int q = 0; q < 8; ++q) { float gl = acc[ai][0][m][q >> 2][q & 3] + bgl[q >> 2][q & 3], ln = acc[ai][1][m][q >> 2][q & 3] + bln[q >> 2][q & 3];
                    gl = fminf(gl, 7.0f); ln = fminf(fmaxf(ln, -7.0f), 7.0f);
                    o[q] = gl * sigmoidf_(1.702f * gl) * (ln + 1.0f); }
                if constexpr (OUT8) { unsigned w0 = 0u, w1 = 0u;
                    w0 = __builtin_amdgcn_cvt_pk_fp8_f32(o[0], o[1], w0, false); w0 = __builtin_amdgcn_cvt_pk_fp8_f32(o[2], o[3], w0, true);
                    w1 = __builtin_amdgcn_cvt_pk_fp8_f32(o[4], o[5], w1, false); w1 = __builtin_amdgcn_cvt_pk_fp8_f32(o[6], o[7], w1, true);
                    *(u32x2*)((unsigned char*)ACT + eoff) = (u32x2){w0, w1}; }
                else { u32x4 w; w.x = cvt_pk_bf16(o[0], o[1]); w.y = cvt_pk_bf16(o[2], o[3]); w.z = cvt_pk_bf16(o[4], o[5]); w.w = cvt_pk_bf16(o[6], o[7]);
                    *(u32x4*)(ACT + eoff) = w; } }
    }
};
}
#define XB_TMO      128
#define XB_XCNT(j)  (256  + 64 * (j))
#define XB_XSUB(j)  (1280 + 64 * (j))
#define XB_XGEN(j)  (2304 + 64 * (j))
#define XB_TOP      3328
#define XB_TOPGEN   3392
#define XCD_BAR_WORDS 3456
#define XB_SPIN_CAP (1u << 18)
__device__ __forceinline__ unsigned xb_ld(unsigned* p)              { return __hip_atomic_load(p, __ATOMIC_RELAXED, __HIP_MEMORY_SCOPE_AGENT); }
__device__ __forceinline__ unsigned xb_add(unsigned* p, unsigned v) { return __hip_atomic_fetch_add(p, v, __ATOMIC_RELAXED, __HIP_MEMORY_SCOPE_AGENT); }
__device__ __forceinline__ unsigned xb_xcc_id() { return (unsigned)__builtin_amdgcn_s_getreg((3 << 11) | 20) & 0xFu; }
#define XB_SPIN(cond, bar) do { unsigned _sp = 0; while (cond) { __builtin_amdgcn_s_sleep(1); \
    if ((++_sp & 255u) == 0u) { if (xb_ld(&(bar)[XB_TMO])) break; if (_sp > XB_SPIN_CAP) { atomicAdd(&(bar)[XB_TMO], 1u); break; } } } } while (0)
struct XcdBarrier { unsigned* bar; unsigned x; volatile LAS unsigned* st; };
__device__ __forceinline__ XcdBarrier xcd_barrier_post(unsigned* bar, volatile LAS unsigned* st) {
    XcdBarrier b; b.bar = bar; b.x = xb_xcc_id(); b.st = st;
    if (threadIdx.x == 0) (void)xb_add(&bar[XB_XCNT(b.x)], 1u);
    return b;
}
__device__ __forceinline__ void xcd_barrier_complete(unsigned* bar, unsigned x, unsigned& nloc, unsigned& nx) {
    const unsigned G = gridDim.x * gridDim.y * gridDim.z;
    unsigned sum, cnt, mine, sp = 0u;
    for (;;) {
        sum = 0u; cnt = 0u; mine = 0u;
#pragma unroll
        for (unsigned j = 0; j < 16; ++j) { const unsigned c = xb_ld(&bar[XB_XCNT(j)]); sum += c; cnt += (c > 0u) ? 1u : 0u; mine = (j == x) ? c : mine; }
        if (sum == G) break;
        __builtin_amdgcn_s_sleep(1);
        if ((++sp & 255u) == 0u) { if (xb_ld(&bar[XB_TMO])) break; if (sp > XB_SPIN_CAP) { atomicAdd(&bar[XB_TMO], 1u); break; } }
    }
    nloc = mine > 0u ? mine : 1u; nx = cnt > 0u ? cnt : 1u;
}
__device__ __forceinline__ void xcd_barrier(const XcdBarrier& b) {
    asm volatile("s_waitcnt vmcnt(0)" ::: "memory");
    __syncthreads();
    if (threadIdx.x == 0) {
        unsigned* bar = b.bar;
        __builtin_amdgcn_s_waitcnt(0);
        unsigned nloc = b.st[0], nx = b.st[1];
        if (nloc == 0u) { xcd_barrier_complete(bar, b.x, nloc, nx); b.st[0] = nloc; b.st[1] = nx; }
        const unsigned old = xb_add(&bar[XB_XSUB(b.x)], 1u);
        const unsigned gen = old / nloc;
        if (old + 1u == (gen + 1u) * nloc) {
            __builtin_amdgcn_fence(__ATOMIC_RELEASE, "agent");
            asm volatile("s_waitcnt vmcnt(0)" ::: "memory");
            const unsigned og = xb_add(&bar[XB_TOP], 1u);
            const unsigned tg = og / nx;
            if (og + 1u == (tg + 1u) * nx) xb_add(&bar[XB_TOPGEN], 1u);
            else XB_SPIN(xb_ld(&bar[XB_TOPGEN]) == tg, bar);
            __builtin_amdgcn_fence(__ATOMIC_ACQUIRE, "agent");
            xb_add(&bar[XB_XGEN(b.x)], 1u);
            asm volatile("s_waitcnt vmcnt(0)" ::: "memory");
        } else {
            XB_SPIN(xb_ld(&bar[XB_XGEN(b.x)]) == gen, bar);
            __builtin_amdgcn_fence(__ATOMIC_ACQUIRE, "agent");
            asm volatile("s_waitcnt vmcnt(0)" ::: "memory");
        }
    }
    __syncthreads();
}
struct KArgs { const float* in[31]; float* out; unsigned char* ws; int ph_lo, ph_hi; };
typedef KArgs Ptrs;
__device__ __forceinline__ void tr_item(const float* W, int ldw, int k0, int n0, bf16* WT, int ldt, int dest_row0, LAS float* scr, int lane) {
#pragma unroll 8
    for (int i = 0; i < 32; ++i) { const int kk = 2 * i + (lane >> 5); scr[kk * 33 + (lane & 31)] = W[(size_t)(k0 + kk) * ldw + n0 + (lane & 31)]; }
    LDS_WAIT();
    const int c = lane & 7;
#pragma unroll
    for (int j = 0; j < 4; ++j) { const int n = (lane >> 3) + 8 * j; const LAS float* s = scr + (8 * c) * 33 + n;
        u32x4 o; o.x = pk2(s[0 * 33], s[1 * 33]); o.y = pk2(s[2 * 33], s[3 * 33]); o.z = pk2(s[4 * 33], s[5 * 33]); o.w = pk2(s[6 * 33], s[7 * 33]);
        *(u32x4*)(WT + (size_t)(dest_row0 + n) * ldt + k0 + 8 * c) = o; }
    LDS_WAIT();
}
__device__ __forceinline__ void tr_item8(const float* W, int ldw, int k0, int n0, unsigned char* WT8, int ldt, int dest_row0, float scale, LAS float* scr, int lane) {
#pragma unroll 8
    for (int i = 0; i < 32; ++i) { const int kk = 2 * i + (lane >> 5); scr[kk * 33 + (lane & 31)] = W[(size_t)(k0 + kk) * ldw + n0 + (lane & 31)] * scale; }
    LDS_WAIT();
    const int c = lane & 7;
#pragma unroll
    for (int j = 0; j < 4; ++j) { const int n = (lane >> 3) + 8 * j; const LAS float* s = scr + (8 * c) * 33 + n; unsigned w0 = 0u, w1 = 0u;
        w0 = __builtin_amdgcn_cvt_pk_fp8_f32(s[0 * 33], s[1 * 33], w0, false); w0 = __builtin_amdgcn_cvt_pk_fp8_f32(s[2 * 33], s[3 * 33], w0, true);
        w1 = __builtin_amdgcn_cvt_pk_fp8_f32(s[4 * 33], s[5 * 33], w1, false); w1 = __builtin_amdgcn_cvt_pk_fp8_f32(s[6 * 33], s[7 * 33], w1, true);
        *(u32x2*)(WT8 + (size_t)(dest_row0 + n) * ldt + k0 + 8 * c) = (u32x2){w0, w1}; }
    LDS_WAIT();
}
template <class PT> __device__ __forceinline__ void convert_moe(const PT& P, int l, ldsp lds, int gw, int NGW, int wave, int lane) {
    LAS float* scr = (LAS float*)(lds + 40960 + wave * 8448);
    const float* wgu = P.in[25] + (size_t)l * NEXP * 1024 * 2048; const float* wdn = P.in[27] + (size_t)l * NEXP * 1024 * 1024;
    bf16* WGU = (bf16*)(P.ws + WS_WGU); bf16* WDN = (bf16*)(P.ws + WS_WDN);
    constexpr int I_GU = 16 * 64, I_DN = 16 * 32, I_E = I_GU + I_DN;
    const bool f8 = (F8_LAYERS >> l) & 1u;
    for (int it = gw; it < NEXP * I_E; it += NGW) {
        const int e = it / I_E; int r = it - e * I_E;
        if (f8) {
            if (r < I_GU) { const int kb = r >> 6, nb = r & 63, n0 = nb * 32; const int half = n0 >> 10, pn = (n0 & 1023) >> 7, j0 = n0 & 127;
                tr_item8(wgu + (size_t)e * 1024 * 2048, 2048, kb * 64, n0, (unsigned char*)WGU, 1024, e * 2048 + 256 * pn + 128 * half + j0, (float)(1 << F8_WGU_SHIFT), scr, lane); }
            else { r -= I_GU; const int kb = r >> 5, nb = r & 31; tr_item8(wdn + (size_t)e * 1024 * 1024, 1024, kb * 64, nb * 32, (unsigned char*)WDN, 1024, e * 1024 + nb * 32, (float)(1 << F8_WDN_SHIFT), scr, lane); }
            continue; }
        if (r < I_GU) { const int kb = r >> 6, nb = r & 63, n0 = nb * 32; const int half = n0 >> 10, pn = (n0 & 1023) >> 7, j0 = n0 & 127;
            tr_item(wgu + (size_t)e * 1024 * 2048, 2048, kb * 64, n0, WGU, 1024, e * 2048 + 256 * pn + 128 * half + j0 - 0, scr, lane); }
        else { r -= I_GU; const int kb = r >> 5, nb = r & 31; tr_item(wdn + (size_t)e * 1024 * 1024, 1024, kb * 64, nb * 32, WDN, 1024, e * 1024 + nb * 32, scr, lane); }
    }
}

template <class PT> __device__ __forceinline__ void phase_pre_a(const PT& P, ldsp lds, int wg, int G, int g_wave) {
    const int tid = fresh_tid(), lane = tid & 63, wave = __builtin_amdgcn_readfirstlane(tid >> 6);
    const int gw = wg * NWAVES + wave, NGW = G * NWAVES, gt = wg * NTHR + tid, NT = G * NTHR;
    unsigned char* ws = P.ws;
    LAS float* sl = (LAS float*)lds;
    for (int i = tid; i < 9 * 1024; i += NTHR) { const int bb = i >> 10, d = i & 1023; const float c = (bb < 8) ? P.in[1][bb * 1024 + d] : P.in[3][d]; sl[i] = silu_(c); }
    __syncthreads();
    if (gw < 192) { const int l = gw / 96, jb = gw % 96, j = jb * 64 + lane; const float* wm = P.in[4] + (size_t)l * 1024 * 6144 + j;
        float acc[9];
#pragma unroll
        for (int b = 0; b < 9; ++b) acc[b] = 0.f;
        for (int d = 0; d < 1024; d += 4) { float w[4];
#pragma unroll
            for (int q = 0; q < 4; ++q) w[q] = wm[(size_t)(d + q) * 6144];
#pragma unroll
            for (int q = 0; q < 4; ++q)
#pragma unroll
                for (int b = 0; b < 9; ++b) acc[b] += sl[b * 1024 + d + q] * w[q]; }
        const float bmv = P.in[5][l * 6144 + j]; float* mo = (float*)(ws + WS_MODS) + (size_t)l * 9 * 6144 + j;
#pragma unroll
        for (int b = 0; b < 9; ++b) mo[b * 6144] = acc[b] + bmv; }
    { f32x2* rope = (f32x2*)(ws + WS_ROPE); for (int i = gt; i < 128 * 16; i += NT) { const int pos = i >> 4, k = i & 15; const float fr = powf(10000.0f, -(float)k / 16.0f); float s, c; sincosf((float)pos * fr, &s, &c); rope[i] = (f32x2){c, s}; }
      f32x2* tw = (f32x2*)(ws + WS_TW); for (int i = gt; i < 8192; i += NT) { float s, c; sincospif((float)i / 4096.0f, &s, &c); tw[i] = (f32x2){c, s}; }
      float* sp = (float*)(ws + WS_SP); for (int i = gt; i < 2 * 2 * 1024; i += NT) { const float lam = P.in[15][i]; sp[i] = log1pf(expf(-lam)); }
      bf16* fc = (bf16*)(ws + WS_FC); for (int i = gt; i < 512 * 256; i += NT) { const int r = i >> 8, c = i & 255, part = r >> 8, m = r & 255; float s, co; sincospif((float)((c * m) & 255) / 128.0f, &s, &co); fc[i] = (bf16)f2bf((part ? s : co) * 0.0625f); }
      bf16* f1 = (bf16*)(ws + WS_F1); for (int i = gt; i < 256 * 256; i += NT) { const int R = i >> 8, kk = i & 255, w = R >> 5, pq = (R >> 4) & 1, k1 = 16 * w + (R & 15), pin = kk >> 7, n1 = kk & 127;
          float s, co; sincospif((float)((n1 * k1) & 127) / 64.0f, &s, &co); const float v = pq == 0 ? (pin == 0 ? co : -s) : (pin == 0 ? s : co); f1[i] = (bf16)f2bf(v * 0.08838834764831845f); }
      bf16* f2 = (bf16*)(ws + WS_F2); for (int i = gt; i < 64 * 128; i += NT) { const int k2 = i >> 7, kk = i & 127, part = kk >> 6, n2 = kk & 63; float s, co; sincospif((float)((n2 * k2) & 63) / 32.0f, &s, &co); f2[i] = (bf16)f2bf((part ? -s : co) * 0.125f); }
      bf16* f3 = (bf16*)(ws + WS_F256); for (int i = gt; i < 256 * 512; i += NT) { const int k = i >> 9, kk = i & 511, part = kk >> 8, t = kk & 255; float s, co; sincospif((float)((k * t) & 255) / 128.0f, &s, &co); f3[i] = (bf16)f2bf((part ? -s : co) * 0.0625f); }
    }
    for (int l = 0; l < DEPTH; ++l) {
        unsigned char* wl = ws + WS_WSM + l * WSM_LAYER;
        const float* win = P.in[6] + (size_t)l * 1024 * IN_COLS;
        bf16* wxf = (bf16*)(wl + WSM_WXF); for (int i = gt; i < 1024 * 1024; i += NT) { const int d = i >> 10, c = i & 1023; wxf[i] = (bf16)f2bf(win[(size_t)d * IN_COLS + 3584 + c]); }
        bf16* wrh = (bf16*)(wl + WSM_WRH); bf16* wrl = (bf16*)(wl + WSM_WRL); const float* wr = P.in[23] + (size_t)l * 1024 * 32;
        for (int i = gt; i < 32 * 1024; i += NT) { const int e = i >> 10, k = i & 1023; const float v = wr[k * 32 + e]; const unsigned h = f2bf(v); wrh[i] = (bf16)h; wrl[i] = (bf16)f2bf(v - bf2f(h)); }
        bf16* wg = (bf16*)(wl + WSM_WG);
        for (int i = gt; i < 4 * 16 * 64 * 64; i += NT) { const int in_ = i & 63, out_ = (i >> 6) & 63, hb = (i >> 12) & 15, gm = i >> 16; const int dir = gm >> 1;
            const float* src = ((gm & 1) ? P.in[13] : P.in[11]) + (size_t)l * 2 * 16 * 4096 + (size_t)dir * 16 * 4096 + hb * 4096; wg[i] = (bf16)f2bf(src[in_ * 64 + out_]); }
    }
    LAS float* scr = (LAS float*)(lds + 40960 + wave * 8448);
    constexpr int I_IN = 16 * 112, I_SQ = 16 * 32, I_MG = 16 * 96, I_L = I_IN + 4 * I_SQ + I_MG;
    for (int it = gw; it < DEPTH * I_L; it += NGW) {
        const int l = it / I_L; int r = it - l * I_L; unsigned char* wl = ws + WS_WSM + l * WSM_LAYER;
        if (r < I_IN) { const int kb = r / 112, nb = r % 112, n0 = nb * 32; const int dr = n0 < 1536 ? n0 : (n0 < 2560 ? n0 + 1024 : n0 - 1024);
            tr_item(P.in[6] + (size_t)l * 1024 * IN_COLS, IN_COLS, kb * 64, n0, (bf16*)(wl + WSM_WIN), 1024, dr, scr, lane); continue; }
        r -= I_IN;
        if (r < 4 * I_SQ) { const int which = r / I_SQ; r -= which * I_SQ; const int kb = r >> 5, nb = r & 31;
            const float* src = (which == 0 ? P.in[8] : which == 1 ? P.in[16] : which == 2 ? P.in[17] : P.in[20]) + (size_t)l * 1024 * 1024;
            const size_t dst = which == 0 ? WSM_WOA : which == 1 ? WSM_WOR : which == 2 ? WSM_WOF : WSM_WOUT;
            tr_item(src, 1024, kb * 64, nb * 32, (bf16*)(wl + dst), 1024, nb * 32, scr, lane); continue; }
        r -= 4 * I_SQ;
        { const int kb = r / 96, nb = r % 96; tr_item(P.in[18] + (size_t)l * 1024 * 3072, 3072, kb * 64, nb * 32, (bf16*)(wl + WSM_WM), 1024, nb * 32, scr, lane); }
    }
    convert_moe(P, 0, lds, gw, NGW, wave, lane);
}

struct FoldStore {
    static constexpr bool PERM = true;
    bf16* O;
    __device__ __forceinline__ void operator()(const f32x4 (&acc)[2][2][4][2], const pg8::Unit& u, int wr, int wc, int fr, int fq) const {
        const int row0 = 3584 + u.pm * 1024 + (u.pn >> 2) * 256 + wr * 64 + fr; const int col0 = (u.pn & 3) * 256 + wc * 32 + 8 * fq;
#pragma unroll
        for (int ai = 0; ai < 2; ++ai)
#pragma unroll
            for (int m = 0; m < 4; ++m) { bf16* rowp = O + (size_t)(row0 + ai * 128 + m * 16) * 1024 + col0;
#pragma unroll
                for (int bj = 0; bj < 2; ++bj) { const f32x4 v0 = acc[ai][bj][m][0], v1 = acc[ai][bj][m][1];
                    u32x4 w; w.x = pg8::cvt_pk_bf16(v0[0], v0[1]); w.y = pg8::cvt_pk_bf16(v0[2], v0[3]); w.z = pg8::cvt_pk_bf16(v1[0], v1[1]); w.w = pg8::cvt_pk_bf16(v1[2], v1[3]);
                    *(u32x4*)(rowp + bj * 128) = w; } }
    }
};
__device__ __forceinline__ void modulate_rows(const float* xlat, const float* xctx, const float* mods  , bf16* U, int nrow, int gw, int NGW, int lane) {
    for (int r = gw; r < nrow; r += NGW) {
        const bool lat = r < NLAT; const float* xr = lat ? xlat + (size_t)r * D : xctx + (size_t)(r - NLAT) * D; const int bb = lat ? (r >> 13) : 8;
        const float* sh = mods + (size_t)(bb * 6 + 0) * D; const float* sc = mods + (size_t)(bb * 6 + 1) * D;
        u32x2* o = (u32x2*)(U + (size_t)r * D);
#pragma unroll
        for (int j = 0; j < 4; ++j) { const int c = 4 * lane + 256 * j; const f32x4 v = *(const f32x4*)(xr + c), s = *(const f32x4*)(sc + c), h = *(const f32x4*)(sh + c);
            const f32x4 uu = v * (s + 1.0f) + h; u32x2 w; w.x = pk2(uu[0], uu[1]); w.y = pk2(uu[2], uu[3]); o[lane + 64 * j] = w; }
    }
}
namespace att {
__device__ __forceinline__ int crow(int r, int hi) { return (r & 3) + 8 * (r >> 2) + 4 * hi; }
__device__ __forceinline__ void attn_unit(ldsp lds, bf16* Z, const float* sink  , int qrow0, int g, int nloc, int krow_loc0, int jlo, int krow_ctx0, int tid, bf16* Ob, int opitch) {
    const int lane = tid & 63, r32 = lane & 31, hi = lane >> 5; const int wid = __builtin_amdgcn_readfirstlane(tid >> 6);
    const int hh = wid >> 1, ts = wid & 1, head = 4 * g + hh;
    const int nt = nloc + 4;
    LAS float* wsf = (LAS float*)(lds + 32768) + wid * 64;
    const int krow_l = lane, kch = wid;
    const int vrow_l = 16 * (wid & 3) + (lane >> 2), vdh = wid >> 2, vch = lane & 3;
    const unsigned kdst = (unsigned)(kch * 1024 + krow_l * 16), vdst = (unsigned)(16384 + vdh * 4096 + vrow_l * 64 + vch * 16);
#define TILE_ROW(t) ((t) < nloc ? krow_loc0 + 64 * (t) : krow_ctx0 + 64 * ((t) - nloc))
    bf16x8 qr[4];
    { const bf16* Qw = Z + (size_t)(qrow0 + 32 * ts + r32) * ZC + ZQ + head * 64;
#pragma unroll
      for (int d0 = 0; d0 < 4; ++d0) qr[d0] = *(const bf16x8*)(Qw + d0 * 16 + hi * 8); }
    u32x4 kreg, vreg;
    { const int tr = TILE_ROW(0); kreg = *(const u32x4*)(Z + (size_t)(tr + krow_l) * ZC + ZK + g * 64 + kch * 8); vreg = *(const u32x4*)(Z + (size_t)(tr + vrow_l) * ZC + ZV + g * 64 + vdh * 32 + vch * 8); }
    *(LAS u32x4*)(lds + kdst) = kreg; *(LAS u32x4*)(lds + vdst) = vreg;
    float m_run = sink[head] * 1.4426950408889634f, l_run = 1.0f;
    f32x16 o[2]; o[0] = f32x16{}; o[1] = f32x16{};
    __syncthreads();
    for (int t = 0; t < nt; ++t) {
        const unsigned boff = (unsigned)(t & 1) * 8192u;
        if (t + 1 < nt) { const int tr = TILE_ROW(t + 1); kreg = *(const u32x4*)(Z + (size_t)(tr + krow_l) * ZC + ZK + g * 64 + kch * 8); vreg = *(const u32x4*)(Z + (size_t)(tr + vrow_l) * ZC + ZV + g * 64 + vdh * 32 + vch * 8); }
        f32x16 p0 = f32x16{}, p1 = f32x16{};
        { ldsp kb = lds + boff + hi * 1024 + r32 * 16;
#pragma unroll
          for (int d0 = 0; d0 < 4; ++d0) { const bf16x8 b0 = *(const LAS bf16x8*)(kb + d0 * 2048), b1 = *(const LAS bf16x8*)(kb + d0 * 2048 + 512);
              p0 = __builtin_amdgcn_mfma_f32_32x32x16_bf16(b0, qr[d0], p0, 0, 0, 0); p1 = __builtin_amdgcn_mfma_f32_32x32x16_bf16(b1, qr[d0], p1, 0, 0, 0); } }
        if (t < nloc) { const int j = jlo + t; const int qi = 32 * ts + r32;
            if (j == 0) {
#pragma unroll
                for (int r = 0; r < 16; ++r) { const int kk = crow(r, hi); if (kk < qi) p0[r] = -INFINITY; if (kk + 32 < qi) p1[r] = -INFINITY; } }
            if (j == 4) {
#pragma unroll
                for (int r = 0; r < 16; ++r) { const int kk = crow(r, hi); if (kk > qi) p0[r] = -INFINITY; if (kk + 32 > qi) p1[r] = -INFINITY; } } }
        float rm = p0[0];
#pragma unroll
        for (int r = 1; r < 16; ++r) rm = fmaxf(rm, p0[r]);
#pragma unroll
        for (int r = 0; r < 16; ++r) rm = fmaxf(rm, p1[r]);
        rm = fmaxf(rm, __shfl_xor(rm, 32));
        const float mnew = fmaxf(m_run, rm), f = __builtin_amdgcn_exp2f(m_run - mnew); m_run = mnew;
        float s = 0.f;
#pragma unroll
        for (int r = 0; r < 16; ++r) { p0[r] = __builtin_amdgcn_exp2f(p0[r] - mnew); p1[r] = __builtin_amdgcn_exp2f(p1[r] - mnew); s += p0[r] + p1[r]; }
        s += __shfl_xor(s, 32);
        l_run = l_run * f + s;
        if (hi == 0) wsf[r32] = f;
        LDS_WAIT();
#pragma unroll
        for (int r = 0; r < 16; ++r) { const float fr_ = wsf[crow(r, hi)]; o[0][r] *= fr_; o[1][r] *= fr_; }
        u32x4 pw0, pw1, pw2, pw3;
        pw0 = (u32x4){pk2(p0[0], p0[1]), pk2(p0[2], p0[3]), pk2(p0[4], p0[5]), pk2(p0[6], p0[7])};
        pw1 = (u32x4){pk2(p0[8], p0[9]), pk2(p0[10], p0[11]), pk2(p0[12], p0[13]), pk2(p0[14], p0[15])};
        pw2 = (u32x4){pk2(p1[0], p1[1]), pk2(p1[2], p1[3]), pk2(p1[4], p1[5]), pk2(p1[6], p1[7])};
        pw3 = (u32x4){pk2(p1[8], p1[9]), pk2(p1[10], p1[11]), pk2(p1[12], p1[13]), pk2(p1[14], p1[15])};
        { const LAS unsigned char* vp = lds + 16384 + boff + ((lane >> 4) & 1) * 32 + (lane & 3) * 8 + (4 * hi + ((lane & 15) >> 2)) * 64;
#pragma unroll
          for (int d0 = 0; d0 < 2; ++d0) {
#pragma unroll
              for (int ks = 0; ks < 4; ++ks) {
                  const s16x4 lo = __builtin_bit_cast(s16x4, __builtin_amdgcn_ds_read_tr16_b64_v4i16((LAS s16x4*)(vp + d0 * 4096 + ks * 1024)));
                  const s16x4 hh_ = __builtin_bit_cast(s16x4, __builtin_amdgcn_ds_read_tr16_b64_v4i16((LAS s16x4*)(vp + d0 * 4096 + ks * 1024 + 512)));
                  const bf16x8 vf = (bf16x8){lo[0], lo[1], lo[2], lo[3], hh_[0], hh_[1], hh_[2], hh_[3]};
                  const u32x4 pw = ks == 0 ? pw0 : ks == 1 ? pw1 : ks == 2 ? pw2 : pw3;
                  o[d0] = __builtin_amdgcn_mfma_f32_32x32x16_bf16(__builtin_bit_cast(bf16x8, pw), vf, o[d0], 0, 0, 0); } } }
        if (t + 1 < nt) { *(LAS u32x4*)(lds + (boff ^ 8192u) + kdst) = kreg; *(LAS u32x4*)(lds + (boff ^ 8192u) + vdst) = vreg; }
        __syncthreads();
    }
#undef TILE_ROW
    if (hi == 0) wsf[32 + r32] = l_run;
    LDS_WAIT();
    bf16* Ow = Ob + (size_t)(qrow0 + 32 * ts) * opitch + head * 64;
#pragma unroll
    for (int r = 0; r < 16; ++r) { const int q = crow(r, hi); const float rl = __builtin_amdgcn_rcpf(wsf[32 + q]);
#pragma unroll
        for (int d0 = 0; d0 < 2; ++d0) Ow[(size_t)q * opitch + d0 * 32 + r32] = (bf16)f2bf(o[d0][r] * rl); }
    LDS_WAIT();
}
__device__ __forceinline__ void attn_phase(ldsp lds, bf16* Z, const float* sink, bool with_ctx, int wg, int G, int g_wave, bf16* Ob, int opitch) {
    const int tid = fresh_tid();
    const int nlat = NB * 4 * (SEQ / 64), nctx = with_ctx ? NB * 4 * (CTXL / 64) : 0;
    for (int u = wg; u < nlat + nctx; u += G) {
        if (u < nlat) { const int qb = u & 127, g = (u >> 7) & 3, b = u >> 9; const int qpos0 = qb * 64;
            const int jlo = qpos0 == 0 ? 2 : (qpos0 == 64 ? 1 : 0); const int jhi = qpos0 == SEQ - 64 ? 2 : (qpos0 == SEQ - 128 ? 3 : 4);
            attn_unit(lds, Z, sink, b * SEQ + qpos0, g, jhi - jlo + 1, b * SEQ + qpos0 - 128 + 64 * jlo, jlo, NLAT + b * CTXL, tid, Ob, opitch);
        } else { const int v = u - nlat; const int qb = v & 3, g = (v >> 2) & 3, b = v >> 4;
            attn_unit(lds, Z, sink, NLAT + b * CTXL + qb * 64, g, 0, 0, 0, NLAT + b * CTXL, tid, Ob, opitch); }
    }
}
}
namespace fft {
constexpr int RS = 144;
constexpr int OUT_OFF = 73728;
template <int K> struct Tile { u32x4 v[K / 64]; };
template <int K> __device__ __forceinline__ void tile_load(Tile<K>& t, const bf16* base, size_t rstride, size_t pstride, int tid) {
    constexpr int KH = K / 2;
#pragma unroll
    for (int i = 0; i < K / 64; ++i) { const int c = tid + NTHR * i, kk = c >> 3, ch = c & 7; const int part = kk / KH, n = kk % KH;
        t.v[i] = *(const u32x4*)(base + (size_t)n * rstride + (size_t)part * pstride + ch * 8); }
}
template <int K> __device__ __forceinline__ void tile_put(const Tile<K>& t, ldsp lds, int tid) {
#pragma unroll
    for (int i = 0; i < K / 64; ++i) { const int c = tid + NTHR * i, kk = c >> 3, ch = c & 7; *(LAS u32x4*)(lds + kk * RS + ch * 16) = t.v[i]; }
}
__device__ __forceinline__ bf16x8 tile_frag(const LAS unsigned char* bp, int ks, int nt) {
    const s16x4 lo = __builtin_bit_cast(s16x4, __builtin_amdgcn_ds_read_tr16_b64_v4i16((LAS s16x4*)(bp + (32 * ks) * RS + nt * 32)));
    const s16x4 hi = __builtin_bit_cast(s16x4, __builtin_amdgcn_ds_read_tr16_b64_v4i16((LAS s16x4*)(bp + (32 * ks + 4) * RS + nt * 32)));
    return (bf16x8){lo[0], lo[1], lo[2], lo[3], hi[0], hi[1], hi[2], hi[3]};
}
template <int KS, int MTW, int NTW>
__device__ __forceinline__ void mma_reg(ldsp lds, const bf16x8 (&af)[MTW][KS], int nt0, f32x4 (&acc)[MTW][NTW], int tid) {
    const int lane = tid & 63, fr = lane & 15, kq = lane >> 4;
#pragma unroll
    for (int i = 0; i < MTW; ++i)
#pragma unroll
        for (int j = 0; j < NTW; ++j) acc[i][j] = (f32x4){0.f, 0.f, 0.f, 0.f};
    const LAS unsigned char* bp = lds + (8 * kq + (fr >> 2)) * RS + (4 * (fr & 3)) * 2;
#pragma unroll
    for (int ks = 0; ks < KS; ++ks)
#pragma unroll
        for (int j = 0; j < NTW; ++j) { const bf16x8 bfrag = tile_frag(bp, ks, nt0 + j);
#pragma unroll
            for (int i = 0; i < MTW; ++i) acc[i][j] = __builtin_amdgcn_mfma_f32_16x16x32_bf16(bfrag, af[i][ks], acc[i][j], 0, 0, 0); }
}
__device__ __forceinline__ void put4(ldsp p, float a, float b, float c, float d) { *(LAS u32x2*)p = (u32x2){pg8::cvt_pk_bf16(a, b), pg8::cvt_pk_bf16(c, d)}; }

__device__ __forceinline__ void pass1_phase(ldsp lds, bf16* Z, bf16* T, const unsigned char* ws, bool with_ctx, int wg, int G, int g_wave) {
    const bf16* F1 = (const bf16*)(ws + WS_F1); const bf16* F3 = (const bf16*)(ws + WS_F256); const f32x2* TW = (const f32x2*)(ws + WS_TW);
    const int tid = fresh_tid(); const int lane = tid & 63, fr = lane & 15, kq = lane >> 4; const int w = __builtin_amdgcn_readfirstlane(tid >> 6);
    bf16x8 af[2][8];
#pragma unroll
    for (int i = 0; i < 2; ++i)
#pragma unroll
        for (int ks = 0; ks < 8; ++ks) af[i][ks] = *(const bf16x8*)(F1 + (size_t)(16 * (2 * w + i) + fr) * 256 + 32 * ks + 8 * kq);
    const int NU = NB * 64 * 16;
    Tile<256> tl;
    if (wg < NU) { const int ct = wg & 15, n2 = (wg >> 4) & 63, b = wg >> 10; tile_load<256>(tl, Z + (size_t)(b * SEQ + n2) * ZC + ZXC + ct * 64, (size_t)64 * ZC, 1024, tid); }
    for (int u = wg; u < NU; u += G) { const int ct = u & 15, n2 = (u >> 4) & 63, b = u >> 10;
        tile_put<256>(tl, lds, tid);
        __syncthreads();
        { const int un = u + G; if (un < NU) { const int ct2 = un & 15, n22 = (un >> 4) & 63, b2 = un >> 10; tile_load<256>(tl, Z + (size_t)(b2 * SEQ + n22) * ZC + ZXC + ct2 * 64, (size_t)64 * ZC, 1024, tid); } }
        f32x4 acc[2][4];
        mma_reg<8, 2, 4>(lds, af, 0, acc, tid);
        { const int k1 = 16 * w + fr; const f32x2 cs = TW[(n2 * k1) & 8191]; ldsp o = lds + OUT_OFF + (k1 * 2) * RS + (4 * kq) * 2;
#pragma unroll
          for (int j = 0; j < 4; ++j) { const f32x4 p = acc[0][j], q = acc[1][j];
              put4(o + j * 32, p[0] * cs.x - q[0] * cs.y, p[1] * cs.x - q[1] * cs.y, p[2] * cs.x - q[2] * cs.y, p[3] * cs.x - q[3] * cs.y);
              put4(o + RS + j * 32, q[0] * cs.x + p[0] * cs.y, q[1] * cs.x + p[1] * cs.y, q[2] * cs.x + p[2] * cs.y, q[3] * cs.x + p[3] * cs.y); } }
        __syncthreads();
#pragma unroll
        for (int i = 0; i < 4; ++i) { const int c = tid + NTHR * i, row = c >> 3, ch = c & 7, k1 = row >> 1, part = row & 1;
            *(u32x4*)(T + (size_t)(b * SEQ + k1 * 64 + n2) * 2048 + part * 1024 + ct * 64 + ch * 8) = *(const LAS u32x4*)(lds + OUT_OFF + row * RS + ch * 16); }
    }
    __syncthreads();
    if (with_ctx) for (int u = wg; u < NB * 16; u += G) { const int b = u >> 4, ct = u & 15;
        Tile<512> tc; tile_load<512>(tc, Z + (size_t)(NLAT + b * CTXL) * ZC + ZXC + ct * 64, ZC, 1024, tid); tile_put<512>(tc, lds, tid);
        __syncthreads();
        f32x4 acc[2][4];
#pragma unroll
        for (int i = 0; i < 2; ++i)
#pragma unroll
            for (int j = 0; j < 4; ++j) acc[i][j] = (f32x4){0.f, 0.f, 0.f, 0.f};
        const LAS unsigned char* bp = lds + (8 * kq + (fr >> 2)) * RS + (4 * (fr & 3)) * 2;
#pragma unroll 2
        for (int ks = 0; ks < 16; ++ks) { bf16x8 a2[2];
#pragma unroll
            for (int i = 0; i < 2; ++i) a2[i] = *(const bf16x8*)(F3 + (size_t)(16 * (2 * w + i) + fr) * 512 + 32 * ks + 8 * kq);
#pragma unroll
            for (int j = 0; j < 4; ++j) { const bf16x8 bfrag = tile_frag(bp, ks, j);
#pragma unroll
                for (int i = 0; i < 2; ++i) acc[i][j] = __builtin_amdgcn_mfma_f32_16x16x32_bf16(bfrag, a2[i], acc[i][j], 0, 0, 0); } }
        __syncthreads();
#pragma unroll
        for (int i = 0; i < 2; ++i) { const int k = 16 * (2 * w + i) + fr; bf16* o = Z + (size_t)(NLAT + b * CTXL + k) * ZC + ZXC + ct * 64 + 4 * kq;
#pragma unroll
            for (int j = 0; j < 4; ++j) *(u32x2*)(o + 16 * j) = (u32x2){pg8::cvt_pk_bf16(acc[i][j][0], acc[i][j][1]), pg8::cvt_pk_bf16(acc[i][j][2], acc[i][j][3])}; }
    }
}
__device__ __forceinline__ void pass2_phase(ldsp lds, bf16* Z, const bf16* T, const unsigned char* ws, int wg, int G, int g_wave) {
    const bf16* F2 = (const bf16*)(ws + WS_F2);
    const int tid = fresh_tid(); const int lane = tid & 63, fr = lane & 15, kq = lane >> 4; const int w = __builtin_amdgcn_readfirstlane(tid >> 6);
    bf16x8 af[1][4];
#pragma unroll
    for (int ks = 0; ks < 4; ++ks) af[0][ks] = *(const bf16x8*)(F2 + (size_t)(16 * (w >> 1) + fr) * 128 + 32 * ks + 8 * kq);
    const int NU = NB * 128 * 16;
    Tile<128> tl;
    if (wg < NU) { const int ct = wg & 15, k1 = (wg >> 4) & 127, b = wg >> 11; tile_load<128>(tl, T + (size_t)(b * SEQ + k1 * 64) * 2048 + ct * 64, 2048, 1024, tid); }
    for (int u = wg; u < NU; u += G) { const int ct = u & 15, k1 = (u >> 4) & 127, b = u >> 11;
        tile_put<128>(tl, lds, tid);
        __syncthreads();
        { const int un = u + G; if (un < NU) { const int ct2 = un & 15, k12 = (un >> 4) & 127, b2 = un >> 11; tile_load<128>(tl, T + (size_t)(b2 * SEQ + k12 * 64) * 2048 + ct2 * 64, 2048, 1024, tid); } }
        f32x4 acc[1][2];
        mma_reg<4, 1, 2>(lds, af, 2 * (w & 1), acc, tid);
        { const int k2 = 16 * (w >> 1) + fr; ldsp o = lds + OUT_OFF + k2 * RS + (32 * (w & 1) + 4 * kq) * 2;
#pragma unroll
          for (int j = 0; j < 2; ++j) put4(o + j * 32, acc[0][j][0], acc[0][j][1], acc[0][j][2], acc[0][j][3]); }
        __syncthreads();
        { const int row = tid >> 3, ch = tid & 7;
          *(u32x4*)(Z + (size_t)(b * SEQ + k1 + 128 * row) * ZC + ZXC + ct * 64 + ch * 8) = *(const LAS u32x4*)(lds + OUT_OFF + row * RS + ch * 16); }
    }
    __syncthreads();
}
}
namespace rg {
constexpr int XRS = 144;
constexpr int WAVE_LDS = 68 * XRS;
struct Args {
    bf16* Z; const float* conv_w; const float* conv_b;
    const bf16* Wg;
    const float* b_a; const float* b_i; const float* sp;
    f32x2* SUM;
    const float* CARRY;
    bf16* Gout; int gpitch;
};
template <bool FINAL>
__device__ __forceinline__ void wave_unit(LAS unsigned char* xt, const LAS unsigned char* wgl, const LAS float* cst, const Args& A, int bb, int cid, int hb, int tid) {
    const int lane = tid & 63, fr = lane & 15, kq = lane >> 4;
    const bool isctx = cid < 4; const int rowbase = isctx ? NLAT + bb * CTXL : bb * SEQ, len = isctx ? CTXL : SEQ, t0 = isctx ? cid * 64 : (cid - 4) * 64;
#pragma unroll
    for (int i = 0; i < 9; ++i) { const int rr = i * 8 + (lane >> 3), ch = lane & 7, t = t0 - 2 + rr;
        u32x4 v = {0u, 0u, 0u, 0u};
        if (rr < 68 && t >= 0 && t < len) v = *(const u32x4*)(A.Z + (size_t)(rowbase + t) * ZC + ZXR + hb * 64 + ch * 8);
        if (rr < 68) *(LAS u32x4*)(xt + rr * XRS + ch * 16) = v; }
    LDS_WAIT();
    bf16x8 af[4][2];
#pragma unroll
    for (int ks = 0; ks < 2; ++ks) { const int c0 = 32 * ks + 8 * kq;
        float cw[4][8], cb[8];
#pragma unroll
        for (int tap = 0; tap < 4; ++tap) { const f32x4 a = *(const LAS f32x4*)(cst + tap * 64 + c0), b = *(const LAS f32x4*)(cst + tap * 64 + c0 + 4);
#pragma unroll
            for (int j = 0; j < 4; ++j) { cw[tap][j] = a[j]; cw[tap][4 + j] = b[j]; } }
        { const f32x4 a = *(const LAS f32x4*)(cst + 256 + c0), b = *(const LAS f32x4*)(cst + 256 + c0 + 4);
#pragma unroll
          for (int j = 0; j < 4; ++j) { cb[j] = a[j]; cb[4 + j] = b[j]; } }
#pragma unroll
        for (int mt = 0; mt < 4; ++mt) { float xc[8];
#pragma unroll
            for (int j = 0; j < 8; ++j) xc[j] = cb[j];
#pragma unroll
            for (int tap = 0; tap < 4; ++tap) { const u32x4 xv = *(const LAS u32x4*)(xt + (16 * mt + fr + tap) * XRS + (32 * ks + 8 * kq) * 2);
#pragma unroll
                for (int j = 0; j < 8; ++j) { const unsigned w = xv[j >> 1]; const float x = (j & 1) ? bf2f(w >> 16) : bf2f(w & 0xffffu); xc[j] += cw[tap][j] * x; } }
            u32x4 p; p.x = pg8::cvt_pk_bf16(xc[0], xc[1]); p.y = pg8::cvt_pk_bf16(xc[2], xc[3]); p.z = pg8::cvt_pk_bf16(xc[4], xc[5]); p.w = pg8::cvt_pk_bf16(xc[6], xc[7]);
            af[mt][ks] = __builtin_bit_cast(bf16x8, p); } }
    const int bsum = bb * NCHUNK + cid;
#pragma unroll 1
    for (int nt = 0; nt < 4; ++nt) {
        const int cch = hb * 64 + 16 * nt + fr;
        float xd[4][4];
        { float cwd[4];
#pragma unroll
          for (int tap = 0; tap < 4; ++tap) cwd[tap] = cst[tap * 64 + 16 * nt + fr];
          const float cbd = cst[256 + 16 * nt + fr];
#pragma unroll
          for (int mt = 0; mt < 4; ++mt) { float xs[7];
#pragma unroll
              for (int q = 0; q < 7; ++q) xs[q] = bf2f(*(const LAS unsigned short*)(xt + (16 * mt + 4 * kq + q) * XRS + (16 * nt + fr) * 2));
#pragma unroll
              for (int r = 0; r < 4; ++r) xd[mt][r] = cbd + cwd[0] * xs[r] + cwd[1] * xs[r + 1] + cwd[2] * xs[r + 2] + cwd[3] * xs[r + 3]; } }
        float hsum[4][4];
#pragma unroll
        for (int dir = 0; dir < 2; ++dir) {
            f32x4 g[2][4];
#pragma unroll
            for (int gi = 0; gi < 2; ++gi) { const int gm = 2 * dir + gi; bf16x8 bw[2];
#pragma unroll
                for (int ks = 0; ks < 2; ++ks) bw[ks] = *(const LAS bf16x8*)(wgl + (gm * 64 + 16 * nt + fr) * 144 + (32 * ks + 8 * kq) * 2);
#pragma unroll
                for (int mt = 0; mt < 4; ++mt) { f32x4 c = {0.f, 0.f, 0.f, 0.f};
                    c = __builtin_amdgcn_mfma_f32_16x16x32_bf16(af[mt][0], bw[0], c, 0, 0, 0); c = __builtin_amdgcn_mfma_f32_16x16x32_bf16(af[mt][1], bw[1], c, 0, 0, 0); g[gi][mt] = c; } }
            const float ba = cst[(5 + dir) * 64 + 16 * nt + fr], bi = cst[(7 + dir) * 64 + 16 * nt + fr], spv = cst[(9 + dir) * 64 + 16 * nt + fr];
            float carry = 0.f;
            if (FINAL) carry = A.CARRY[(((size_t)dir * NB + bb) * NCHUNK + cid) * 1024 + cch];
            float ptot = 1.f;
#pragma unroll
            for (int mi = 0; mi < 4; ++mi) { const int mt = dir == 0 ? mi : 3 - mi;
                float a[4], bv[4];
#pragma unroll
                for (int r = 0; r < 4; ++r) {
                    const float rr = __builtin_amdgcn_rcpf(1.0f + __builtin_amdgcn_exp2f(__builtin_fmaf(g[0][mt][r], -1.4426950408889634f, ba)));
                    const float ii = __builtin_amdgcn_rcpf(1.0f + __builtin_amdgcn_exp2f(__builtin_fmaf(g[1][mt][r], -1.4426950408889634f, bi)));
                    a[r] = __builtin_amdgcn_exp2f(-rr * spv);
                    const float om = __builtin_fmaf(-a[r], a[r], 1.0f);
                    bv[r] = __builtin_amdgcn_sqrtf(om) * ii * xd[mt][r]; }
                float s[4], p[4];
                if (dir == 0) { s[0] = bv[0]; p[0] = a[0];
#pragma unroll
                    for (int r = 1; r < 4; ++r) { s[r] = a[r] * s[r - 1] + bv[r]; p[r] = a[r] * p[r - 1]; } }
                else { s[3] = bv[3]; p[3] = a[3];
#pragma unroll
                    for (int r = 2; r >= 0; --r) { s[r] = a[r] * s[r + 1] + bv[r]; p[r] = a[r] * p[r + 1]; } }
                const float pe = dir == 0 ? p[3] : p[0], se = dir == 0 ? s[3] : s[0];
                float pa[4], sa[4];
#pragma unroll
                for (int q = 0; q < 4; ++q) { pa[q] = __shfl(pe, fr + 16 * q); sa[q] = __shfl(se, fr + 16 * q); }
                float cin = carry, mine = carry;
#pragma unroll
                for (int qi = 0; qi < 4; ++qi) { const int q = dir == 0 ? qi : 3 - qi; if (q == kq) mine = cin; cin = pa[q] * cin + sa[q]; ptot *= pa[q]; }
                carry = cin;
                if (FINAL) {
#pragma unroll
                    for (int r = 0; r < 4; ++r) { const float h = s[r] + p[r] * mine; hsum[mt][r] = dir == 0 ? h : hsum[mt][r] + h; } }
                __builtin_amdgcn_sched_barrier(0);
            }
            if (!FINAL) { if (kq == 0) A.SUM[(((size_t)dir * NB + bb) * NCHUNK + cid) * 1024 + cch] = (f32x2){ptot, carry}; }
        }
        if (FINAL) {
#pragma unroll
            for (int mt = 0; mt < 4; ++mt)
#pragma unroll
                for (int r = 0; r < 4; ++r) { const int t = t0 + 16 * mt + 4 * kq + r; const bf16* gp = A.Z + (size_t)(rowbase + t) * ZC + ZGR + cch;
                    const float gr = bf2f(*gp); A.Gout[(size_t)(rowbase + t) * A.gpitch + cch] = (bf16)f2bf(gelu_tanh(gr) * hsum[mt][r]); }
        }
    }
    (void)bsum;
    LDS_WAIT();
}
template <bool FINAL>
__device__ __forceinline__ void phase(ldsp lds, const Args& A, bool ctx_too, int wg, int G, int g_wave) {
    const int tid = fresh_tid(); const int wave = __builtin_amdgcn_readfirstlane(tid >> 6); LAS unsigned char* xt = lds + wave * WAVE_LDS;
    LAS unsigned char* wgl = lds + NWAVES * WAVE_LDS; LAS float* cst = (LAS float*)(lds + NWAVES * WAVE_LDS + 4 * 64 * 144);
    const int hb = wg & 15;
    for (int c = tid; c < 4 * 64 * 8; c += NTHR) { const int row = c >> 3, ch = c & 7, gm = row >> 6, o = row & 63;
        *(LAS u32x4*)(wgl + row * 144 + ch * 16) = *(const u32x4*)(A.Wg + ((size_t)((gm * 16 + hb) * 64 + o)) * 64 + ch * 8); }
    for (int c = tid; c < 11 * 64; c += NTHR) { const int k = c >> 6, ch = hb * 64 + (c & 63);
        cst[c] = k < 4 ? A.conv_w[k * 1024 + ch] : k == 4 ? A.conv_b[ch] : k < 7 ? -1.4426950408889634f * A.b_a[(k - 5) * 1024 + ch] : k < 9 ? -1.4426950408889634f * A.b_i[(k - 7) * 1024 + ch] : 8.0f * 1.4426950408889634f * A.sp[(k - 9) * 1024 + ch]; }
    __syncthreads();
    const int c_lo = ctx_too ? 0 : 4, nch = NCHUNK - c_lo, total = NB * nch;
    const int per = G >> 4;
    for (int u = (wg >> 4) * NWAVES + wave; u < total; u += per * NWAVES) { const int cid = c_lo + u % nch, bb = u / nch; wave_unit<FINAL>(xt, wgl, cst, A, bb, cid, hb, tid); }
    __syncthreads();
}
__device__ __forceinline__ void carry_phase(const f32x2* SUM, float* CARRY, int wg, int G, int g_wave) {
    const int tid = fresh_tid(); const int lane = tid & 63, wave = __builtin_amdgcn_readfirstlane(tid >> 6);
    for (int u = wg + G * wave; u < 2 * NB * 16; u += G * NWAVES) { const int cb = u & 15, bb = (u >> 4) & 7, dir = u >> 7;
        const f32x2* S = SUM + ((size_t)dir * NB + bb) * NCHUNK * 1024 + cb * 64 + lane; float* C = CARRY + ((size_t)dir * NB + bb) * NCHUNK * 1024 + cb * 64 + lane;
        float state = 0.f;
        for (int i0 = 0; i0 < NCHUNK; i0 += 12) { f32x2 v[12]; int id[12];
#pragma unroll
            for (int j = 0; j < 12; ++j) { const int i = i0 + j; id[j] = dir == 0 ? i : (i < 4 ? 3 - i : NCHUNK + 3 - i); v[j] = S[(size_t)id[j] * 1024]; }
#pragma unroll
            for (int j = 0; j < 12; ++j) { C[(size_t)id[j] * 1024] = state; state = v[j].x * state + v[j].y; } }
    }
}
}
namespace rowp {
struct LnArgs { bool dry; bool f8; float* X1; bf16* U2; const float* lng; const float* lnb; const float* mods; const bf16* wrh; const bf16* wrl; const float* brt; int* asg_e; int* asg_p; float* asg_g; int* wgc; };
__device__ __forceinline__ void ln_router_phase(ldsp lds, const LnArgs& A, int nrow, int wg, int G, int g_wave) {
    const int tid = fresh_tid(), lane = tid & 63, fr = lane & 15, kq = lane >> 4; const int wave = __builtin_amdgcn_readfirstlane(tid >> 6);
    LAS int* cnt = (LAS int*)(lds + LM_CNT);
    if (tid < 32 && !A.dry) cnt[tid] = 0;
    __syncthreads();
    constexpr int ARS = 2064;
    LAS float* part = (LAS float*)(lds + 66048); LAS float* lg = (LAS float*)(lds + 82432);
    const int ngrp = nrow / 16;
    for (int grp = wg; grp < ngrp; grp += G) {
#pragma unroll
        for (int rr = 0; rr < 2; ++rr) { const int lr = 2 * wave + rr, row = grp * 16 + lr; const int bb = row < NLAT ? (row >> 13) : 8;
            float* xp = A.X1 + (size_t)row * D; f32x4 v[4]; float s = 0.f;
#pragma unroll
            for (int j = 0; j < 4; ++j) { v[j] = *(const f32x4*)(xp + 4 * lane + 256 * j); s += (v[j][0] + v[j][1]) + (v[j][2] + v[j][3]); }
            const float mean = wave_sum(s) * (1.0f / D); float s2 = 0.f;
#pragma unroll
            for (int j = 0; j < 4; ++j) { v[j] = v[j] - mean; s2 += (v[j][0] * v[j][0] + v[j][1] * v[j][1]) + (v[j][2] * v[j][2] + v[j][3] * v[j][3]); }
            const float rstd = 1.0f / sqrtf(wave_sum(s2) * (1.0f / D) + LN_EPS);
            const float* sh = A.mods + (size_t)(bb * 6 + 3) * D; const float* sc = A.mods + (size_t)(bb * 6 + 4) * D;
#pragma unroll
            for (int j = 0; j < 4; ++j) { const int c = 4 * lane + 256 * j; const f32x4 gg = *(const f32x4*)(A.lng + c), bbv = *(const f32x4*)(A.lnb + c);
                const f32x4 x1 = v[j] * rstd * gg + bbv; if (!A.dry) *(f32x4*)(xp + c) = x1;
                const f32x4 u = x1 * (*(const f32x4*)(sc + c) + 1.0f) + *(const f32x4*)(sh + c);
                unsigned h[4], lo[4];
#pragma unroll
                for (int e = 0; e < 4; ++e) { h[e] = f2bf(u[e]); lo[e] = f2bf(u[e] - bf2f(h[e])); }
                const u32x2 hw = {h[0] | (h[1] << 16), h[2] | (h[3] << 16)}, lw = {lo[0] | (lo[1] << 16), lo[2] | (lo[3] << 16)};
                if (A.dry) {} else if (A.f8) { unsigned w8 = 0u; w8 = __builtin_amdgcn_cvt_pk_fp8_f32(u[0], u[1], w8, false); w8 = __builtin_amdgcn_cvt_pk_fp8_f32(u[2], u[3], w8, true); *(unsigned*)((unsigned char*)A.U2 + (size_t)row * D + c) = w8; }
                else *(u32x2*)(A.U2 + (size_t)row * D + c) = hw;
                *(LAS u32x2*)(lds + lr * ARS + c * 2) = hw; *(LAS u32x2*)(lds + 33024 + lr * ARS + c * 2) = lw; } }
        __syncthreads();
        { f32x4 acc[2] = {{0.f, 0.f, 0.f, 0.f}, {0.f, 0.f, 0.f, 0.f}};
#pragma unroll
          for (int ks = 0; ks < 4; ++ks) { const int k0 = 128 * wave + 32 * ks + 8 * kq;
              const bf16x8 ah = *(const LAS bf16x8*)(lds + fr * ARS + k0 * 2), al = *(const LAS bf16x8*)(lds + 33024 + fr * ARS + k0 * 2);
#pragma unroll
              for (int nt = 0; nt < 2; ++nt) { const bf16x8 bh = *(const bf16x8*)(A.wrh + (size_t)(16 * nt + fr) * D + k0), bl = *(const bf16x8*)(A.wrl + (size_t)(16 * nt + fr) * D + k0);
                  acc[nt] = __builtin_amdgcn_mfma_f32_16x16x32_bf16(ah, bh, acc[nt], 0, 0, 0);
                  acc[nt] = __builtin_amdgcn_mfma_f32_16x16x32_bf16(al, bh, acc[nt], 0, 0, 0);
                  acc[nt] = __builtin_amdgcn_mfma_f32_16x16x32_bf16(ah, bl, acc[nt], 0, 0, 0); } }
#pragma unroll
          for (int nt = 0; nt < 2; ++nt)
#pragma unroll
              for (int r = 0; r < 4; ++r) part[(wave * 16 + 4 * kq + r) * 32 + 16 * nt + fr] = acc[nt][r]; }
        __syncthreads();
        { const int row = tid >> 5, e = tid & 31; float s = A.brt[e];
#pragma unroll
          for (int w = 0; w < 8; ++w) s += part[(w * 16 + row) * 32 + e];
          lg[row * 32 + e] = s; }
        __syncthreads();
        if (tid < 16) { const int row = grp * 16 + tid; float v[32];
#pragma unroll
            for (int e = 0; e < 32; ++e) v[e] = lg[tid * 32 + e];
            int be[4]; float bv[4];
#pragma unroll
            for (int k = 0; k < 4; ++k) { float best = -INFINITY; int bi = 0;
#pragma unroll
                for (int e = 0; e < 32; ++e) { const bool taken = (k > 0 && be[0] == e) || (k > 1 && be[1] == e) || (k > 2 && be[2] == e); if (!taken && v[e] > best) { best = v[e]; bi = e; } }
                be[k] = bi; bv[k] = best; }
            float ex[4], se = 0.f;
#pragma unroll
            for (int k = 0; k < 4; ++k) { ex[k] = __expf(bv[k] - bv[0]); se += ex[k]; }
            const float inv = 1.0f / se;
#pragma unroll
            for (int k = 0; k < 4; ++k) { if (A.dry) { if (ex[k] * inv < -1.0f) A.asg_g[row * 4 + k] = (float)be[k]; } else { const int pos = __hip_atomic_fetch_add(&cnt[be[k]], 1, __ATOMIC_RELAXED, __HIP_MEMORY_SCOPE_WORKGROUP); A.asg_e[row * 4 + k] = be[k]; A.asg_p[row * 4 + k] = pos; A.asg_g[row * 4 + k] = ex[k] * inv; } } }
        __syncthreads();
    }
    __syncthreads();
    if (tid < 32 && !A.dry) A.wgc[wg * 32 + tid] = cnt[tid];
}
__device__ __forceinline__ void moe_tables(ldsp lds, const int* wgc, int wg, int G, int g_wave) {
    const int tid = fresh_tid();
    LAS int* pst = (LAS int*)(lds + LM_PST); LAS int* myb = (LAS int*)(lds + LM_MYB); LAS int* ntl = (LAS int*)(lds + LM_NT); LAS unsigned short* te = (LAS unsigned short*)(lds + LM_TE);
    LAS int* tmp = (LAS int*)lds;
    { const int e = tid & 31, p = tid >> 5; int tot = 0, below = 0;
#pragma unroll 1
      for (int w = p; w < G; w += 16) { const int c = wgc[w * 32 + e]; tot += c; if (w < wg) below += c; }
      tmp[p * 32 + e] = tot; tmp[512 + p * 32 + e] = below; }
    __syncthreads();
    if (tid < 32) { int tot = 0, below = 0;
#pragma unroll
        for (int p = 0; p < 16; ++p) { tot += tmp[p * 32 + tid]; below += tmp[512 + p * 32 + tid]; }
        myb[tid] = below; tmp[1024 + tid] = (tot + 255) & ~255; }
    __syncthreads();
    if (tid == 0) { int acc = 0;
#pragma unroll 1
        for (int e = 0; e < 32; ++e) { pst[e] = acc; const int nt_e = tmp[1024 + e] >> 8;
#pragma unroll 1
            for (int i = 0; i < nt_e; ++i) te[(acc >> 8) + i] = (unsigned short)e; acc += tmp[1024 + e]; } pst[32] = acc; ntl[0] = acc >> 8; }
    __syncthreads();
}
__device__ __forceinline__ void gather_phase(ldsp lds, bool f8, const bf16* U2, bf16* XS, const int* asg_e, const int* asg_p, int* asg_s, int nrow, int wg, int G, int g_wave) {
    const int tid = fresh_tid(), lane = tid & 63; const int wave = __builtin_amdgcn_readfirstlane(tid >> 6);
    const LAS int* pst = (const LAS int*)(lds + LM_PST); const LAS int* myb = (const LAS int*)(lds + LM_MYB);
    const int ngrp = nrow / 16;
    for (int grp = wg; grp < ngrp; grp += G) {
#pragma unroll
        for (int rr = 0; rr < 2; ++rr) { const int row = grp * 16 + 2 * wave + rr;
            if (f8) { const unsigned char* u8 = (const unsigned char*)U2; unsigned char* x8 = (unsigned char*)XS;
                const u32x4 v0 = *(const u32x4*)(u8 + (size_t)row * D + lane * 16);
#pragma unroll
                for (int k = 0; k < 4; ++k) { const int e = asg_e[row * 4 + k], slot = pst[e] + myb[e] + asg_p[row * 4 + k];
                    if (lane == 0) asg_s[row * 4 + k] = slot;
                    *(u32x4*)(x8 + (size_t)slot * D + lane * 16) = v0; } }
            else {
            const u32x4 v0 = *(const u32x4*)(U2 + (size_t)row * D + lane * 8), v1 = *(const u32x4*)(U2 + (size_t)row * D + 512 + lane * 8);
#pragma unroll
            for (int k = 0; k < 4; ++k) { const int e = asg_e[row * 4 + k], slot = pst[e] + myb[e] + asg_p[row * 4 + k];
                if (lane == 0) asg_s[row * 4 + k] = slot;
                *(u32x4*)(XS + (size_t)slot * D + lane * 8) = v0; *(u32x4*)(XS + (size_t)slot * D + 512 + lane * 8) = v1; } } }
    }
}
struct CombArgs { const float* X1; const bf16* YS; const int* asg_s; const float* asg_g; const float* mods; const float* lng; const float* lnb; float* out_lat; float* out_ctx; bf16* Unext; const float* mods_next; };
__device__ __forceinline__ void combine_phase(const CombArgs& A, int nrow, int gw, int NGW, int lane) {
    for (int row = gw; row < nrow; row += NGW) { const bool lat = row < NLAT; const int bb = lat ? (row >> 13) : 8;
        int sl[4]; float gt[4];
#pragma unroll
        for (int k = 0; k < 4; ++k) { sl[k] = A.asg_s[row * 4 + k]; gt[k] = A.asg_g[row * 4 + k]; }
        const float* g2 = A.mods + (size_t)(bb * 6 + 5) * D; f32x4 v[4]; float s = 0.f;
#pragma unroll
        for (int j = 0; j < 4; ++j) { const int c = 4 * lane + 256 * j; f32x4 f = {0.f, 0.f, 0.f, 0.f};
#pragma unroll
            for (int k = 0; k < 4; ++k) { const u32x2 y = *(const u32x2*)(A.YS + (size_t)sl[k] * D + c); f[0] += gt[k] * bf2f(y.x & 0xffffu); f[1] += gt[k] * bf2f(y.x >> 16); f[2] += gt[k] * bf2f(y.y & 0xffffu); f[3] += gt[k] * bf2f(y.y >> 16); }
            v[j] = *(const f32x4*)(A.X1 + (size_t)row * D + c) * DN_ALPHA + *(const f32x4*)(g2 + c) * f; s += (v[j][0] + v[j][1]) + (v[j][2] + v[j][3]); }
        const float mean = wave_sum(s) * (1.0f / D); float s2 = 0.f;
#pragma unroll
        for (int j = 0; j < 4; ++j) { v[j] = v[j] - mean; s2 += (v[j][0] * v[j][0] + v[j][1] * v[j][1]) + (v[j][2] * v[j][2] + v[j][3] * v[j][3]); }
        const float rstd = 1.0f / sqrtf(wave_sum(s2) * (1.0f / D) + LN_EPS);
        float* op = lat ? A.out_lat + (size_t)row * D : A.out_ctx + (size_t)(row - NLAT) * D;
        const float* sh = A.mods_next + (size_t)(bb * 6 + 0) * D; const float* sc = A.mods_next + (size_t)(bb * 6 + 1) * D;
#pragma unroll
        for (int j = 0; j < 4; ++j) { const int c = 4 * lane + 256 * j; const f32x4 x2 = v[j] * rstd * *(const f32x4*)(A.lng + c) + *(const f32x4*)(A.lnb + c);
            *(f32x4*)(op + c) = x2;
            if (A.Unext) { const f32x4 u = x2 * (*(const f32x4*)(sc + c) + 1.0f) + *(const f32x4*)(sh + c); u32x2 w; w.x = pk2(u[0], u[1]); w.y = pk2(u[2], u[3]); *(u32x2*)(A.Unext + (size_t)row * D + c) = w; } }
    }
}
}
constexpr int PH_PER_LAYER = 12, N_PHASES = 2 + DEPTH * PH_PER_LAYER;
static_assert(sizeof(KArgs) == 31 * 8 + 8 + 8 + 8, "no padding in the argument struct");
#ifndef PHMASK
#define PHMASK 0xffffffu
#endif
#ifndef SUBM
#define SUBM 7
#endif
#ifndef SUB3
#define SUB3 3
#endif
#ifndef REPMASK
#define REPMASK 0
#endif
#ifndef REP2
#define REP2 0
#endif
#ifndef REP3
#define REP3 0
#endif
#define NREP(slot) ((((REPMASK) >> (slot)) & 1) ? 2 : 1)
#define FORREP(n) for (int rep = 0; rep < (n); ++rep)
typedef const __attribute__((address_space(4))) KArgs CKArgs;
__device__ __forceinline__ CKArgs* fresh_args() { CKArgs* p = (CKArgs*)__builtin_amdgcn_kernarg_segment_ptr(); asm volatile("" : "+s"(p)); return p; }

__global__ void __launch_bounds__(NTHR, 2) mega(KArgs args) {
    extern __shared__ __attribute__((aligned(16))) unsigned char lds_raw[];
    const ldsp lds = (ldsp)lds_raw;
    const int G = gridDim.x, wg = blockIdx.x; const int g_wave = __builtin_amdgcn_readfirstlane((int)threadIdx.x >> 6);
    { const int tid0 = threadIdx.x; for (int u = tid0; u < (LDS_BYTES - RING_BYTES) / 4; u += NTHR) ((LAS unsigned*)(lds + RING_BYTES))[u] = 0u; }
    __syncthreads();
    const int lo = args.ph_lo, hi = args.ph_hi;
    XcdBarrier bar; bar.bar = (unsigned*)(args.ws + WS_CTL) + CW_BAR; bar.x = 0; bar.st = nullptr;
    if (hi - lo > 1) bar = xcd_barrier_post((unsigned*)(args.ws + WS_CTL) + CW_BAR, (volatile LAS unsigned*)(lds + LM_XB));
#define PHM(k) (((PHMASK) >> ((k) < 2 ? (k) : 2 + ((k) - 2) % PH_PER_LAYER)) & 1u)
#define IN(k) (PHM(k) && lo <= (k) && (k) < hi)
#define SEAM(k) do { if (lo <= (k) && (k) + 1 < hi) xcd_barrier(bar); } while (0)
#define ENTER() CKArgs& P = *fresh_args(); unsigned char* const ws = P.ws; (void)ws

    if (IN(0)) FORREP(NREP(0)) { ENTER(); phase_pre_a(P, lds, wg, G, g_wave); __syncthreads(); }
    SEAM(0);
    if (IN(1)) FORREP(NREP(1)) { ENTER();
#pragma unroll
        for (int l = 0; l < DEPTH; ++l) { unsigned char* wl = ws + WS_WSM + l * WSM_LAYER;
            pg8::Gemm g{(const bf16*)(ws + WS_FC), (const bf16*)(wl + WSM_WXF), 256, 1024, 256}; pg8::FoldOrder S{G, wg}; FoldStore E{(bf16*)(wl + WSM_WIN)};
            pg8::gemm_phase<FoldStore, pg8::FoldOrder>(lds, g, S, E, g_wave); }
        const int tid = fresh_tid(); modulate_rows(P.in[0], P.in[2], (const float*)(ws + WS_MODS), (bf16*)(ws + WS_U), NROW, wg * NWAVES + (tid >> 6), G * NWAVES, tid & 63);
    }
    SEAM(1);
#pragma unroll 1
    for (int l = 0; l < DEPTH; ++l) {
        const int pb = 2 + PH_PER_LAYER * l; const bool last = (l == DEPTH - 1);
        const int nrow = last ? NLAT : NROW;
#define WL(off) (ws + WS_WSM + (size_t)l * WSM_LAYER + (off))
#define MODS(ll) ((const float*)(ws + WS_MODS) + (size_t)(ll) * 9 * 6144)
        if (IN(pb + 0)) FORREP(NREP(2)) { ENTER(); pg8::Gemm g{(const bf16*)(ws + WS_U), (const bf16*)WL(WSM_WIN), 1024, 1024, 1024}; pg8::StaticOrder S; S.init(NROW, ZC, G, wg); epi::In E{(bf16*)(ws + WS_Z), (const f32x2*)(ws + WS_ROPE)};
            pg8::gemm_phase<epi::In, pg8::StaticOrder>(lds, g, S, E, g_wave); }
        SEAM(pb + 0);
        if (IN(pb + 1)) {
            if (SUBM & 1) FORREP((REP2 & 1) ? 2 : 1) { ENTER(); rg::Args RA{(bf16*)(ws + WS_Z), P.in[9] + l * 4096, P.in[10] + l * 1024, (const bf16*)WL(WSM_WG), P.in[12] + l * 2048, P.in[14] + l * 2048, (const float*)(ws + WS_SP) + l * 2048, (f32x2*)(ws + WS_SUM), nullptr, nullptr, 0};
                rg::phase<false>(lds, RA, true, wg, G, g_wave); __syncthreads(); }
            if (SUBM & 2) FORREP((REP2 & 2) ? 2 : 1) { ENTER(); att::attn_phase(lds, (bf16*)(ws + WS_Z), P.in[7] + l * 16, !last, wg, G, g_wave, rep ? (bf16*)(ws + WS_Y) : (bf16*)(ws + WS_Z) + ZQ, rep ? 1024 : ZC); __syncthreads(); }
            if (SUBM & 4) FORREP((REP2 & 4) ? 2 : 1) { ENTER(); fft::pass1_phase(lds, (bf16*)(ws + WS_Z), (bf16*)(ws + WS_T), ws, !last, wg, G, g_wave); } }
        SEAM(pb + 1);
        if (IN(pb + 2)) FORREP(NREP(13)) { ENTER(); rg::carry_phase((const f32x2*)(ws + WS_SUM), (float*)(ws + WS_CARRY), wg, G, g_wave); }
        SEAM(pb + 2);
        if (IN(pb + 3)) {
            if (SUB3 & 1) FORREP((REP3 & 1) ? 2 : 1) { ENTER(); rg::Args RA{(bf16*)(ws + WS_Z), P.in[9] + l * 4096, P.in[10] + l * 1024, (const bf16*)WL(WSM_WG), P.in[12] + l * 2048, P.in[14] + l * 2048, (const float*)(ws + WS_SP) + l * 2048, (f32x2*)(ws + WS_SUM), (const float*)(ws + WS_CARRY),
                  rep ? (bf16*)(ws + WS_Y) : (bf16*)(ws + WS_Z) + ZGR, rep ? 1024 : ZC};
              rg::phase<true>(lds, RA, !last, wg, G, g_wave); __syncthreads(); }
            if (SUB3 & 2) FORREP((REP3 & 2) ? 2 : 1) { ENTER(); fft::pass2_phase(lds, (bf16*)(ws + WS_Z), (const bf16*)(ws + WS_T), ws, wg, G, g_wave); } }
        SEAM(pb + 3);
        if (IN(pb + 4)) FORREP(NREP(5)) {
            { ENTER(); pg8::Gemm g{(const bf16*)(ws + WS_Z) + ZQ, (const bf16*)WL(WSM_WOA), ZC, 1024, 1024}; pg8::StaticOrder S; S.init(nrow, 1024, G, wg); epi::Store E{(bf16*)(ws + WS_Y), 3072, nullptr, 0, 1024}; pg8::gemm_phase<epi::Store, pg8::StaticOrder>(lds, g, S, E, g_wave); }
            { ENTER(); pg8::Gemm g{(const bf16*)(ws + WS_Z) + ZGR, (const bf16*)WL(WSM_WOR), ZC, 1024, 1024}; pg8::StaticOrder S; S.init(nrow, 1024, G, wg); epi::Store E{(bf16*)(ws + WS_Y) + 1024, 3072, nullptr, 0, 1024}; pg8::gemm_phase<epi::Store, pg8::StaticOrder>(lds, g, S, E, g_wave); }
            { ENTER(); pg8::Gemm g{(const bf16*)(ws + WS_Z) + ZXC, (const bf16*)WL(WSM_WOF), ZC, 1024, 1024}; pg8::StaticOrder S; S.init(nrow, 1024, G, wg); epi::Store E{(bf16*)(ws + WS_Y) + 2048, 3072, nullptr, 0, 1024}; pg8::gemm_phase<epi::Store, pg8::StaticOrder>(lds, g, S, E, g_wave); }
        }
        SEAM(pb + 4);
        if (IN(pb + 5)) FORREP(NREP(6)) { ENTER(); pg8::Gemm g{(const bf16*)(ws + WS_U), (const bf16*)WL(WSM_WM), 1024, 1024, 1024}; pg8::MergeOrder S; S.init(nrow, G, wg); epi::Merge E{(bf16*)(ws + WS_M), (const bf16*)(ws + WS_Y), P.in[19] + l * 3072};
            pg8::gemm_phase<epi::Merge, pg8::MergeOrder>(lds, g, S, E, g_wave); }
        SEAM(pb + 5);
        if (IN(pb + 6)) FORREP(NREP(7)) { ENTER(); pg8::Gemm g{(const bf16*)(ws + WS_M), (const bf16*)WL(WSM_WOUT), 1024, 1024, 1024}; pg8::StaticOrder S; S.init(nrow, 1024, G, wg);
            epi::Out E{(float*)(ws + WS_T), l == 0 ? P.in[0] : (const float*)P.out, l == 0 ? P.in[2] : (const float*)(ws + WS_X2C), MODS(l)};
            pg8::gemm_phase<epi::Out, pg8::StaticOrder>(lds, g, S, E, g_wave); }
        SEAM(pb + 6);
        if (IN(pb + 7)) FORREP(NREP(8)) { ENTER(); rowp::LnArgs A{rep != 0, (bool)((F8_LAYERS >> l) & 1u), (float*)(ws + WS_T), (bf16*)(ws + WS_U), P.in[21] + l * 1024, P.in[22] + l * 1024, MODS(l), (const bf16*)WL(WSM_WRH), (const bf16*)WL(WSM_WRL), P.in[24] + l * 32,
                (int*)(ws + WS_ASGE), (int*)(ws + WS_ASGP), (float*)(ws + WS_ASGG), (int*)(ws + WS_WGC)};
            rowp::ln_router_phase(lds, A, nrow, wg, G, g_wave); }
        SEAM(pb + 7);
        if (IN(pb + 8)) FORREP(NREP(9)) { ENTER(); rowp::moe_tables(lds, (const int*)(ws + WS_WGC), wg, G, g_wave);
            rowp::gather_phase(lds, (bool)((F8_LAYERS >> l) & 1u), (const bf16*)(ws + WS_U), (bf16*)(ws + WS_Z), (const int*)(ws + WS_ASGE), (const int*)(ws + WS_ASGP), (int*)(ws + WS_ASGS), nrow, wg, G, g_wave); }
        SEAM(pb + 8);
        if (IN(pb + 9)) FORREP(NREP(10)) { ENTER(); if (!IN(pb + 8)) rowp::moe_tables(lds, (const int*)(ws + WS_WGC), wg, G, g_wave);
            pg8::MoeOrder<8> S{G, wg, __builtin_amdgcn_readfirstlane(*(const LAS int*)(lds + LM_NT)), (const LAS unsigned short*)(lds + LM_TE)};
            if ((F8_LAYERS >> l) & 1u) { pg8::Gemm g{(const bf16*)(ws + WS_Z), (const bf16*)(ws + WS_WGU), 512, 512, 512};
                epi::Swiglu<true> E{(bf16*)(ws + WS_Y), P.in[26] + (size_t)l * NEXP * 2048, 127 - F8_WGU_SHIFT}; pg8::gemm_phase<epi::Swiglu<true>, pg8::MoeOrder<8>, true>(lds, g, S, E, g_wave); }
            else { pg8::Gemm g{(const bf16*)(ws + WS_Z), (const bf16*)(ws + WS_WGU), 1024, 1024, 1024};
                epi::Swiglu<false> E{(bf16*)(ws + WS_Y), P.in[26] + (size_t)l * NEXP * 2048, 0}; pg8::gemm_phase<epi::Swiglu<false>, pg8::MoeOrder<8>, false>(lds, g, S, E, g_wave); } }
        SEAM(pb + 9);
        if (IN(pb + 10)) FORREP(NREP(11)) { ENTER(); if (!IN(pb + 9)) rowp::moe_tables(lds, (const int*)(ws + WS_WGC), wg, G, g_wave);
            pg8::MoeOrder<4> S{G, wg, __builtin_amdgcn_readfirstlane(*(const LAS int*)(lds + LM_NT)), (const LAS unsigned short*)(lds + LM_TE)};
            if ((F8_LAYERS >> l) & 1u) { pg8::Gemm g{(const bf16*)(ws + WS_Y), (const bf16*)(ws + WS_WDN), 512, 512, 512};
                epi::Store E{(bf16*)(ws + WS_Z), 1024, P.in[28] + (size_t)l * NEXP * 1024, 127 - F8_WDN_SHIFT, 1024}; pg8::gemm_phase<epi::Store, pg8::MoeOrder<4>, true>(lds, g, S, E, g_wave); }
            else { pg8::Gemm g{(const bf16*)(ws + WS_Y), (const bf16*)(ws + WS_WDN), 1024, 1024, 1024};
                epi::Store E{(bf16*)(ws + WS_Z), 1024, P.in[28] + (size_t)l * NEXP * 1024, 0, 1024}; pg8::gemm_phase<epi::Store, pg8::MoeOrder<4>, false>(lds, g, S, E, g_wave); } }
        SEAM(pb + 10);
        if (IN(pb + 11)) FORREP(NREP(12)) { ENTER(); const int tid = fresh_tid(); const int wave = __builtin_amdgcn_readfirstlane(tid >> 6);
            rowp::CombArgs A{(const float*)(ws + WS_T), (const bf16*)(ws + WS_Z), (const int*)(ws + WS_ASGS), (const float*)(ws + WS_ASGG), MODS(l), P.in[29] + l * 1024, P.in[30] + l * 1024, P.out, (float*)(ws + WS_X2C),
                last ? nullptr : (bf16*)(ws + WS_U), MODS(last ? l : l + 1)};
            rowp::combine_phase(A, nrow, wg * NWAVES + wave, G * NWAVES, tid & 63);
            if (!last) convert_moe(P, l + 1, lds, wg * NWAVES + wave, G * NWAVES, wave, tid & 63); }
        if (!last) SEAM(pb + 11);
    }
#undef IN
#undef SEAM
}

extern "C" void kernel_launch(void* const* d_in, const int* in_sizes, int n_in, void* d_out, int out_size, void* d_ws, size_t ws_size, hipStream_t stream) {
    static int grid = 0;
    if (grid == 0) {
        if (n_in != 31 || in_sizes[0] != NLAT * D || out_size != NLAT * D || ws_size < WS_END) { fprintf(stderr, "kernel_launch: unexpected shapes / workspace (n_in %d, ws %zu < %zu)\n", n_in, ws_size, (size_t)WS_END); grid = -1; return; }
        int dev = 0, cus = 0, per_cu = 0;
        if (hipGetDevice(&dev) != hipSuccess || hipDeviceGetAttribute(&cus, hipDeviceAttributeMultiprocessorCount, dev) != hipSuccess) { grid = -1; return; }
        if (hipFuncSetAttribute((const void*)mega, hipFuncAttributeMaxDynamicSharedMemorySize, LDS_BYTES) != hipSuccess) { fprintf(stderr, "kernel_launch: hipFuncSetAttribute failed\n"); grid = -1; return; }
        if (hipOccupancyMaxActiveBlocksPerMultiprocessor(&per_cu, (const void*)mega, NTHR, LDS_BYTES) != hipSuccess || per_cu < 1) fprintf(stderr, "kernel_launch: occupancy query says %d\n", per_cu);
        (void)hipGetLastError();
        grid = cus;
    }
    if (grid < 0) return;
    if (hipMemsetAsync((char*)d_ws + WS_CTL, 0, CTL_ZERO_BYTES, stream) != hipSuccess) return;
    KArgs a{};
    for (int i = 0; i < 31; ++i) a.in[i] = (const float*)d_in[i];
    a.out = (float*)d_out; a.ws = (unsigned char*)d_ws;
#if MK_SINGLE
    a.ph_lo = 0; a.ph_hi = N_PHASES;
    hipLaunchKernelGGL(mega, dim3(grid), dim3(NTHR), LDS_BYTES, stream, a);
#else
    for (int p = 0; p < N_PHASES; ++p) { a.ph_lo = p; a.ph_hi = p + 1; hipLaunchKernelGGL(mega, dim3(grid), dim3(NTHR), LDS_BYTES, stream, a); }
#endif
}
```

```cpp
#include <hip/hip_runtime.h>
#include <cstdio>
#include <cstdint>

#ifndef MK_SINGLE
#define MK_SINGLE 1
#endif

#define GAS __attribute__((address_space(1)))
#define LAS __attribute__((address_space(3)))
typedef unsigned short bf16;
typedef short bf16x8 __attribute__((ext_vector_type(8)));
typedef short s16x4 __attribute__((ext_vector_type(4)));
typedef float f32x2 __attribute__((ext_vector_type(2)));
typedef float f32x4 __attribute__((ext_vector_type(4)));
typedef float f32x16 __attribute__((ext_vector_type(16)));
typedef unsigned u32x2 __attribute__((ext_vector_type(2)));
typedef unsigned u32x4 __attribute__((ext_vector_type(4)));
typedef LAS unsigned char* ldsp;

constexpr int NB = 8, SEQ = 8192, D = 1024, CTXL = 256, DEPTH = 2;
constexpr int NLAT = NB * SEQ, NCTX = NB * CTXL, NROW = NLAT + NCTX;
constexpr int IN_COLS = 4608;
constexpr int ZC = 5632, ZQ = 0, ZK = 1024, ZV = 1280, ZGR = 1536, ZXR = 2560, ZXC = 3584, ZXS = 4608;
constexpr int NEXP = 32, TOPK = 4, DFF = 1024;
constexpr int NSLOT = 278528;
constexpr int NCHUNK = (SEQ + CTXL) / 64;
constexpr float LN_EPS = 1e-5f, DN_ALPHA = 1.41421356237309515f;
constexpr float ATT_C2 = 0.125f * 1.4426950408889634f;
constexpr int NWAVES = 8, NTHR = 512;
#ifndef F8_LAYERS
#define F8_LAYERS 3u
#endif
#ifndef F8_MERGE
#define F8_MERGE 0
#endif
constexpr int F8_WGU_SHIFT = 6, F8_WDN_SHIFT = 7, F8_WM_SHIFT = 6;
typedef int v8i __attribute__((ext_vector_type(8)));

constexpr size_t MiB = 1u << 20;
constexpr size_t WS_CTL = 0, CTL_ZERO_BYTES = 1 * MiB;
constexpr size_t WS_MODS = 1 * MiB;
constexpr size_t WS_ROPE = WS_MODS + 512 * 1024;
constexpr size_t WS_TW   = WS_ROPE + 16 * 1024;
constexpr size_t WS_SP   = WS_TW + 64 * 1024;
constexpr size_t WS_FC   = WS_SP + 16 * 1024;
constexpr size_t WS_F1   = WS_FC + 256 * 1024;
constexpr size_t WS_F2   = WS_F1 + 128 * 1024;
constexpr size_t WS_F256 = WS_F2 + 16 * 1024;
constexpr size_t WS_WGC  = WS_F256 + 256 * 1024;
constexpr size_t WS_ASGE = 3 * MiB;
constexpr size_t WS_ASGP = WS_ASGE + 2 * MiB;
constexpr size_t WS_ASGG = WS_ASGP + 2 * MiB;
constexpr size_t WS_ASGS = WS_ASGG + 2 * MiB;
constexpr size_t WS_SUM  = 12 * MiB;
constexpr size_t WS_X2C  = 30 * MiB;
constexpr size_t WS_U8 = 1980 * MiB;
constexpr size_t WS_CARRY = 1971 * MiB;
constexpr size_t WS_WSM  = 41 * MiB;
constexpr size_t WSM_LAYER = 32 * MiB;
constexpr size_t WSM_WIN = 0;
constexpr size_t WSM_WXF = 11 * MiB;
constexpr size_t WSM_WOA = 13 * MiB, WSM_WOR = 15 * MiB, WSM_WOF = 17 * MiB, WSM_WOUT = 19 * MiB;
constexpr size_t WSM_WM  = 21 * MiB;
constexpr size_t WSM_WRH = 27 * MiB, WSM_WRL = WSM_WRH + 64 * 1024;
constexpr size_t WSM_WM8 = 29 * MiB;
constexpr size_t WSM_WG  = 28 * MiB;
constexpr size_t WS_WGU  = 105 * MiB;
constexpr size_t WS_WDN  = 233 * MiB;
constexpr size_t WS_U    = 297 * MiB;
constexpr size_t WS_T    = 429 * MiB;
constexpr size_t WS_Z    = 693 * MiB;
constexpr size_t WS_Y    = 1419 * MiB;
constexpr size_t WS_M    = WS_Y + 396 * MiB;
constexpr size_t WS_END  = 2046 * MiB;
static_assert((size_t)NROW * ZC * 2 <= 726 * MiB && (size_t)NSLOT * 1024 * 2 <= 544 * MiB && (size_t)NROW * 3072 * 2 <= 396 * MiB && (size_t)NROW * 2048 * 2 <= 264 * MiB, "ws map");
constexpr int CW_TMO = 0, CW_BAR = 4096;

constexpr int RING_BYTES = 131072;
constexpr int LM_XB = RING_BYTES;
constexpr int LM_CNT = RING_BYTES + 64;
constexpr int LM_PST = LM_CNT + 128;
constexpr int LM_MYB = LM_PST + 144;
constexpr int LM_NT  = LM_MYB + 128;
constexpr int LM_TE  = LM_NT + 16;
constexpr int LDS_BYTES = 147456;

#define LDS_WAIT() asm volatile("s_waitcnt lgkmcnt(0)" ::: "memory")
#define VM_WAIT() asm volatile("s_waitcnt vmcnt(0)" ::: "memory")
typedef float f32x2_cv __attribute__((ext_vector_type(2))); typedef __bf16 bf16x2_cv __attribute__((ext_vector_type(2)));
__device__ __forceinline__ unsigned pk2(float lo, float hi) { const f32x2_cv v = {lo, hi}; const bf16x2_cv b = __builtin_convertvector(v, bf16x2_cv); return __builtin_bit_cast(unsigned, b); }
__device__ __forceinline__ unsigned f2bf(float f) { return pk2(f, 0.0f) & 0xffffu; }
__device__ __forceinline__ float bf2f(unsigned h) { return __builtin_bit_cast(float, h << 16); }
__device__ __forceinline__ float wave_sum(float v) {
#pragma unroll
    for (int o = 1; o < 64; o <<= 1) v += __shfl_xor(v, o);
    return v;
}
__device__ __forceinline__ float sigmoidf_(float x) { return __builtin_amdgcn_rcpf(1.0f + __builtin_amdgcn_exp2f(-1.4426950408889634f * x)); }
__device__ __forceinline__ float gelu_tanh(float x) { const float u = 0.7978845608028654f * (x + 0.044715f * x * x * x); return x * sigmoidf_(2.0f * u); }
__device__ __forceinline__ float silu_(float x) { return x * sigmoidf_(x); }

__device__ __forceinline__ int fresh_tid_w(int wave_sgpr) { int w = wave_sgpr; asm volatile("" : "+s"(w)); int t = w * 64 + (int)__builtin_amdgcn_mbcnt_hi(~0u, __builtin_amdgcn_mbcnt_lo(~0u, 0u)); asm volatile("" : "+v"(t)); return t; }
#define fresh_tid() fresh_tid_w(g_wave)
namespace pg8 {
#define PG8_LAS __attribute__((address_space(3)))
typedef unsigned short bf16_t;
constexpr int BM = 256, BK = 64, HALF = 128, HTB = HALF * BK * 2, STAGE_BYTES = 8 * HTB, NXCD = 8, WGM = 8;
__host__ __device__ __forceinline__ int lds_byte(int r, int c) { const int st = (r >> 4) * 2 + (c >> 5), rr = r & 15, cc = c & 31, ob = rr * 64 + cc * 2; return st * 1024 + (ob ^ (((ob >> 9) & 1) << 5)); }
__host__ __device__ __forceinline__ void stage_rc(int b, int& R, int& C) { const int st = b / 1024, sb = b % 1024, swz = sb ^ (((sb >> 9) & 1) << 5); R = (st >> 1) * 16 + swz / 64; C = (st & 1) * 32 + (swz % 64) / 2; }
__host__ __device__ __forceinline__ int perm32(int rho) { const int n = rho >> 4, i = rho & 15; return 8 * (i >> 2) + 4 * n + (i & 3); }

struct Unit { int pm, pn; };
struct Gemm { const bf16_t* A; const bf16_t* Bt; int lda, ldb, K; };

struct StaticOrder {
    int nM, nN, nwg, G, c;
    __device__ void init(int M, int N, int G_, int c_) { nM = M / BM; nN = N / BM; nwg = nM * nN; G = G_; c = c_; }
    __device__ bool next(int i, Unit& u) const {
        const long L = (long)i * G + c; if (L >= nwg) return false;
        int wgid = (int)L; { const int q = nwg / NXCD, r = nwg % NXCD, xcd = wgid % NXCD, off = wgid / NXCD; wgid = (xcd < r ? xcd * (q + 1) : r * (q + 1) + (xcd - r) * q) + off; }
        const int nig = WGM * nN, gid = wgid / nig, fm = gid * WGM, gsz = (nM - fm) < WGM ? (nM - fm) : WGM;
        u.pm = fm + ((wgid % nig) % gsz); u.pn = (wgid % nig) / gsz; return true;
    }
    __device__ __forceinline__ const char* a_ptr(const Gemm& g, const Unit& u) const { return (const char*)g.A + (size_t)u.pm * BM * g.lda * 2; }
    __device__ __forceinline__ const char* b_ptr(const Gemm& g, const Unit& u) const { return (const char*)g.Bt + (size_t)u.pn * BM * g.ldb * 2; }
};
struct MergeOrder {
    StaticOrder s;
    __device__ void init(int M, int G_, int c_) { s.init(M, 1024, G_, c_); }
    __device__ bool next(int i, Unit& u) const { const int j = i / 3, br = i - 3 * j; Unit t; if (!s.next(j, t)) return false; u.pm = t.pm; u.pn = br * 4 + t.pn; return true; }
    __device__ __forceinline__ const char* a_ptr(const Gemm& g, const Unit& u) const { return (const char*)g.A + (size_t)u.pm * BM * g.lda * 2; }
    __device__ __forceinline__ const char* b_ptr(const Gemm& g, const Unit& u) const { return (const char*)g.Bt + (size_t)u.pn * BM * g.ldb * 2; }
};
struct FoldOrder {
    int G, c;
    __device__ bool next(int i, Unit& u) const { const int L = i * G + c; if (L >= 32) return false; u.pm = L & 1; u.pn = L >> 1; return true; }
    __device__ __forceinline__ const char* a_ptr(const Gemm& g, const Unit& u) const { return (const char*)g.A + (size_t)u.pm * BM * g.lda * 2; }
    __device__ __forceinline__ const char* b_ptr(const Gemm& g, const Unit& u) const { const int grp = u.pn >> 2, dn = u.pn & 3; return (const char*)g.Bt + ((size_t)dn * BM * g.ldb + grp * 256) * 2; }
};
template <int NPN> struct MoeOrder {
    int G, c, nt; const PG8_LAS unsigned short* te;
    __device__ bool next(int i, Unit& u) const { const int x = c & 7, slot = c >> 3, per = G >> 3; const int Lx = i * per + slot; const int rl = Lx / NPN, pn = Lx - rl * NPN, rt = rl * 8 + x;
        if (rt >= nt) return false; u.pm = rt; u.pn = __builtin_amdgcn_readfirstlane((int)te[rt]) * NPN + pn; return true; }
    __device__ __forceinline__ const char* a_ptr(const Gemm& g, const Unit& u) const { return (const char*)g.A + (size_t)u.pm * BM * g.lda * 2; }
    __device__ __forceinline__ const char* b_ptr(const Gemm& g, const Unit& u) const { return (const char*)g.Bt + (size_t)u.pn * BM * g.ldb * 2; }
};

typedef float f32x2_c __attribute__((ext_vector_type(2))); typedef __bf16 bf16x2_c __attribute__((ext_vector_type(2)));
__device__ __forceinline__ unsigned cvt_pk_bf16(float lo, float hi) { const f32x2_c v = {lo, hi}; const bf16x2_c b = __builtin_convertvector(v, bf16x2_c); return __builtin_bit_cast(unsigned, b); }

template <class Epi, class Sched, bool F8 = false>
__device__ __forceinline__ void gemm_phase(PG8_LAS unsigned char* lds, const Gemm g, const Sched& S, const Epi& E, int g_wave) {
    const int tid = fresh_tid(), wid = __builtin_amdgcn_readfirstlane(tid >> 6), lane = tid & 63, wr = wid >> 2, wc = wid & 3, fr = lane & 15, fq = lane >> 4;
    const int K = g.K, nt = K / BK;
    unsigned voffA[2], voffB[2];
#pragma unroll
    for (int i = 0; i < 2; ++i) { int R, C; stage_rc(tid * 16 + i * 8192, R, C); const int Rb = Epi::PERM ? ((R & ~31) + perm32(R & 31)) : R;
        voffA[i] = (unsigned)(R * g.lda + C) * 2u; voffB[i] = (unsigned)(Rb * g.ldb + C) * 2u; }
    const size_t kstep = (size_t)(BK * 2);
    const size_t hstepA = (size_t)HALF * g.lda * 2, hstepB = (size_t)HALF * g.ldb * 2;
    const unsigned ldsw = (unsigned)wid * 1024u; const unsigned ldsbase = (unsigned)(uintptr_t)lds;
    const int aoff = lds_byte(wr * 64 + fr, fq * 8), boff = lds_byte(wc * 32 + fr, fq * 8);
#define PG8_SA(b, h) (((b) * 2 + (h)) * HTB)
#define PG8_SB(b, h) ((4 + (b) * 2 + (h)) * HTB)
#define PG8_STAGE(bufoff, gbase, voff) do { _Pragma("unroll") for (int _i = 0; _i < 2; ++_i) { unsigned _keep; \
        asm volatile("s_mov_b32 %0, m0\n\ts_mov_b32 m0, %3\n\ts_nop 3\n\tglobal_load_lds_dwordx4 %1, %2\n\ts_mov_b32 m0, %0" : "=&s"(_keep) : "v"((voff)[_i]), "s"((const char*)(gbase)), \
                     "s"((unsigned)__builtin_amdgcn_readfirstlane((int)(ldsbase + (unsigned)(bufoff) + ldsw + _i * 8192))) : "memory"); } } while (0)
#define PG8_LDA(dst, b, h) do { _Pragma("unroll") for (int m = 0; m < 4; ++m) _Pragma("unroll") for (int k = 0; k < 2; ++k) dst[m][k] = *(const PG8_LAS bf16x8*)(lds + PG8_SA(b, h) + aoff + m * 2048 + k * 1024); } while (0)
#define PG8_LDB(dst, b, h) do { _Pragma("unroll") for (int n = 0; n < 2; ++n) _Pragma("unroll") for (int k = 0; k < 2; ++k) dst[n][k] = *(const PG8_LAS bf16x8*)(lds + PG8_SB(b, h) + boff + n * 2048 + k * 1024); } while (0)
#define PG8_MMA(ai, bj, At, Bt) do { __builtin_amdgcn_s_setprio(1); _Pragma("unroll") for (int m = 0; m < 4; ++m) _Pragma("unroll") for (int n = 0; n < 2; ++n) _Pragma("unroll") for (int k = 0; k < 2; ++k) \
        acc[ai][bj][m][n] = __builtin_amdgcn_mfma_f32_16x16x32_bf16(Bt[n][k], At[m][k], acc[ai][bj][m][n], 0, 0, 0); __builtin_amdgcn_s_setprio(0); } while (0)
#define PG8_CAT(x, y) __builtin_shufflevector(__builtin_bit_cast(u32x4, x), __builtin_bit_cast(u32x4, y), 0, 1, 2, 3, 4, 5, 6, 7)
#define PG8_MMA8(ai, bj, At, Bt) do { __builtin_amdgcn_s_setprio(1); _Pragma("unroll") for (int m = 0; m < 4; ++m) _Pragma("unroll") for (int n = 0; n < 2; ++n) { \
        const v8i _wa = __builtin_bit_cast(v8i, PG8_CAT(Bt[n][0], Bt[n][1])), _xa = __builtin_bit_cast(v8i, PG8_CAT(At[m][0], At[m][1])); \
        asm volatile("v_mfma_scale_f32_16x16x128_f8f6f4 %0, %1, %2, %0, %3, %4 op_sel_hi:[0,0,0]" : "+v"(acc[ai][bj][m][n]) : "v"(_wa), "v"(_xa), "v"(f8sw), "v"(f8s1)); } \
        __builtin_amdgcn_s_setprio(0); } while (0)
#define PG8_MM(ai, bj, At, Bt) do { if constexpr (F8) PG8_MMA8(ai, bj, At, Bt); else PG8_MMA(ai, bj, At, Bt); } while (0)
#define PG8_WAIT_V(n) asm volatile("s_waitcnt vmcnt(" #n ")" ::: "memory")
#define PG8_WAIT_L(n) asm volatile("s_waitcnt lgkmcnt(" #n ")" ::: "memory")
#define PG8_BAR __builtin_amdgcn_s_barrier()
#define PG8_SCHED __builtin_amdgcn_sched_barrier(0)
    Unit cur, nxt; int ui = 0;
    if (!S.next(0, cur)) return;
    f32x4 acc[2][2][4][2];
#pragma unroll
    for (int a = 0; a < 2; ++a)
#pragma unroll
        for (int b = 0; b < 2; ++b)
#pragma unroll
            for (int m = 0; m < 4; ++m)
#pragma unroll
                for (int n = 0; n < 2; ++n) { acc[a][b][m][n] = (f32x4){0.f, 0.f, 0.f, 0.f}; if constexpr (F8) asm volatile("" : "+v"(acc[a][b][m][n])); }
    bf16x8 At[4][2], B0[2][2], B1[2][2];
    int f8sw = 127, f8s1 = 127; if constexpr (F8) { f8sw = E.f8_scale_w; asm volatile("" : "+v"(f8sw), "+v"(f8s1)); }
    const char* cA = S.a_ptr(g, cur); const char* cB = S.b_ptr(g, cur);
    PG8_STAGE(PG8_SB(0, 0), cB, voffB); PG8_STAGE(PG8_SB(0, 1), cB + hstepB, voffB); PG8_STAGE(PG8_SA(0, 0), cA, voffA); PG8_STAGE(PG8_SA(0, 1), cA + hstepA, voffA);
    if (wr == 1) PG8_BAR;
    PG8_WAIT_V(2); PG8_BAR;
    PG8_STAGE(PG8_SB(1, 0), cB + kstep, voffB); PG8_STAGE(PG8_SA(1, 0), cA + kstep, voffA); PG8_STAGE(PG8_SB(1, 1), cB + hstepB + kstep, voffB);
    PG8_WAIT_V(6); PG8_BAR;
    for (;;) {
        const bool has_next = S.next(ui + 1, nxt);
        const char* nA = has_next ? S.a_ptr(g, nxt) : cA; const char* nB = has_next ? S.b_ptr(g, nxt) : cB;
#pragma unroll 1
        for (int t = 0; t < nt; t += 2) {
            const bool last = (t == nt - 2);
            const char* a1 = cA + (size_t)(t + 1) * kstep;
            const char* a2 = last ? nA : cA + (size_t)(t + 2) * kstep; const char* b2 = last ? nB : cB + (size_t)(t + 2) * kstep;
            const char* a3 = a2 + kstep; const char* b3 = b2 + kstep;
            PG8_LDB(B0, 0, 0); PG8_LDB(B1, 0, 1); PG8_SCHED; PG8_LDA(At, 0, 0); PG8_STAGE(PG8_SA(1, 1), a1 + hstepA, voffA);
            PG8_WAIT_V(8); PG8_WAIT_L(0); PG8_BAR; PG8_MM(0, 0, At, B0); PG8_MM(0, 1, At, B1); PG8_BAR; PG8_SCHED;
            PG8_LDA(At, 0, 1); PG8_STAGE(PG8_SB(0, 0), b2, voffB); PG8_STAGE(PG8_SB(0, 1), b2 + hstepB, voffB); PG8_STAGE(PG8_SA(0, 0), a2, voffA);
            PG8_WAIT_V(8); PG8_WAIT_L(0); PG8_BAR; PG8_MM(1, 0, At, B0); PG8_MM(1, 1, At, B1); PG8_BAR; PG8_SCHED;
            PG8_LDB(B0, 1, 0); PG8_LDB(B1, 1, 1); PG8_SCHED; PG8_LDA(At, 1, 0); PG8_STAGE(PG8_SA(0, 1), a2 + hstepA, voffA);
            PG8_WAIT_V(8); PG8_WAIT_L(0); PG8_BAR; PG8_MM(0, 0, At, B0); PG8_MM(0, 1, At, B1); PG8_BAR; PG8_SCHED;
            PG8_LDA(At, 1, 1); PG8_STAGE(PG8_SB(1, 0), b3, voffB); PG8_STAGE(PG8_SB(1, 1), b3 + hstepB, voffB); PG8_STAGE(PG8_SA(1, 0), a3, voffA);
            PG8_WAIT_V(8); PG8_WAIT_L(0); PG8_BAR; PG8_MM(1, 0, At, B0); PG8_MM(1, 1, At, B1); PG8_BAR; PG8_SCHED;
        }
        if (wr == 0) PG8_BAR;
        if constexpr (F8) {
#pragma unroll
            for (int a = 0; a < 2; ++a)
#pragma unroll
                for (int b = 0; b < 2; ++b) { if (a == 0 && b == 0) asm volatile("s_nop 15\n\ts_nop 3" : "+v"(acc[0][0][0][0]), "+v"(acc[0][0][0][1]), "+v"(acc[0][0][1][0]), "+v"(acc[0][0][1][1]), "+v"(acc[0][0][2][0]), "+v"(acc[0][0][2][1]), "+v"(acc[0][0][3][0]), "+v"(acc[0][0][3][1]));
                    else asm volatile("" : "+v"(acc[a][b][0][0]), "+v"(acc[a][b][0][1]), "+v"(acc[a][b][1][0]), "+v"(acc[a][b][1][1]), "+v"(acc[a][b][2][0]), "+v"(acc[a][b][2][1]), "+v"(acc[a][b][3][0]), "+v"(acc[a][b][3][1])); } }
        E(acc, cur, wr, wc, fr, fq);
        if (!has_next) break;
#pragma unroll
        for (int a = 0; a < 2; ++a)
#pragma unroll
            for (int b = 0; b < 2; ++b)
#pragma unroll
                for (int m = 0; m < 4; ++m)
#pragma unroll
                    for (int n = 0; n < 2; ++n) { acc[a][b][m][n] = (f32x4){0.f, 0.f, 0.f, 0.f}; if constexpr (F8) asm volatile("" : "+v"(acc[a][b][m][n])); }
        cur = nxt; cA = nA; cB = nB; ++ui;
        if (wr == 1) PG8_BAR;
    }
    PG8_WAIT_V(0);
    PG8_BAR;
#undef PG8_SA
#undef PG8_SB
#undef PG8_STAGE
#undef PG8_LDA
#undef PG8_LDB
#undef PG8_MMA
#undef PG8_MMA8
#undef PG8_MM
#undef PG8_CAT
#undef PG8_WAIT_V
#undef PG8_WAIT_L
#undef PG8_BAR
#undef PG8_SCHED
}
}
namespace epi {
using pg8::Unit; using pg8::cvt_pk_bf16; constexpr int HALF = 128, BM = 256;
struct Store {
    static constexpr bool PERM = true;
    bf16* O; int ldc; const float* bias;
    int f8_scale_w;
    int ncol_out;
    __device__ __forceinline__ void operator()(const f32x4 (&acc)[2][2][4][2], const Unit& u, int wr, int wc, int fr, int fq) const {
        const int row0 = u.pm * BM + wr * 64 + fr; const int gcol0 = u.pn * BM + wc * 32 + 8 * fq; const int col0 = gcol0 % ncol_out;
        f32x4 bv[2][2];
#pragma unroll
        for (int bj = 0; bj < 2; ++bj)
#pragma unroll
            for (int n = 0; n < 2; ++n) bv[bj][n] = bias ? *(const f32x4*)(bias + gcol0 + bj * HALF + 4 * n) : (f32x4){0.f, 0.f, 0.f, 0.f};
#pragma unroll
        for (int ai = 0; ai < 2; ++ai)
#pragma unroll
            for (int m = 0; m < 4; ++m) { bf16* rowp = O + (size_t)(row0 + ai * HALF + m * 16) * ldc + col0;
#pragma unroll
                for (int bj = 0; bj < 2; ++bj) { const f32x4 v0 = acc[ai][bj][m][0] + bv[bj][0], v1 = acc[ai][bj][m][1] + bv[bj][1];
                    u32x4 w; w.x = cvt_pk_bf16(v0[0], v0[1]); w.y = cvt_pk_bf16(v0[2], v0[3]); w.z = cvt_pk_bf16(v1[0], v1[1]); w.w = cvt_pk_bf16(v1[2], v1[3]);
                    *(u32x4*)(rowp + bj * HALF) = w; } }
    }
};
struct In {
    static constexpr bool PERM = false;
    bf16* Z; const f32x2* rope;
    __device__ __forceinline__ void operator()(const f32x4 (&acc)[2][2][4][2], const Unit& u, int wr, int wc, int fr, int fq) const {
        const int row0 = u.pm * BM + wr * 64 + fr; const int col0 = u.pn * BM + wc * 32 + 4 * fq;
        const bool isq = u.pn < 4, dorope = (u.pn <= 4) && (u.pm * BM < NLAT);
        const float sc = isq ? ATT_C2 : 1.0f;
#pragma unroll
        for (int ai = 0; ai < 2; ++ai)
#pragma unroll
            for (int m = 0; m < 4; ++m) { const int row = row0 + ai * HALF + m * 16; bf16* rowp = Z + (size_t)row * ZC + col0;
                f32x4 cs0 = {1.f, 0.f, 1.f, 0.f}, cs1 = {1.f, 0.f, 1.f, 0.f};
                if (dorope) { const int t = row & (SEQ - 1); const int pos = (wc & 1) ? (t & 63) : (t >> 6); const f32x4* rp = (const f32x4*)(rope + pos * 16 + 4 * fq); cs0 = rp[0]; cs1 = rp[1]; }
#pragma unroll
                for (int bj = 0; bj < 2; ++bj) { const f32x4 x1 = acc[ai][bj][m][0], x2 = acc[ai][bj][m][1];
                    f32x4 o1, o2;
                    o1[0] = x1[0] * cs0[0] - x2[0] * cs0[1]; o2[0] = x2[0] * cs0[0] + x1[0] * cs0[1];
                    o1[1] = x1[1] * cs0[2] - x2[1] * cs0[3]; o2[1] = x2[1] * cs0[2] + x1[1] * cs0[3];
                    o1[2] = x1[2] * cs1[0] - x2[2] * cs1[1]; o2[2] = x2[2] * cs1[0] + x1[2] * cs1[1];
                    o1[3] = x1[3] * cs1[2] - x2[3] * cs1[3]; o2[3] = x2[3] * cs1[2] + x1[3] * cs1[3];
                    o1 = o1 * sc; o2 = o2 * sc;
                    u32x2 w1, w2; w1.x = cvt_pk_bf16(o1[0], o1[1]); w1.y = cvt_pk_bf16(o1[2], o1[3]); w2.x = cvt_pk_bf16(o2[0], o2[1]); w2.y = cvt_pk_bf16(o2[2], o2[3]);
                    *(u32x2*)(rowp + bj * HALF) = w1; *(u32x2*)(rowp + bj * HALF + 16) = w2; }
                asm volatile("" ::: "memory"); }
    }
};
struct Merge {
    static constexpr bool PERM = true;
    bf16* Mg; const bf16* Y; const float* bm; int f8_scale_w;
    __device__ __forceinline__ void operator()(const f32x4 (&acc)[2][2][4][2], const Unit& u, int wr, int wc, int fr, int fq) const {
        const int br = u.pn >> 2, pn = u.pn & 3;
        const int row0 = u.pm * BM + wr * 64 + fr; const int col0 = pn * BM + wc * 32 + 8 * fq;
        f32x4 bv[2][2];
#pragma unroll
        for (int bj = 0; bj < 2; ++bj)
#pragma unroll
            for (int n = 0; n < 2; ++n) bv[bj][n] = *(const f32x4*)(bm + br * 1024 + col0 + bj * HALF + 4 * n);
        u32x4 yb[2][2], mb[2][2];
#define MG_LOAD(g, p) do { const size_t row_ = (size_t)(row0 + ((g) >> 2) * HALF + ((g) & 3) * 16); _Pragma("unroll") for (int bj = 0; bj < 2; ++bj) { const int col_ = col0 + bj * HALF; \
            yb[p][bj] = *(const u32x4*)(Y + row_ * 3072 + br * 1024 + col_); if (br) { const unsigned long long* mp_ = (const unsigned long long*)(Mg + row_ * 1024 + col_);     \
                const unsigned long long q0_ = __hip_atomic_load(mp_, __ATOMIC_RELAXED, __HIP_MEMORY_SCOPE_AGENT), q1_ = __hip_atomic_load(mp_ + 1, __ATOMIC_RELAXED, __HIP_MEMORY_SCOPE_AGENT); \
                mb[p][bj] = (u32x4){(unsigned)q0_, (unsigned)(q0_ >> 32), (unsigned)q1_, (unsigned)(q1_ >> 32)}; } else mb[p][bj] = (u32x4){0u, 0u, 0u, 0u}; } } while (0)
        MG_LOAD(0, 0);
#pragma unroll
        for (int g = 0; g < 8; ++g) { const int ai = g >> 2, m = g & 3, p = g & 1; const size_t row = (size_t)(row0 + ai * HALF + m * 16);
            if (g < 7) MG_LOAD(g + 1, p ^ 1);
#pragma unroll
            for (int bj = 0; bj < 2; ++bj) { const int col = col0 + bj * HALF; const u32x4 yv = yb[p][bj], mv = mb[p][bj];
                float o[8];
#pragma unroll
                for (int e = 0; e < 8; ++e) { const float a = acc[ai][bj][m][e >> 2][e & 3] + bv[bj][e >> 2][e & 3];
                    const unsigned yw = yv[e >> 1], mw = mv[e >> 1];
                    const float y = (e & 1) ? bf2f(yw >> 16) : bf2f(yw & 0xffffu), mm = (e & 1) ? bf2f(mw >> 16) : bf2f(mw & 0xffffu);
                    o[e] = mm + sigmoidf_(a) * y; }
                u32x4 w; w.x = cvt_pk_bf16(o[0], o[1]); w.y = cvt_pk_bf16(o[2], o[3]); w.z = cvt_pk_bf16(o[4], o[5]); w.w = cvt_pk_bf16(o[6], o[7]);
                *(u32x4*)(Mg + row * 1024 + col) = w; } }
#undef MG_LOAD
    }
};
struct Out {
    static constexpr bool PERM = true;
    float* P; const float* xlat; const float* xctx; const float* mods;
    __device__ __forceinline__ void operator()(const f32x4 (&acc)[2][2][4][2], const Unit& u, int wr, int wc, int fr, int fq) const {
        const int row0 = u.pm * BM + wr * 64 + fr; const int col0 = u.pn * BM + wc * 32 + 8 * fq;
        const int bb = (u.pm * BM < NLAT) ? (u.pm * BM) / SEQ : 8;
        const float* xb = (u.pm * BM < NLAT) ? xlat : (xctx - (size_t)NLAT * D);
        const float* g1 = mods + (size_t)(bb * 6 + 2) * D;
        f32x4 gv[2][2];
#pragma unroll
        for (int bj = 0; bj < 2; ++bj)
#pragma unroll
            for (int n = 0; n < 2; ++n) gv[bj][n] = *(const f32x4*)(g1 + col0 + bj * HALF + 4 * n);
        f32x4 xb2[2][2][2];
#define OUT_LOAD(g, p) do { const size_t off_ = (size_t)(row0 + ((g) >> 2) * HALF + ((g) & 3) * 16) * D + col0; _Pragma("unroll") for (int bj = 0; bj < 2; ++bj) _Pragma("unroll") for (int n = 0; n < 2; ++n) xb2[p][bj][n] = *(const f32x4*)(xb + off_ + bj * HALF + 4 * n); } while (0)
        OUT_LOAD(0, 0);
#pragma unroll
        for (int g = 0; g < 8; ++g) { const int ai = g >> 2, m = g & 3, p = g & 1; const size_t off = (size_t)(row0 + ai * HALF + m * 16) * D + col0;
            if (g < 7) OUT_LOAD(g + 1, p ^ 1);
#pragma unroll
            for (int bj = 0; bj < 2; ++bj)
#pragma unroll
                for (int n = 0; n < 2; ++n) *(f32x4*)(P + off + bj * HALF + 4 * n) = xb2[p][bj][n] * DN_ALPHA + gv[bj][n] * acc[ai][bj][m][n]; }
#undef OUT_LOAD
    }
};
template <bool OUT8> struct Swiglu {
    static constexpr bool PERM = true;
    bf16* ACT; const float* bgu; int f8_scale_w;
    __device__ __forceinline__ void operator()(const f32x4 (&acc)[2][2][4][2], const Unit& u, int wr, int wc, int fr, int fq) const {
        const int e = u.pn >> 3, pn = u.pn & 7;
        const int row0 = u.pm * BM + wr * 64 + fr; const int hc0 = wc * 32 + 8 * fq;
        const float* bg = bgu + e * 2048 + pn * 128 + hc0;
        f32x4 bgl[2], bln[2];
#pragma unroll
        for (int n = 0; n < 2; ++n) { bgl[n] = *(const f32x4*)(bg + 4 * n); bln[n] = *(const f32x4*)(bg + 1024 + 4 * n); }
#pragma unroll
        for (int ai = 0; ai < 2; ++ai)
#pragma unroll
            for (int m = 0; m < 4; ++m) { const size_t eoff = (size_t)(row0 + ai * HALF + m * 16) * DFF + pn * 128 + hc0;
                float o[8];
#pragma unroll
                for (int q = 0; q < 8; ++q) { float gl = acc[ai][0][m][q >> 2][q & 3] + bgl[q >> 2][q & 3], ln = acc[ai][1][m][q >> 2][q & 3] + bln[q >> 2][q & 3];
                    gl = fminf(gl, 7.0f); ln = fminf(fmaxf(ln, -7.0f), 7.0f);
                    o[q] = gl * sigmoidf_(1.702f * gl) * (ln + 1.0f); }
                if constexpr (OUT8) { unsigned w0 = 0u, w1 = 0u;
                    w0 = __builtin_amdgcn_cvt_pk_fp8_f32(o[0], o[1], w0, false); w0 = __builtin_amdgcn_cvt_pk_fp8_f32(o[2], o[3], w0, true);
                    w1 = __builtin_amdgcn_cvt_pk_fp8_f32(o[4], o[5], w1, false); w1 = __builtin_amdgcn_cvt_pk_fp8_f32(o[6], o[7], w1, true);
                    *(u32x2*)((unsigned char*)ACT + eoff) = (u32x2){w0, w1}; }
                else { u32x4 w; w.x = cvt_pk_bf16(o[0], o[1]); w.y = cvt_pk_bf16(o[2], o[3]); w.z = cvt_pk_bf16(o[4], o[5]); w.w = cvt_pk_bf16(o[6], o[7]);
                    *(u32x4*)(ACT + eoff) = w; } }
    }
};
}
#define XB_TMO      128
#define XB_XCNT(j)  (256  + 64 * (j))
#define XB_XSUB(j)  (1280 + 64 * (j))
#define XB_XGEN(j)  (2304 + 64 * (j))
#define XB_TOP      3328
#define XB_TOPGEN   3392
#define XCD_BAR_WORDS 3456
#define XB_SPIN_CAP (1u << 18)
#ifndef XB_LEADER_SLEEP
#define XB_LEADER_SLEEP 0
#endif
__device__ __forceinline__ unsigned xb_ld(unsigned* p)              { return __hip_atomic_load(p, __ATOMIC_RELAXED, __HIP_MEMORY_SCOPE_AGENT); }
__device__ __forceinline__ unsigned xb_add(unsigned* p, unsigned v) { return __hip_atomic_fetch_add(p, v, __ATOMIC_RELAXED, __HIP_MEMORY_SCOPE_AGENT); }
__device__ __forceinline__ unsigned xb_xcc_id() { return (unsigned)__builtin_amdgcn_s_getreg((3 << 11) | 20) & 0xFu; }
#define XB_SPIN(cond, bar) do { unsigned _sp = 0; while (cond) { __builtin_amdgcn_s_sleep(1); \
    if ((++_sp & 255u) == 0u) { if (xb_ld(&(bar)[XB_TMO])) break; if (_sp > XB_SPIN_CAP) { atomicAdd(&(bar)[XB_TMO], 1u); break; } } } } while (0)
struct XcdBarrier { unsigned* bar; unsigned x; volatile LAS unsigned* st; };
__device__ __forceinline__ XcdBarrier xcd_barrier_post(unsigned* bar, volatile LAS unsigned* st) {
    XcdBarrier b; b.bar = bar; b.x = xb_xcc_id(); b.st = st;
    if (threadIdx.x == 0) (void)xb_add(&bar[XB_XCNT(b.x)], 1u);
    return b;
}
__device__ __forceinline__ void xcd_barrier_complete(unsigned* bar, unsigned x, unsigned& nloc, unsigned& nx) {
    const unsigned G = gridDim.x * gridDim.y * gridDim.z;
    unsigned sum, cnt, mine, sp = 0u;
    for (;;) {
        sum = 0u; cnt = 0u; mine = 0u;
#pragma unroll
        for (unsigned j = 0; j < 16; ++j) { const unsigned c = xb_ld(&bar[XB_XCNT(j)]); sum += c; cnt += (c > 0u) ? 1u : 0u; mine = (j == x) ? c : mine; }
        if (sum == G) break;
        __builtin_amdgcn_s_sleep(1);
        if ((++sp & 255u) == 0u) { if (xb_ld(&bar[XB_TMO])) break; if (sp > XB_SPIN_CAP) { atomicAdd(&bar[XB_TMO], 1u); break; } }
    }
    nloc = mine > 0u ? mine : 1u; nx = cnt > 0u ? cnt : 1u;
}
__device__ __forceinline__ void xcd_barrier(const XcdBarrier& b) {
    asm volatile("s_waitcnt vmcnt(0)" ::: "memory");
    __syncthreads();
    if (threadIdx.x == 0) {
        unsigned* bar = b.bar;
        __builtin_amdgcn_s_waitcnt(0);
        unsigned nloc = b.st[0], nx = b.st[1];
        if (nloc == 0u) { xcd_barrier_complete(bar, b.x, nloc, nx); b.st[0] = nloc; b.st[1] = nx; }
        const unsigned old = xb_add(&bar[XB_XSUB(b.x)], 1u);
        const unsigned gen = old / nloc;
        if (old + 1u == (gen + 1u) * nloc) {
#if XB_LEADER_SLEEP
            __builtin_amdgcn_s_sleep(XB_LEADER_SLEEP);
#endif
            __builtin_amdgcn_fence(__ATOMIC_RELEASE, "agent");
            asm volatile("s_waitcnt vmcnt(0)" ::: "memory");
            const unsigned og = xb_add(&bar[XB_TOP], 1u);
            const unsigned tg = og / nx;
            if (og + 1u == (tg + 1u) * nx) xb_add(&bar[XB_TOPGEN], 1u);
            else XB_SPIN(xb_ld(&bar[XB_TOPGEN]) == tg, bar);
            __builtin_amdgcn_fence(__ATOMIC_ACQUIRE, "agent");
            xb_add(&bar[XB_XGEN(b.x)], 1u);
            asm volatile("s_waitcnt vmcnt(0)" ::: "memory");
        } else {
            XB_SPIN(xb_ld(&bar[XB_XGEN(b.x)]) == gen, bar);
            __builtin_amdgcn_fence(__ATOMIC_ACQUIRE, "agent");
            asm volatile("s_waitcnt vmcnt(0)" ::: "memory");
        }
    }
    __syncthreads();
}
struct KArgs { const float* in[31]; float* out; unsigned char* ws; int ph_lo, ph_hi; };
typedef KArgs Ptrs;
__device__ __forceinline__ void tr_item(const float* W, int ldw, int k0, int n0, bf16* WT, int ldt, int dest_row0, LAS float* scr, int lane) {
#pragma unroll 8
    for (int i = 0; i < 32; ++i) { const int kk = 2 * i + (lane >> 5); scr[kk * 33 + (lane & 31)] = W[(size_t)(k0 + kk) * ldw + n0 + (lane & 31)]; }
    LDS_WAIT();
    const int c = lane & 7;
#pragma unroll
    for (int j = 0; j < 4; ++j) { const int n = (lane >> 3) + 8 * j; const LAS float* s = scr + (8 * c) * 33 + n;
        u32x4 o; o.x = pk2(s[0 * 33], s[1 * 33]); o.y = pk2(s[2 * 33], s[3 * 33]); o.z = pk2(s[4 * 33], s[5 * 33]); o.w = pk2(s[6 * 33], s[7 * 33]);
        *(u32x4*)(WT + (size_t)(dest_row0 + n) * ldt + k0 + 8 * c) = o; }
    LDS_WAIT();
}
__device__ __forceinline__ void tr_item8(const float* W, int ldw, int k0, int n0, unsigned char* WT8, int ldt, int dest_row0, float scale, LAS float* scr, int lane) {
#pragma unroll 8
    for (int i = 0; i < 32; ++i) { const int kk = 2 * i + (lane >> 5); scr[kk * 33 + (lane & 31)] = W[(size_t)(k0 + kk) * ldw + n0 + (lane & 31)] * scale; }
    LDS_WAIT();
    const int c = lane & 7;
#pragma unroll
    for (int j = 0; j < 4; ++j) { const int n = (lane >> 3) + 8 * j; const LAS float* s = scr + (8 * c) * 33 + n; unsigned w0 = 0u, w1 = 0u;
        w0 = __builtin_amdgcn_cvt_pk_fp8_f32(s[0 * 33], s[1 * 33], w0, false); w0 = __builtin_amdgcn_cvt_pk_fp8_f32(s[2 * 33], s[3 * 33], w0, true);
        w1 = __builtin_amdgcn_cvt_pk_fp8_f32(s[4 * 33], s[5 * 33], w1, false); w1 = __builtin_amdgcn_cvt_pk_fp8_f32(s[6 * 33], s[7 * 33], w1, true);
        *(u32x2*)(WT8 + (size_t)(dest_row0 + n) * ldt + k0 + 8 * c) = (u32x2){w0, w1}; }
    LDS_WAIT();
}
template <class PT> __device__ __forceinline__ void convert_moe(const PT& P, int l, ldsp lds, int gw, int NGW, int wave, int lane) {
    LAS float* scr = (LAS float*)(lds + 40960 + wave * 8448);
    const float* wgu = P.in[25] + (size_t)l * NEXP * 1024 * 2048; const float* wdn = P.in[27] + (size_t)l * NEXP * 1024 * 1024;
    bf16* WGU = (bf16*)(P.ws + WS_WGU); bf16* WDN = (bf16*)(P.ws + WS_WDN);
    constexpr int I_GU = 16 * 64, I_DN = 16 * 32, I_E = I_GU + I_DN;
    const bool f8 = (F8_LAYERS >> l) & 1u;
    for (int it = gw; it < NEXP * I_E; it += NGW) {
        const int e = it / I_E; int r = it - e * I_E;
        if (f8) {
            if (r < I_GU) { const int kb = r >> 6, nb = r & 63, n0 = nb * 32; const int half = n0 >> 10, pn = (n0 & 1023) >> 7, j0 = n0 & 127;
                tr_item8(wgu + (size_t)e * 1024 * 2048, 2048, kb * 64, n0, (unsigned char*)WGU, 1024, e * 2048 + 256 * pn + 128 * half + j0, (float)(1 << F8_WGU_SHIFT), scr, lane); }
            else { r -= I_GU; const int kb = r >> 5, nb = r & 31; tr_item8(wdn + (size_t)e * 1024 * 1024, 1024, kb * 64, nb * 32, (unsigned char*)WDN, 1024, e * 1024 + nb * 32, (float)(1 << F8_WDN_SHIFT), scr, lane); }
            continue; }
        if (r < I_GU) { const int kb = r >> 6, nb = r & 63, n0 = nb * 32; const int half = n0 >> 10, pn = (n0 & 1023) >> 7, j0 = n0 & 127;
            tr_item(wgu + (size_t)e * 1024 * 2048, 2048, kb * 64, n0, WGU, 1024, e * 2048 + 256 * pn + 128 * half + j0 - 0, scr, lane); }
        else { r -= I_GU; const int kb = r >> 5, nb = r & 31; tr_item(wdn + (size_t)e * 1024 * 1024, 1024, kb * 64, nb * 32, WDN, 1024, e * 1024 + nb * 32, scr, lane); }
    }
}

template <class PT> __device__ __forceinline__ void phase_pre_a(const PT& P, ldsp lds, int wg, int G, int g_wave) {
    const int tid = fresh_tid(), lane = tid & 63, wave = __builtin_amdgcn_readfirstlane(tid >> 6);
    const int gw = wg * NWAVES + wave, NGW = G * NWAVES, gt = wg * NTHR + tid, NT = G * NTHR;
    unsigned char* ws = P.ws;
    LAS float* sl = (LAS float*)lds;
    for (int i = tid; i < 9 * 1024; i += NTHR) { const int bb = i >> 10, d = i & 1023; const float c = (bb < 8) ? P.in[1][bb * 1024 + d] : P.in[3][d]; sl[i] = silu_(c); }
    __syncthreads();
    if (gw < 192) { const int l = gw / 96, jb = gw % 96, j = jb * 64 + lane; const float* wm = P.in[4] + (size_t)l * 1024 * 6144 + j;
        float acc[9];
#pragma unroll
        for (int b = 0; b < 9; ++b) acc[b] = 0.f;
        for (int d = 0; d < 1024; d += 4) { float w[4];
#pragma unroll
            for (int q = 0; q < 4; ++q) w[q] = wm[(size_t)(d + q) * 6144];
#pragma unroll
            for (int q = 0; q < 4; ++q)
#pragma unroll
                for (int b = 0; b < 9; ++b) acc[b] += sl[b * 1024 + d + q] * w[q]; }
        const float bmv = P.in[5][l * 6144 + j]; float* mo = (float*)(ws + WS_MODS) + (size_t)l * 9 * 6144 + j;
#pragma unroll
        for (int b = 0; b < 9; ++b) mo[b * 6144] = acc[b] + bmv; }
    { f32x2* rope = (f32x2*)(ws + WS_ROPE); for (int i = gt; i < 128 * 16; i += NT) { const int pos = i >> 4, k = i & 15; const float fr = powf(10000.0f, -(float)k / 16.0f); float s, c; sincosf((float)pos * fr, &s, &c); rope[i] = (f32x2){c, s}; }
      f32x2* tw = (f32x2*)(ws + WS_TW); for (int i = gt; i < 8192; i += NT) { float s, c; sincospif((float)i / 4096.0f, &s, &c); tw[i] = (f32x2){c, s}; }
      float* sp = (float*)(ws + WS_SP); for (int i = gt; i < 2 * 2 * 1024; i += NT) { const float lam = P.in[15][i]; sp[i] = log1pf(expf(-lam)); }
      bf16* fc = (bf16*)(ws + WS_FC); for (int i = gt; i < 512 * 256; i += NT) { const int r = i >> 8, c = i & 255, part = r >> 8, m = r & 255; float s, co; sincospif((float)((c * m) & 255) / 128.0f, &s, &co); fc[i] = (bf16)f2bf((part ? s : co) * 0.0625f); }
      bf16* f1 = (bf16*)(ws + WS_F1); for (int i = gt; i < 256 * 256; i += NT) { const int R = i >> 8, kk = i & 255, w = R >> 5, pq = (R >> 4) & 1, k1 = 16 * w + (R & 15), pin = kk >> 7, n1 = kk & 127;
          float s, co; sincospif((float)((n1 * k1) & 127) / 64.0f, &s, &co); const float v = pq == 0 ? (pin == 0 ? co : -s) : (pin == 0 ? s : co); f1[i] = (bf16)f2bf(v * 0.08838834764831845f); }
      bf16* f2 = (bf16*)(ws + WS_F2); for (int i = gt; i < 64 * 128; i += NT) { const int k2 = i >> 7, kk = i & 127, part = kk >> 6, n2 = kk & 63; float s, co; sincospif((float)((n2 * k2) & 63) / 32.0f, &s, &co); f2[i] = (bf16)f2bf((part ? -s : co) * 0.125f); }
      bf16* f3 = (bf16*)(ws + WS_F256); for (int i = gt; i < 256 * 512; i += NT) { const int k = i >> 9, kk = i & 511, part = kk >> 8, t = kk & 255; float s, co; sincospif((float)((k * t) & 255) / 128.0f, &s, &co); f3[i] = (bf16)f2bf((part ? -s : co) * 0.0625f); }
    }
    for (int l = 0; l < DEPTH; ++l) {
        unsigned char* wl = ws + WS_WSM + l * WSM_LAYER;
        const float* win = P.in[6] + (size_t)l * 1024 * IN_COLS;
        bf16* wxf = (bf16*)(wl + WSM_WXF); for (int i = gt; i < 1024 * 1024; i += NT) { const int d = i >> 10, c = i & 1023; wxf[i] = (bf16)f2bf(win[(size_t)d * IN_COLS + 3584 + c]); }
        bf16* wrh = (bf16*)(wl + WSM_WRH); bf16* wrl = (bf16*)(wl + WSM_WRL); const float* wr = P.in[23] + (size_t)l * 1024 * 32;
        for (int i = gt; i < 32 * 1024; i += NT) { const int e = i >> 10, k = i & 1023; const float v = wr[k * 32 + e]; const unsigned h = f2bf(v); wrh[i] = (bf16)h; wrl[i] = (bf16)f2bf(v - bf2f(h)); }
        bf16* wg = (bf16*)(wl + WSM_WG);
        for (int i = gt; i < 4 * 16 * 64 * 64; i += NT) { const int in_ = i & 63, out_ = (i >> 6) & 63, hb = (i >> 12) & 15, gm = i >> 16; const int dir = gm >> 1;
            const float* src = ((gm & 1) ? P.in[13] : P.in[11]) + (size_t)l * 2 * 16 * 4096 + (size_t)dir * 16 * 4096 + hb * 4096; wg[i] = (bf16)f2bf(src[in_ * 64 + out_]); }
    }
    LAS float* scr = (LAS float*)(lds + 40960 + wave * 8448);
    constexpr int I_IN = 16 * 112, I_SQ = 16 * 32, I_MG = 16 * 96, I_L = I_IN + 4 * I_SQ + I_MG;
    for (int it = gw; it < DEPTH * I_L; it += NGW) {
        const int l = it / I_L; int r = it - l * I_L; unsigned char* wl = ws + WS_WSM + l * WSM_LAYER;
        if (r < I_IN) { const int kb = r / 112, nb = r % 112, n0 = nb * 32; const int dr = n0 < 1536 ? n0 : (n0 < 2560 ? n0 + 1024 : n0 - 1024);
            tr_item(P.in[6] + (size_t)l * 1024 * IN_COLS, IN_COLS, kb * 64, n0, (bf16*)(wl + WSM_WIN), 1024, dr, scr, lane); continue; }
        r -= I_IN;
        if (r < 4 * I_SQ) { const int which = r / I_SQ; r -= which * I_SQ; const int kb = r >> 5, nb = r & 31;
            const float* src = (which == 0 ? P.in[8] : which == 1 ? P.in[16] : which == 2 ? P.in[17] : P.in[20]) + (size_t)l * 1024 * 1024;
            const size_t dst = which == 0 ? WSM_WOA : which == 1 ? WSM_WOR : which == 2 ? WSM_WOF : WSM_WOUT;
            tr_item(src, 1024, kb * 64, nb * 32, (bf16*)(wl + dst), 1024, nb * 32, scr, lane); continue; }
        r -= 4 * I_SQ;
        { const int kb = r / 96, nb = r % 96;
          if (F8_MERGE) tr_item8(P.in[18] + (size_t)l * 1024 * 3072, 3072, kb * 64, nb * 32, (unsigned char*)(wl + WSM_WM8), 1024, nb * 32, (float)(1 << F8_WM_SHIFT), scr, lane);
          else tr_item(P.in[18] + (size_t)l * 1024 * 3072, 3072, kb * 64, nb * 32, (bf16*)(wl + WSM_WM), 1024, nb * 32, scr, lane); }
    }
    convert_moe(P, 0, lds, gw, NGW, wave, lane);
}

struct FoldStore {
    static constexpr bool PERM = true;
    bf16* O;
    __device__ __forceinline__ void operator()(const f32x4 (&acc)[2][2][4][2], const pg8::Unit& u, int wr, int wc, int fr, int fq) const {
        const int row0 = 3584 + u.pm * 1024 + (u.pn >> 2) * 256 + wr * 64 + fr; const int col0 = (u.pn & 3) * 256 + wc * 32 + 8 * fq;
#pragma unroll
        for (int ai = 0; ai < 2; ++ai)
#pragma unroll
            for (int m = 0; m < 4; ++m) { bf16* rowp = O + (size_t)(row0 + ai * 128 + m * 16) * 1024 + col0;
#pragma unroll
                for (int bj = 0; bj < 2; ++bj) { const f32x4 v0 = acc[ai][bj][m][0], v1 = acc[ai][bj][m][1];
                    u32x4 w; w.x = pg8::cvt_pk_bf16(v0[0], v0[1]); w.y = pg8::cvt_pk_bf16(v0[2], v0[3]); w.z = pg8::cvt_pk_bf16(v1[0], v1[1]); w.w = pg8::cvt_pk_bf16(v1[2], v1[3]);
                    *(u32x4*)(rowp + bj * 128) = w; } }
    }
};
__device__ __forceinline__ void modulate_rows(const float* xlat, const float* xctx, const float* mods  , bf16* U, unsigned char* U8, int nrow, int gw, int NGW, int lane) {
    for (int r = gw; r < nrow; r += NGW) {
        const bool lat = r < NLAT; const float* xr = lat ? xlat + (size_t)r * D : xctx + (size_t)(r - NLAT) * D; const int bb = lat ? (r >> 13) : 8;
        const float* sh = mods + (size_t)(bb * 6 + 0) * D; const float* sc = mods + (size_t)(bb * 6 + 1) * D;
        u32x2* o = (u32x2*)(U + (size_t)r * D);
#pragma unroll
        for (int j = 0; j < 4; ++j) { const int c = 4 * lane + 256 * j; const f32x4 v = *(const f32x4*)(xr + c), s = *(const f32x4*)(sc + c), h = *(const f32x4*)(sh + c);
            const f32x4 uu = v * (s + 1.0f) + h; u32x2 w; w.x = pk2(uu[0], uu[1]); w.y = pk2(uu[2], uu[3]); o[lane + 64 * j] = w;
            if (U8) { unsigned w8 = 0u; w8 = __builtin_amdgcn_cvt_pk_fp8_f32(uu[0], uu[1], w8, false); w8 = __builtin_amdgcn_cvt_pk_fp8_f32(uu[2], uu[3], w8, true); *(unsigned*)(U8 + (size_t)r * D + c) = w8; } }
    }
}
namespace att {
__device__ __forceinline__ int crow(int r, int hi) { return (r & 3) + 8 * (r >> 2) + 4 * hi; }
__device__ __forceinline__ void qk_tile(f32x16& p0, f32x16& p1, ldsp kb, const bf16x8 (&qr)[4], const f32x16& negm) {
    p0 = negm; p1 = negm;
#pragma unroll
    for (int d0 = 0; d0 < 4; ++d0) { const bf16x8 b0 = *(const LAS bf16x8*)(kb + d0 * 2048), b1 = *(const LAS bf16x8*)(kb + d0 * 2048 + 512);
        p0 = __builtin_amdgcn_mfma_f32_32x32x16_bf16(b0, qr[d0], p0, 0, 0, 0); p1 = __builtin_amdgcn_mfma_f32_32x32x16_bf16(b1, qr[d0], p1, 0, 0, 0); }
}
__device__ __forceinline__ void band_mask(f32x16& p0, f32x16& p1, int j, int qi, int hi) {
    if (j == 0) {
#pragma unroll
        for (int r = 0; r < 16; ++r) { const int kk = crow(r, hi); if (kk < qi) p0[r] = -INFINITY; if (kk + 32 < qi) p1[r] = -INFINITY; } }
    if (j == 4) {
#pragma unroll
        for (int r = 0; r < 16; ++r) { const int kk = crow(r, hi); if (kk > qi) p0[r] = -INFINITY; if (kk + 32 > qi) p1[r] = -INFINITY; } }
}
__device__ __forceinline__ float max32(const f32x16& p0, const f32x16& p1) {
    float rm = __builtin_fmaxf(p0[0], p1[0]);
#pragma unroll
    for (int r = 1; r < 16; ++r) rm = __builtin_fmaxf(__builtin_fmaxf(rm, p0[r]), p1[r]);
    return rm;
}
__device__ __forceinline__ float exp32(f32x16& p0, f32x16& p1) { float s = 0.f;
#pragma unroll
    for (int r = 0; r < 16; ++r) { p0[r] = __builtin_amdgcn_exp2f(p0[r]); p1[r] = __builtin_amdgcn_exp2f(p1[r]); s += p0[r] + p1[r]; }
    return s; }
__device__ __forceinline__ void pv_tile(f32x16 (&o)[2], const f32x16& p0, const f32x16& p1, const LAS unsigned char* vp) {
    u32x4 pw[4];
    pw[0] = (u32x4){pk2(p0[0], p0[1]), pk2(p0[2], p0[3]), pk2(p0[4], p0[5]), pk2(p0[6], p0[7])};
    pw[1] = (u32x4){pk2(p0[8], p0[9]), pk2(p0[10], p0[11]), pk2(p0[12], p0[13]), pk2(p0[14], p0[15])};
    pw[2] = (u32x4){pk2(p1[0], p1[1]), pk2(p1[2], p1[3]), pk2(p1[4], p1[5]), pk2(p1[6], p1[7])};
    pw[3] = (u32x4){pk2(p1[8], p1[9]), pk2(p1[10], p1[11]), pk2(p1[12], p1[13]), pk2(p1[14], p1[15])};
#pragma unroll
    for (int d0 = 0; d0 < 2; ++d0)
#pragma unroll
        for (int ks = 0; ks < 4; ++ks) {
            const s16x4 lo = __builtin_bit_cast(s16x4, __builtin_amdgcn_ds_read_tr16_b64_v4i16((LAS s16x4*)(vp + d0 * 4096 + ks * 1024)));
            const s16x4 hh_ = __builtin_bit_cast(s16x4, __builtin_amdgcn_ds_read_tr16_b64_v4i16((LAS s16x4*)(vp + d0 * 4096 + ks * 1024 + 512)));
            const bf16x8 vf = (bf16x8){lo[0], lo[1], lo[2], lo[3], hh_[0], hh_[1], hh_[2], hh_[3]};
            o[d0] = __builtin_amdgcn_mfma_f32_32x32x16_bf16(__builtin_bit_cast(bf16x8, pw[ks]), vf, o[d0], 0, 0, 0); }
}
__device__ __forceinline__ void attn_unit(ldsp lds, bf16* Z, const float* sink  , int qrow0, int g, int nloc, int krow_loc0, int jlo, int krow_ctx0, int tid, bf16* Ob, int opitch) {
    const int lane = tid & 63, r32 = lane & 31, hi = lane >> 5; const int wid = __builtin_amdgcn_readfirstlane(tid >> 6);
    const int hh = wid >> 1, ts = wid & 1, head = 4 * g + hh;
    const int nt = nloc + 4, nsteps = (nt + 1) >> 1;
    LAS float* wsf = (LAS float*)(lds + 65536) + wid * 64;
    const int krow_l = lane, kch = wid;
    const int vrow_l = 16 * (wid & 3) + (lane >> 2), vdh = wid >> 2, vch = lane & 3;
#define TILE_ROW(t) ((t) < nloc ? krow_loc0 + 64 * (t) : krow_ctx0 + 64 * ((t) - nloc))
#define DMA_SUB(t, bo, i) do { const int tr_ = TILE_ROW(t); \
        __builtin_amdgcn_global_load_lds((const unsigned*)(Z + (size_t)(tr_ + krow_l) * ZC + ZK + g * 64 + kch * 8), (LAS unsigned*)(lds + (bo) + (i) * 8192 + kch * 1024), 16, 0, 0); \
        __builtin_amdgcn_global_load_lds((const unsigned*)(Z + (size_t)(tr_ + vrow_l) * ZC + ZV + g * 64 + vdh * 32 + vch * 8), (LAS unsigned*)(lds + 32768 + (bo) + (i) * 8192 + vdh * 4096 + (wid & 3) * 1024), 16, 0, 0); } while (0)
    bf16x8 qr[4];
    { const bf16* Qw = Z + (size_t)(qrow0 + 32 * ts + r32) * ZC + ZQ + head * 64;
#pragma unroll
      for (int d0 = 0; d0 < 4; ++d0) qr[d0] = *(const bf16x8*)(Qw + d0 * 16 + hi * 8); }
    DMA_SUB(0, 0u, 0); DMA_SUB(1, 0u, 1);
    float m_run = sink[head] * 1.4426950408889634f, l_run = 1.0f;
    f32x16 o[2]; o[0] = f32x16{}; o[1] = f32x16{};
    f32x16 negm;
#pragma unroll
    for (int r = 0; r < 16; ++r) negm[r] = -m_run;
    const int qi = 32 * ts + r32;
    __syncthreads();
    for (int s = 0; s < nsteps; ++s) {
        const unsigned boff = (unsigned)(s & 1) * 16384u; const int ta = 2 * s, tb = 2 * s + 1; const bool hasb = tb < nt;
        const bool more = s + 1 < nsteps, moreb = 2 * s + 3 < nt;
        if (more) { DMA_SUB(ta + 2, boff ^ 16384u, 0); if (moreb) DMA_SUB(tb + 2, boff ^ 16384u, 1); }
        const LAS unsigned char* vp = lds + 32768 + boff + ((lane >> 4) & 1) * 32 + (lane & 3) * 8 + (4 * hi + ((lane & 15) >> 2)) * 64;
        float sm = 0.f;
#pragma unroll
        for (int sub = 0; sub < 2; ++sub) { const int tt = 2 * s + sub;
            if (sub == 0 || hasb) {
                f32x16 a0, a1;
                qk_tile(a0, a1, lds + boff + sub * 8192 + hi * 1024 + r32 * 16, qr, negm);
                if (tt < nloc) band_mask(a0, a1, jlo + tt, qi, hi);
                float rm = max32(a0, a1);
                { const auto rr = __builtin_amdgcn_permlane32_swap(__float_as_uint(rm), __float_as_uint(rm), false, false); rm = fmaxf(__uint_as_float(rr[0]), __uint_as_float(rr[1])); }
                if (__builtin_expect(__any(rm > 8.0f), 0)) {
                    const float dl = __builtin_fmaxf(rm, 0.f), f = __builtin_amdgcn_exp2f(-dl); m_run += dl; l_run *= f; sm *= f;
#pragma unroll
                    for (int r = 0; r < 16; ++r) { a0[r] -= dl; a1[r] -= dl; negm[r] = -m_run; }
                    if (hi == 0) wsf[r32] = f;
                    LDS_WAIT();
#pragma unroll
                    for (int r = 0; r < 16; ++r) { const float fr_ = wsf[crow(r, hi)]; o[0][r] *= fr_; o[1][r] *= fr_; }
                }
                sm += exp32(a0, a1);
                pv_tile(o, a0, a1, vp + sub * 8192);
                __builtin_amdgcn_sched_barrier(0);
            } }
        { const auto rr = __builtin_amdgcn_permlane32_swap(__float_as_uint(sm), __float_as_uint(sm), false, false); sm = __uint_as_float(rr[0]) + __uint_as_float(rr[1]); }
        l_run += sm;
        __syncthreads();
    }
#undef TILE_ROW
#undef DMA_SUB
    if (hi == 0) wsf[32 + r32] = l_run;
    LDS_WAIT();
    bf16* Ow = Ob + (size_t)(qrow0 + 32 * ts) * opitch + head * 64;
    { ldsp stg = lds + 67584 + wid * 4608;
#pragma unroll
      for (int r = 0; r < 16; ++r) { const int q = crow(r, hi); const float rl = __builtin_amdgcn_rcpf(wsf[32 + q]);
#pragma unroll
          for (int d0 = 0; d0 < 2; ++d0) *(LAS unsigned short*)(stg + q * 144 + (d0 * 32 + r32) * 2) = (unsigned short)f2bf(o[d0][r] * rl); }
      LDS_WAIT();
#pragma unroll
      for (int i = 0; i < 4; ++i) { const int row = i * 8 + (lane >> 3), ch = lane & 7; *(u32x4*)(Ow + (size_t)row * opitch + ch * 8) = *(const LAS u32x4*)(stg + row * 144 + ch * 16); } }
    LDS_WAIT();
}
__device__ __forceinline__ void attn_phase(ldsp lds, bf16* Z, const float* sink, bool with_ctx, int wg, int G, int g_wave, bf16* Ob, int opitch) {
    const int tid = fresh_tid();
    const int nlat = NB * 4 * (SEQ / 64), nctx = with_ctx ? NB * 4 * (CTXL / 64) : 0;
    for (int u = wg; u < nlat + nctx; u += G) {
        if (u < nlat) { const int qb = u & 127, g = (u >> 7) & 3, b = u >> 9; const int qpos0 = qb * 64;
            const int jlo = qpos0 == 0 ? 2 : (qpos0 == 64 ? 1 : 0); const int jhi = qpos0 == SEQ - 64 ? 2 : (qpos0 == SEQ - 128 ? 3 : 4);
            attn_unit(lds, Z, sink, b * SEQ + qpos0, g, jhi - jlo + 1, b * SEQ + qpos0 - 128 + 64 * jlo, jlo, NLAT + b * CTXL, tid, Ob, opitch);
        } else { const int v = u - nlat; const int qb = v & 3, g = (v >> 2) & 3, b = v >> 4;
            attn_unit(lds, Z, sink, NLAT + b * CTXL + qb * 64, g, 0, 0, 0, NLAT + b * CTXL, tid, Ob, opitch); }
    }
}
}
namespace fft {
constexpr int RS = 144;
constexpr int OUT_OFF = 73728;
template <int K> struct Tile { u32x4 v[K / 64]; };
template <int K> __device__ __forceinline__ void tile_load(Tile<K>& t, const bf16* base, size_t rstride, size_t pstride, int tid) {
    constexpr int KH = K / 2;
#pragma unroll
    for (int i = 0; i < K / 64; ++i) { const int c = tid + NTHR * i, kk = c >> 3, ch = c & 7; const int part = kk / KH, n = kk % KH;
        t.v[i] = *(const u32x4*)(base + (size_t)n * rstride + (size_t)part * pstride + ch * 8); }
}
template <int K> __device__ __forceinline__ void tile_put(const Tile<K>& t, ldsp lds, int tid) {
#pragma unroll
    for (int i = 0; i < K / 64; ++i) { const int c = tid + NTHR * i, kk = c >> 3, ch = c & 7; *(LAS u32x4*)(lds + kk * RS + ch * 16) = t.v[i]; }
}
__device__ __forceinline__ bf16x8 tile_frag(const LAS unsigned char* bp, int ks, int nt) {
    const s16x4 lo = __builtin_bit_cast(s16x4, __builtin_amdgcn_ds_read_tr16_b64_v4i16((LAS s16x4*)(bp + (32 * ks) * RS + nt * 32)));
    const s16x4 hi = __builtin_bit_cast(s16x4, __builtin_amdgcn_ds_read_tr16_b64_v4i16((LAS s16x4*)(bp + (32 * ks + 4) * RS + nt * 32)));
    return (bf16x8){lo[0], lo[1], lo[2], lo[3], hi[0], hi[1], hi[2], hi[3]};
}
template <int KS, int MTW, int NTW>
__device__ __forceinline__ void mma_reg(ldsp lds, const bf16x8 (&af)[MTW][KS], int nt0, f32x4 (&acc)[MTW][NTW], int tid) {
    const int lane = tid & 63, fr = lane & 15, kq = lane >> 4;
#pragma unroll
    for (int i = 0; i < MTW; ++i)
#pragma unroll
        for (int j = 0; j < NTW; ++j) acc[i][j] = (f32x4){0.f, 0.f, 0.f, 0.f};
    const LAS unsigned char* bp = lds + (8 * kq + (fr >> 2)) * RS + (4 * (fr & 3)) * 2;
#pragma unroll
    for (int ks = 0; ks < KS; ++ks)
#pragma unroll
        for (int j = 0; j < NTW; ++j) { const bf16x8 bfrag = tile_frag(bp, ks, nt0 + j);
#pragma unroll
            for (int i = 0; i < MTW; ++i) acc[i][j] = __builtin_amdgcn_mfma_f32_16x16x32_bf16(bfrag, af[i][ks], acc[i][j], 0, 0, 0); }
}
__device__ __forceinline__ void put4(ldsp p, float a, float b, float c, float d) { *(LAS u32x2*)p = (u32x2){pg8::cvt_pk_bf16(a, b), pg8::cvt_pk_bf16(c, d)}; }

__device__ __forceinline__ void pass1_phase(ldsp lds, bf16* Z, bf16* T, const unsigned char* ws, bool with_ctx, int wg, int G, int g_wave) {
    const bf16* F1 = (const bf16*)(ws + WS_F1); const bf16* F3 = (const bf16*)(ws + WS_F256); const f32x2* TW = (const f32x2*)(ws + WS_TW);
    const int tid = fresh_tid(); const int lane = tid & 63, fr = lane & 15, kq = lane >> 4; const int w = __builtin_amdgcn_readfirstlane(tid >> 6);
    bf16x8 af[2][8];
#pragma unroll
    for (int i = 0; i < 2; ++i)
#pragma unroll
        for (int ks = 0; ks < 8; ++ks) af[i][ks] = *(const bf16x8*)(F1 + (size_t)(16 * (2 * w + i) + fr) * 256 + 32 * ks + 8 * kq);
    const int NU = NB * 64 * 16;
    Tile<256> tl;
    if (wg < NU) { const int ct = wg & 15, n2 = (wg >> 4) & 63, b = wg >> 10; tile_load<256>(tl, Z + (size_t)(b * SEQ + n2) * ZC + ZXC + ct * 64, (size_t)64 * ZC, 1024, tid); }
    for (int u = wg; u < NU; u += G) { const int ct = u & 15, n2 = (u >> 4) & 63, b = u >> 10;
        tile_put<256>(tl, lds, tid);
        __syncthreads();
        { const int un = u + G; if (un < NU) { const int ct2 = un & 15, n22 = (un >> 4) & 63, b2 = un >> 10; tile_load<256>(tl, Z + (size_t)(b2 * SEQ + n22) * ZC + ZXC + ct2 * 64, (size_t)64 * ZC, 1024, tid); } }
        f32x4 acc[2][4];
        mma_reg<8, 2, 4>(lds, af, 0, acc, tid);
        { const int k1 = 16 * w + fr; const f32x2 cs = TW[(n2 * k1) & 8191]; ldsp o = lds + OUT_OFF + (k1 * 2) * RS + (4 * kq) * 2;
#pragma unroll
          for (int j = 0; j < 4; ++j) { const f32x4 p = acc[0][j], q = acc[1][j];
              put4(o + j * 32, p[0] * cs.x - q[0] * cs.y, p[1] * cs.x - q[1] * cs.y, p[2] * cs.x - q[2] * cs.y, p[3] * cs.x - q[3] * cs.y);
              put4(o + RS + j * 32, q[0] * cs.x + p[0] * cs.y, q[1] * cs.x + p[1] * cs.y, q[2] * cs.x + p[2] * cs.y, q[3] * cs.x + p[3] * cs.y); } }
        __syncthreads();
#pragma unroll
        for (int i = 0; i < 4; ++i) { const int c = tid + NTHR * i, row = c >> 3, ch = c & 7, k1 = row >> 1, part = row & 1;
            *(u32x4*)(T + (size_t)(b * SEQ + k1 * 64 + n2) * 2048 + part * 1024 + ct * 64 + ch * 8) = *(const LAS u32x4*)(lds + OUT_OFF + row * RS + ch * 16); }
    }
    __syncthreads();
    if (with_ctx) for (int u = wg; u < NB * 16; u += G) { const int b = u >> 4, ct = u & 15;
        Tile<512> tc; tile_load<512>(tc, Z + (size_t)(NLAT + b * CTXL) * ZC + ZXC + ct * 64, ZC, 1024, tid); tile_put<512>(tc, lds, tid);
        __syncthreads();
        f32x4 acc[2][4];
#pragma unroll
        for (int i = 0; i < 2; ++i)
#pragma unroll
            for (int j = 0; j < 4; ++j) acc[i][j] = (f32x4){0.f, 0.f, 0.f, 0.f};
        const LAS unsigned char* bp = lds + (8 * kq + (fr >> 2)) * RS + (4 * (fr & 3)) * 2;
#pragma unroll 2
        for (int ks = 0; ks < 16; ++ks) { bf16x8 a2[2];
#pragma unroll
            for (int i = 0; i < 2; ++i) a2[i] = *(const bf16x8*)(F3 + (size_t)(16 * (2 * w + i) + fr) * 512 + 32 * ks + 8 * kq);
#pragma unroll
            for (int j = 0; j < 4; ++j) { const bf16x8 bfrag = tile_frag(bp, ks, j);
#pragma unroll
                for (int i = 0; i < 2; ++i) acc[i][j] = __builtin_amdgcn_mfma_f32_16x16x32_bf16(bfrag, a2[i], acc[i][j], 0, 0, 0); } }
        __syncthreads();
#pragma unroll
        for (int i = 0; i < 2; ++i) { const int k = 16 * (2 * w + i) + fr; bf16* o = Z + (size_t)(NLAT + b * CTXL + k) * ZC + ZXC + ct * 64 + 4 * kq;
#pragma unroll
            for (int j = 0; j < 4; ++j) *(u32x2*)(o + 16 * j) = (u32x2){pg8::cvt_pk_bf16(acc[i][j][0], acc[i][j][1]), pg8::cvt_pk_bf16(acc[i][j][2], acc[i][j][3])}; }
    }
}
__device__ __forceinline__ void pass2_phase(ldsp lds, bf16* Z, const bf16* T, const unsigned char* ws, int wg, int G, int g_wave) {
    const bf16* F2 = (const bf16*)(ws + WS_F2);
    const int tid = fresh_tid(); const int lane = tid & 63, fr = lane & 15, kq = lane >> 4; const int w = __builtin_amdgcn_readfirstlane(tid >> 6);
    bf16x8 af[1][4];
#pragma unroll
    for (int ks = 0; ks < 4; ++ks) af[0][ks] = *(const bf16x8*)(F2 + (size_t)(16 * (w >> 1) + fr) * 128 + 32 * ks + 8 * kq);
    const int NU = NB * 128 * 16;
    Tile<128> tl;
    if (wg < NU) { const int ct = wg & 15, k1 = (wg >> 4) & 127, b = wg >> 11; tile_load<128>(tl, T + (size_t)(b * SEQ + k1 * 64) * 2048 + ct * 64, 2048, 1024, tid); }
    for (int u = wg; u < NU; u += G) { const int ct = u & 15, k1 = (u >> 4) & 127, b = u >> 11;
        tile_put<128>(tl, lds, tid);
        __syncthreads();
        { const int un = u + G; if (un < NU) { const int ct2 = un & 15, k12 = (un >> 4) & 127, b2 = un >> 11; tile_load<128>(tl, T + (size_t)(b2 * SEQ + k12 * 64) * 2048 + ct2 * 64, 2048, 1024, tid); } }
        f32x4 acc[1][2];
        mma_reg<4, 1, 2>(lds, af, 2 * (w & 1), acc, tid);
        { const int k2 = 16 * (w >> 1) + fr; ldsp o = lds + OUT_OFF + k2 * RS + (32 * (w & 1) + 4 * kq) * 2;
#pragma unroll
          for (int j = 0; j < 2; ++j) put4(o + j * 32, acc[0][j][0], acc[0][j][1], acc[0][j][2], acc[0][j][3]); }
        __syncthreads();
        { const int row = tid >> 3, ch = tid & 7;
          *(u32x4*)(Z + (size_t)(b * SEQ + k1 + 128 * row) * ZC + ZXC + ct * 64 + ch * 8) = *(const LAS u32x4*)(lds + OUT_OFF + row * RS + ch * 16); }
    }
    __syncthreads();
}
}
namespace rg {
constexpr int XRS = 144;
constexpr int WAVE_LDS = 68 * XRS;
struct Args {
    bf16* Z; const float* conv_w; const float* conv_b;
    const bf16* Wg;
    const float* b_a; const float* b_i; const float* sp;
    f32x2* SUM;
    const float* CARRY;
    bf16* Gout; int gpitch;
};
template <bool FINAL>
__device__ __forceinline__ void wave_unit(LAS unsigned char* xt, const LAS unsigned char* wgl, const LAS float* cst, const Args& A, int bb, int cid, int hb, int tid) {
    const int lane = tid & 63, fr = lane & 15, kq = lane >> 4;
    const bool isctx = cid < 4; const int rowbase = isctx ? NLAT + bb * CTXL : bb * SEQ, len = isctx ? CTXL : SEQ, t0 = isctx ? cid * 64 : (cid - 4) * 64;
#pragma unroll
    for (int i = 0; i < 9; ++i) { const int rr = i * 8 + (lane >> 3), ch = lane & 7, t = t0 - 2 + rr;
        u32x4 v = {0u, 0u, 0u, 0u};
        if (rr < 68 && t >= 0 && t < len) v = *(const u32x4*)(A.Z + (size_t)(rowbase + t) * ZC + ZXR + hb * 64 + ch * 8);
        if (rr < 68) *(LAS u32x4*)(xt + rr * XRS + ch * 16) = v; }
    LDS_WAIT();
    bf16x8 af[4][2];
#pragma unroll
    for (int ks = 0; ks < 2; ++ks) { const int c0 = 32 * ks + 8 * kq;
        float cw[4][8], cb[8];
#pragma unroll
        for (int tap = 0; tap < 4; ++tap) { const f32x4 a = *(const LAS f32x4*)(cst + tap * 64 + c0), b = *(const LAS f32x4*)(cst + tap * 64 + c0 + 4);
#pragma unroll
            for (int j = 0; j < 4; ++j) { cw[tap][j] = a[j]; cw[tap][4 + j] = b[j]; } }
        { const f32x4 a = *(const LAS f32x4*)(cst + 256 + c0), b = *(const LAS f32x4*)(cst + 256 + c0 + 4);
#pragma unroll
          for (int j = 0; j < 4; ++j) { cb[j] = a[j]; cb[4 + j] = b[j]; } }
#pragma unroll
        for (int mt = 0; mt < 4; ++mt) { float xc[8];
#pragma unroll
            for (int j = 0; j < 8; ++j) xc[j] = cb[j];
#pragma unroll
            for (int tap = 0; tap < 4; ++tap) { const u32x4 xv = *(const LAS u32x4*)(xt + (16 * mt + fr + tap) * XRS + (32 * ks + 8 * kq) * 2);
#pragma unroll
                for (int j = 0; j < 8; ++j) { const unsigned w = xv[j >> 1]; const float x = (j & 1) ? bf2f(w >> 16) : bf2f(w & 0xffffu); xc[j] += cw[tap][j] * x; } }
            u32x4 p; p.x = pg8::cvt_pk_bf16(xc[0], xc[1]); p.y = pg8::cvt_pk_bf16(xc[2], xc[3]); p.z = pg8::cvt_pk_bf16(xc[4], xc[5]); p.w = pg8::cvt_pk_bf16(xc[6], xc[7]);
            af[mt][ks] = __builtin_bit_cast(bf16x8, p); } }
    const int bsum = bb * NCHUNK + cid;
#pragma unroll 1
    for (int nt = 0; nt < 4; ++nt) {
        const int cch = hb * 64 + 16 * nt + fr;
        float xd[4][4];
        { float cwd[4];
#pragma unroll
          for (int tap = 0; tap < 4; ++tap) cwd[tap] = cst[tap * 64 + 16 * nt + fr];
          const float cbd = cst[256 + 16 * nt + fr];
#pragma unroll
          for (int mt = 0; mt < 4; ++mt) { float xs[7];
#pragma unroll
              for (int q = 0; q < 7; ++q) xs[q] = bf2f(*(const LAS unsigned short*)(xt + (16 * mt + 4 * kq + q) * XRS + (16 * nt + fr) * 2));
#pragma unroll
              for (int r = 0; r < 4; ++r) xd[mt][r] = cbd + cwd[0] * xs[r] + cwd[1] * xs[r + 1] + cwd[2] * xs[r + 2] + cwd[3] * xs[r + 3]; } }
        float hsum[4][4];
#pragma unroll
        for (int dir = 0; dir < 2; ++dir) {
            f32x4 g[2][4];
#pragma unroll
            for (int gi = 0; gi < 2; ++gi) { const int gm = 2 * dir + gi; bf16x8 bw[2];
#pragma unroll
                for (int ks = 0; ks < 2; ++ks) bw[ks] = *(const LAS bf16x8*)(wgl + (gm * 64 + 16 * nt + fr) * 144 + (32 * ks + 8 * kq) * 2);
#pragma unroll
                for (int mt = 0; mt < 4; ++mt) { f32x4 c = {0.f, 0.f, 0.f, 0.f};
                    c = __builtin_amdgcn_mfma_f32_16x16x32_bf16(af[mt][0], bw[0], c, 0, 0, 0); c = __builtin_amdgcn_mfma_f32_16x16x32_bf16(af[mt][1], bw[1], c, 0, 0, 0); g[gi][mt] = c; } }
            const float ba = cst[(5 + dir) * 64 + 16 * nt + fr], bi = cst[(7 + dir) * 64 + 16 * nt + fr], spv = cst[(9 + dir) * 64 + 16 * nt + fr];
            float carry = 0.f;
            if (FINAL) carry = A.CARRY[(((size_t)dir * NB + bb) * NCHUNK + cid) * 1024 + cch];
            float ptot = 1.f;
#pragma unroll
            for (int mi = 0; mi < 4; ++mi) { const int mt = dir == 0 ? mi : 3 - mi;
                float a[4], bv[4];
#pragma unroll
                for (int r = 0; r < 4; ++r) {
                    const float rr = __builtin_amdgcn_rcpf(1.0f + __builtin_amdgcn_exp2f(__builtin_fmaf(g[0][mt][r], -1.4426950408889634f, ba)));
                    const float ii = __builtin_amdgcn_rcpf(1.0f + __builtin_amdgcn_exp2f(__builtin_fmaf(g[1][mt][r], -1.4426950408889634f, bi)));
                    a[r] = __builtin_amdgcn_exp2f(-rr * spv);
                    const float om = __builtin_fmaf(-a[r], a[r], 1.0f);
                    bv[r] = __builtin_amdgcn_sqrtf(om) * ii * xd[mt][r]; }
                float s[4], p[4];
                if (dir == 0) { s[0] = bv[0]; p[0] = a[0];
#pragma unroll
                    for (int r = 1; r < 4; ++r) { s[r] = a[r] * s[r - 1] + bv[r]; p[r] = a[r] * p[r - 1]; } }
                else { s[3] = bv[3]; p[3] = a[3];
#pragma unroll
                    for (int r = 2; r >= 0; --r) { s[r] = a[r] * s[r + 1] + bv[r]; p[r] = a[r] * p[r + 1]; } }
                const float pe = dir == 0 ? p[3] : p[0], se = dir == 0 ? s[3] : s[0];
                float pa[4], sa[4];
#pragma unroll
                for (int q = 0; q < 4; ++q) { pa[q] = __shfl(pe, fr + 16 * q); sa[q] = __shfl(se, fr + 16 * q); }
                float cin = carry, mine = carry;
#pragma unroll
                for (int qi = 0; qi < 4; ++qi) { const int q = dir == 0 ? qi : 3 - qi; if (q == kq) mine = cin; cin = pa[q] * cin + sa[q]; ptot *= pa[q]; }
                carry = cin;
                if (FINAL) {
#pragma unroll
                    for (int r = 0; r < 4; ++r) { const float h = s[r] + p[r] * mine; hsum[mt][r] = dir == 0 ? h : hsum[mt][r] + h; } }
                __builtin_amdgcn_sched_barrier(0);
            }
            if (!FINAL) { if (kq == 0) A.SUM[(((size_t)dir * NB + bb) * NCHUNK + cid) * 1024 + cch] = (f32x2){ptot, carry}; }
        }
        if (FINAL) {
#pragma unroll
            for (int mt = 0; mt < 4; ++mt)
#pragma unroll
                for (int r = 0; r < 4; ++r) *(LAS unsigned short*)(xt + (16 * mt + 4 * kq + r + 2) * XRS + (16 * nt + fr) * 2) = (unsigned short)f2bf(hsum[mt][r]);
        }
    }
    if (FINAL) {
        LDS_WAIT();
#pragma unroll
        for (int i = 0; i < 8; ++i) { const int row = i * 8 + (lane >> 3), ch = lane & 7; const size_t grow = (size_t)(rowbase + t0 + row);
            const u32x4 hv = *(const LAS u32x4*)(xt + (row + 2) * XRS + ch * 16); const u32x4 gv = *(const u32x4*)(A.Z + grow * ZC + ZGR + hb * 64 + ch * 8);
            u32x4 ov;
#pragma unroll
            for (int q = 0; q < 4; ++q) { const float h0 = bf2f(hv[q] & 0xffffu), h1 = bf2f(hv[q] >> 16), g0 = bf2f(gv[q] & 0xffffu), g1 = bf2f(gv[q] >> 16);
                ov[q] = pg8::cvt_pk_bf16(gelu_tanh(g0) * h0, gelu_tanh(g1) * h1); }
            *(u32x4*)(A.Gout + grow * A.gpitch + hb * 64 + ch * 8) = ov; }
    }
    (void)bsum;
    LDS_WAIT();
}
template <bool FINAL>
__device__ __forceinline__ void phase(ldsp lds, const Args& A, bool ctx_too, int wg, int G, int g_wave) {
    const int tid = fresh_tid(); const int wave = __builtin_amdgcn_readfirstlane(tid >> 6); LAS unsigned char* xt = lds + wave * WAVE_LDS;
    LAS unsigned char* wgl = lds + NWAVES * WAVE_LDS; LAS float* cst = (LAS float*)(lds + NWAVES * WAVE_LDS + 4 * 64 * 144);
    const int hb = wg & 15;
    for (int c = tid; c < 4 * 64 * 8; c += NTHR) { const int row = c >> 3, ch = c & 7, gm = row >> 6, o = row & 63;
        *(LAS u32x4*)(wgl + row * 144 + ch * 16) = *(const u32x4*)(A.Wg + ((size_t)((gm * 16 + hb) * 64 + o)) * 64 + ch * 8); }
    for (int c = tid; c < 11 * 64; c += NTHR) { const int k = c >> 6, ch = hb * 64 + (c & 63);
        cst[c] = k < 4 ? A.conv_w[k * 1024 + ch] : k == 4 ? A.conv_b[ch] : k < 7 ? -1.4426950408889634f * A.b_a[(k - 5) * 1024 + ch] : k < 9 ? -1.4426950408889634f * A.b_i[(k - 7) * 1024 + ch] : 8.0f * 1.4426950408889634f * A.sp[(k - 9) * 1024 + ch]; }
    __syncthreads();
    const int c_lo = ctx_too ? 0 : 4, nch = NCHUNK - c_lo, total = NB * nch;
    const int per = G >> 4;
    for (int u = (wg >> 4) * NWAVES + wave; u < total; u += per * NWAVES) { const int cid = c_lo + u % nch, bb = u / nch; wave_unit<FINAL>(xt, wgl, cst, A, bb, cid, hb, tid); }
    __syncthreads();
}
__device__ __forceinline__ void carry_phase(const f32x2* SUM, float* CARRY, int wg, int G, int g_wave) {
    const int tid = fresh_tid(); const int lane = tid & 63, wave = __builtin_amdgcn_readfirstlane(tid >> 6);
    for (int u = wg + G * wave; u < 2 * NB * 16; u += G * NWAVES) { const int cb = u & 15, bb = (u >> 4) & 7, dir = u >> 7;
        const f32x2* S = SUM + ((size_t)dir * NB + bb) * NCHUNK * 1024 + cb * 64 + lane; float* C = CARRY + ((size_t)dir * NB + bb) * NCHUNK * 1024 + cb * 64 + lane;
        float state = 0.f;
        for (int i0 = 0; i0 < NCHUNK; i0 += 12) { f32x2 v[12]; int id[12];
#pragma unroll
            for (int j = 0; j < 12; ++j) { const int i = i0 + j; id[j] = dir == 0 ? i : (i < 4 ? 3 - i : NCHUNK + 3 - i); v[j] = S[(size_t)id[j] * 1024]; }
#pragma unroll
            for (int j = 0; j < 12; ++j) { C[(size_t)id[j] * 1024] = state; state = v[j].x * state + v[j].y; } }
    }
}
}
namespace rowp {
struct LnArgs { bool dry; bool f8; float* X1; bf16* U2; const float* lng; const float* lnb; const float* mods; const bf16* wrh; const bf16* wrl; const float* brt; int* asg_e; int* asg_p; float* asg_g; int* wgc; };
__device__ __forceinline__ void ln_router_phase(ldsp lds, const LnArgs& A, int nrow, int wg, int G, int g_wave) {
    const int tid = fresh_tid(), lane = tid & 63, fr = lane & 15, kq = lane >> 4; const int wave = __builtin_amdgcn_readfirstlane(tid >> 6);
    LAS int* cnt = (LAS int*)(lds + LM_CNT);
    if (tid < 32 && !A.dry) cnt[tid] = 0;
    __syncthreads();
    constexpr int ARS = 2064;
    LAS float* part = (LAS float*)(lds + 66048); LAS float* lg = (LAS float*)(lds + 82432);
    const int ngrp = nrow / 16;
    for (int grp = wg; grp < ngrp; grp += G) {
#pragma unroll
        for (int rr = 0; rr < 2; ++rr) { const int lr = 2 * wave + rr, row = grp * 16 + lr; const int bb = row < NLAT ? (row >> 13) : 8;
            float* xp = A.X1 + (size_t)row * D; f32x4 v[4]; float s = 0.f;
#pragma unroll
            for (int j = 0; j < 4; ++j) { v[j] = *(const f32x4*)(xp + 4 * lane + 256 * j); s += (v[j][0] + v[j][1]) + (v[j][2] + v[j][3]); }
            const float mean = wave_sum(s) * (1.0f / D); float s2 = 0.f;
#pragma unroll
            for (int j = 0; j < 4; ++j) { v[j] = v[j] - mean; s2 += (v[j][0] * v[j][0] + v[j][1] * v[j][1]) + (v[j][2] * v[j][2] + v[j][3] * v[j][3]); }
            const float rstd = 1.0f / sqrtf(wave_sum(s2) * (1.0f / D) + LN_EPS);
            const float* sh = A.mods + (size_t)(bb * 6 + 3) * D; const float* sc = A.mods + (size_t)(bb * 6 + 4) * D;
#pragma unroll
            for (int j = 0; j < 4; ++j) { const int c = 4 * lane + 256 * j; const f32x4 gg = *(const f32x4*)(A.lng + c), bbv = *(const f32x4*)(A.lnb + c);
                const f32x4 x1 = v[j] * rstd * gg + bbv; if (!A.dry) *(f32x4*)(xp + c) = x1;
                const f32x4 u = x1 * (*(const f32x4*)(sc + c) + 1.0f) + *(const f32x4*)(sh + c);
                unsigned h[4], lo[4];
#pragma unroll
                for (int e = 0; e < 4; ++e) { h[e] = f2bf(u[e]); lo[e] = f2bf(u[e] - bf2f(h[e])); }
                const u32x2 hw = {h[0] | (h[1] << 16), h[2] | (h[3] << 16)}, lw = {lo[0] | (lo[1] << 16), lo[2] | (lo[3] << 16)};
                if (A.dry) {} else if (A.f8) { unsigned w8 = 0u; w8 = __builtin_amdgcn_cvt_pk_fp8_f32(u[0], u[1], w8, false); w8 = __builtin_amdgcn_cvt_pk_fp8_f32(u[2], u[3], w8, true); *(unsigned*)((unsigned char*)A.U2 + (size_t)row * D + c) = w8; }
                else *(u32x2*)(A.U2 + (size_t)row * D + c) = hw;
                *(LAS u32x2*)(lds + lr * ARS + c * 2) = hw; *(LAS u32x2*)(lds + 33024 + lr * ARS + c * 2) = lw; } }
        __syncthreads();
        { f32x4 acc[2] = {{0.f, 0.f, 0.f, 0.f}, {0.f, 0.f, 0.f, 0.f}};
#pragma unroll
          for (int ks = 0; ks < 4; ++ks) { const int k0 = 128 * wave + 32 * ks + 8 * kq;
              const bf16x8 ah = *(const LAS bf16x8*)(lds + fr * ARS + k0 * 2), al = *(const LAS bf16x8*)(lds + 33024 + fr * ARS + k0 * 2);
#pragma unroll
              for (int nt = 0; nt < 2; ++nt) { const bf16x8 bh = *(const bf16x8*)(A.wrh + (size_t)(16 * nt + fr) * D + k0), bl = *(const bf16x8*)(A.wrl + (size_t)(16 * nt + fr) * D + k0);
                  acc[nt] = __builtin_amdgcn_mfma_f32_16x16x32_bf16(ah, bh, acc[nt], 0, 0, 0);
                  acc[nt] = __builtin_amdgcn_mfma_f32_16x16x32_bf16(al, bh, acc[nt], 0, 0, 0);
                  acc[nt] = __builtin_amdgcn_mfma_f32_16x16x32_bf16(ah, bl, acc[nt], 0, 0, 0); } }
#pragma unroll
          for (int nt = 0; nt < 2; ++nt)
#pragma unroll
              for (int r = 0; r < 4; ++r) part[(wave * 16 + 4 * kq + r) * 32 + 16 * nt + fr] = acc[nt][r]; }
        __syncthreads();
        { const int row = tid >> 5, e = tid & 31; float s = A.brt[e];
#pragma unroll
          for (int w = 0; w < 8; ++w) s += part[(w * 16 + row) * 32 + e];
          lg[row * 32 + e] = s; }
        __syncthreads();
        if (tid < 16) { const int row = grp * 16 + tid; float v[32];
#pragma unroll
            for (int e = 0; e < 32; ++e) v[e] = lg[tid * 32 + e];
            int be[4]; float bv[4];
#pragma unroll
            for (int k = 0; k < 4; ++k) { float best = -INFINITY; int bi = 0;
#pragma unroll
                for (int e = 0; e < 32; ++e) { const bool taken = (k > 0 && be[0] == e) || (k > 1 && be[1] == e) || (k > 2 && be[2] == e); if (!taken && v[e] > best) { best = v[e]; bi = e; } }
                be[k] = bi; bv[k] = best; }
            float ex[4], se = 0.f;
#pragma unroll
            for (int k = 0; k < 4; ++k) { ex[k] = __expf(bv[k] - bv[0]); se += ex[k]; }
            const float inv = 1.0f / se;
#pragma unroll
            for (int k = 0; k < 4; ++k) { if (A.dry) { if (ex[k] * inv < -1.0f) A.asg_g[row * 4 + k] = (float)be[k]; } else { const int pos = __hip_atomic_fetch_add(&cnt[be[k]], 1, __ATOMIC_RELAXED, __HIP_MEMORY_SCOPE_WORKGROUP); A.asg_e[row * 4 + k] = be[k]; A.asg_p[row * 4 + k] = pos; A.asg_g[row * 4 + k] = ex[k] * inv; } } }
        __syncthreads();
    }
    __syncthreads();
    if (tid < 32 && !A.dry) A.wgc[wg * 32 + tid] = cnt[tid];
}
__device__ __forceinline__ void moe_tables(ldsp lds, const int* wgc, int wg, int G, int g_wave) {
    const int tid = fresh_tid();
    LAS int* pst = (LAS int*)(lds + LM_PST); LAS int* myb = (LAS int*)(lds + LM_MYB); LAS int* ntl = (LAS int*)(lds + LM_NT); LAS unsigned short* te = (LAS unsigned short*)(lds + LM_TE);
    LAS int* tmp = (LAS int*)lds;
    { const int e = tid & 31, p = tid >> 5; int tot = 0, below = 0;
#pragma unroll 1
      for (int w = p; w < G; w += 16) { const int c = wgc[w * 32 + e]; tot += c; if (w < wg) below += c; }
      tmp[p * 32 + e] = tot; tmp[512 + p * 32 + e] = below; }
    __syncthreads();
    if (tid < 32) { int tot = 0, below = 0;
#pragma unroll
        for (int p = 0; p < 16; ++p) { tot += tmp[p * 32 + tid]; below += tmp[512 + p * 32 + tid]; }
        myb[tid] = below; tmp[1024 + tid] = (tot + 255) & ~255; }
    __syncthreads();
    if (tid == 0) { int acc = 0;
#pragma unroll 1
        for (int e = 0; e < 32; ++e) { pst[e] = acc; const int nt_e = tmp[1024 + e] >> 8;
#pragma unroll 1
            for (int i = 0; i < nt_e; ++i) te[(acc >> 8) + i] = (unsigned short)e; acc += tmp[1024 + e]; } pst[32] = acc; ntl[0] = acc >> 8; }
    __syncthreads();
}
__device__ __forceinline__ void gather_phase(ldsp lds, bool f8, const bf16* U2, bf16* XS, const int* asg_e, const int* asg_p, int* asg_s, int nrow, int wg, int G, int g_wave) {
    const int tid = fresh_tid(), lane = tid & 63; const int wave = __builtin_amdgcn_readfirstlane(tid >> 6);
    const LAS int* pst = (const LAS int*)(lds + LM_PST); const LAS int* myb = (const LAS int*)(lds + LM_MYB);
    const int ngrp = nrow / 16;
    for (int grp = wg; grp < ngrp; grp += G) {
#pragma unroll
        for (int rr = 0; rr < 2; ++rr) { const int row = grp * 16 + 2 * wave + rr;
            if (f8) { const unsigned char* u8 = (const unsigned char*)U2; unsigned char* x8 = (unsigned char*)XS;
                const u32x4 v0 = *(const u32x4*)(u8 + (size_t)row * D + lane * 16);
#pragma unroll
                for (int k = 0; k < 4; ++k) { const int e = asg_e[row * 4 + k], slot = pst[e] + myb[e] + asg_p[row * 4 + k];
                    if (lane == 0) asg_s[row * 4 + k] = slot;
                    *(u32x4*)(x8 + (size_t)slot * D + lane * 16) = v0; } }
            else {
            const u32x4 v0 = *(const u32x4*)(U2 + (size_t)row * D + lane * 8), v1 = *(const u32x4*)(U2 + (size_t)row * D + 512 + lane * 8);
#pragma unroll
            for (int k = 0; k < 4; ++k) { const int e = asg_e[row * 4 + k], slot = pst[e] + myb[e] + asg_p[row * 4 + k];
                if (lane == 0) asg_s[row * 4 + k] = slot;
                *(u32x4*)(XS + (size_t)slot * D + lane * 8) = v0; *(u32x4*)(XS + (size_t)slot * D + 512 + lane * 8) = v1; } } }
    }
}
struct CombArgs { const float* X1; const bf16* YS; const int* asg_s; const float* asg_g; const float* mods; const float* lng; const float* lnb; float* out_lat; float* out_ctx; bf16* Unext; unsigned char* U8next; const float* mods_next; };
__device__ __forceinline__ void combine_phase(const CombArgs& A, int nrow, int gw, int NGW, int lane) {
    for (int row = gw; row < nrow; row += NGW) { const bool lat = row < NLAT; const int bb = lat ? (row >> 13) : 8;
        int sl[4]; float gt[4];
#pragma unroll
        for (int k = 0; k < 4; ++k) { sl[k] = A.asg_s[row * 4 + k]; gt[k] = A.asg_g[row * 4 + k]; }
        const float* g2 = A.mods + (size_t)(bb * 6 + 5) * D; f32x4 v[4]; float s = 0.f;
#pragma unroll
        for (int j = 0; j < 4; ++j) { const int c = 4 * lane + 256 * j; f32x4 f = {0.f, 0.f, 0.f, 0.f};
#pragma unroll
            for (int k = 0; k < 4; ++k) { const u32x2 y = *(const u32x2*)(A.YS + (size_t)sl[k] * D + c); f[0] += gt[k] * bf2f(y.x & 0xffffu); f[1] += gt[k] * bf2f(y.x >> 16); f[2] += gt[k] * bf2f(y.y & 0xffffu); f[3] += gt[k] * bf2f(y.y >> 16); }
            v[j] = *(const f32x4*)(A.X1 + (size_t)row * D + c) * DN_ALPHA + *(const f32x4*)(g2 + c) * f; s += (v[j][0] + v[j][1]) + (v[j][2] + v[j][3]); }
        const float mean = wave_sum(s) * (1.0f / D); float s2 = 0.f;
#pragma unroll
        for (int j = 0; j < 4; ++j) { v[j] = v[j] - mean; s2 += (v[j][0] * v[j][0] + v[j][1] * v[j][1]) + (v[j][2] * v[j][2] + v[j][3] * v[j][3]); }
        const float rstd = 1.0f / sqrtf(wave_sum(s2) * (1.0f / D) + LN_EPS);
        float* op = lat ? A.out_lat + (size_t)row * D : A.out_ctx + (size_t)(row - NLAT) * D;
        const float* sh = A.mods_next + (size_t)(bb * 6 + 0) * D; const float* sc = A.mods_next + (size_t)(bb * 6 + 1) * D;
#pragma unroll
        for (int j = 0; j < 4; ++j) { const int c = 4 * lane + 256 * j; const f32x4 x2 = v[j] * rstd * *(const f32x4*)(A.lng + c) + *(const f32x4*)(A.lnb + c);
            *(f32x4*)(op + c) = x2;
            if (A.Unext) { const f32x4 u = x2 * (*(const f32x4*)(sc + c) + 1.0f) + *(const f32x4*)(sh + c); u32x2 w; w.x = pk2(u[0], u[1]); w.y = pk2(u[2], u[3]); *(u32x2*)(A.Unext + (size_t)row * D + c) = w;
                if (A.U8next) { unsigned w8 = 0u; w8 = __builtin_amdgcn_cvt_pk_fp8_f32(u[0], u[1], w8, false); w8 = __builtin_amdgcn_cvt_pk_fp8_f32(u[2], u[3], w8, true); *(unsigned*)(A.U8next + (size_t)row * D + c) = w8; } } }
    }
}
}
constexpr int PH_PER_LAYER = 12, N_PHASES = 2 + DEPTH * PH_PER_LAYER;
static_assert(sizeof(KArgs) == 31 * 8 + 8 + 8 + 8, "no padding in the argument struct");
#ifndef PHMASK
#define PHMASK 0xffffffu
#endif
#ifndef SUBM
#define SUBM 7
#endif
#ifndef SUB3
#define SUB3 3
#endif
#ifndef REPMASK
#define REPMASK 0
#endif
#ifndef REP2
#define REP2 0
#endif
#ifndef REP3
#define REP3 0
#endif
#define NREP(slot) ((((REPMASK) >> (slot)) & 1) ? 2 : 1)
#ifndef REPDUMMY
#define REPDUMMY 0
#endif
#ifndef REPBAR
#define REPBAR 0
#endif
__device__ __forceinline__ void rep_sync(int mode, const XcdBarrier& bar, bool multi) { if (mode == 1 && multi) xcd_barrier(bar); else if (mode == 2) { asm volatile("s_waitcnt vmcnt(0)" ::: "memory"); __syncthreads(); } else if (mode == 3) { asm volatile("s_waitcnt vmcnt(0)" ::: "memory"); } else if (mode == 4) { __builtin_amdgcn_s_barrier(); } }
#define FORREP(n) for (int rep = 0; rep < (n); ((rep + 1 < (n)) ? rep_sync(REPBAR, bar, hi - lo > 1) : (void)0), ++rep)
typedef const __attribute__((address_space(4))) KArgs CKArgs;
__device__ __forceinline__ CKArgs* fresh_args() { CKArgs* p = (CKArgs*)__builtin_amdgcn_kernarg_segment_ptr(); asm volatile("" : "+s"(p)); return p; }

__global__ void __launch_bounds__(NTHR, 2) mega(KArgs args) {
    extern __shared__ __attribute__((aligned(16))) unsigned char lds_raw[];
    const ldsp lds = (ldsp)lds_raw;
    const int G = gridDim.x, wg = blockIdx.x; const int g_wave = __builtin_amdgcn_readfirstlane((int)threadIdx.x >> 6);
    { const int tid0 = threadIdx.x; for (int u = tid0; u < (LDS_BYTES - RING_BYTES) / 4; u += NTHR) ((LAS unsigned*)(lds + RING_BYTES))[u] = 0u; }
    __syncthreads();
    const int lo = args.ph_lo, hi = args.ph_hi;
    XcdBarrier bar; bar.bar = (unsigned*)(args.ws + WS_CTL) + CW_BAR; bar.x = 0; bar.st = nullptr;
    if (hi - lo > 1) bar = xcd_barrier_post((unsigned*)(args.ws + WS_CTL) + CW_BAR, (volatile LAS unsigned*)(lds + LM_XB));
#define PHM(k) (((PHMASK) >> ((k) < 2 ? (k) : 2 + ((k) - 2) % PH_PER_LAYER)) & 1u)
#define IN(k) (PHM(k) && lo <= (k) && (k) < hi)
#ifndef BAR2
#define BAR2 1
#endif

#ifndef BARPRE
#define BARPRE 0
#endif
#ifndef BARPOST
#define BARPOST 0
#endif
#define SEAM(k) do { if (lo <= (k) && (k) + 1 < hi) { if (BARPRE) { asm volatile("s_waitcnt vmcnt(0)" ::: "memory"); __builtin_amdgcn_s_sleep(127); } xcd_barrier(bar); if (BAR2) xcd_barrier(bar); if (BARPOST) { __builtin_amdgcn_s_sleep(127); __syncthreads(); } } } while (0)
#define ENTER() CKArgs& P = *fresh_args(); unsigned char* const ws = P.ws; (void)ws

    if (IN(0)) FORREP(NREP(0)) { ENTER(); phase_pre_a(P, lds, wg, G, g_wave); __syncthreads(); }
    SEAM(0);
    if (IN(1)) FORREP(NREP(1)) { ENTER();
#pragma unroll
        for (int l = 0; l < DEPTH; ++l) { unsigned char* wl = ws + WS_WSM + l * WSM_LAYER;
            pg8::Gemm g{(const bf16*)(ws + WS_FC), (const bf16*)(wl + WSM_WXF), 256, 1024, 256}; pg8::FoldOrder S{G, wg}; FoldStore E{(bf16*)(wl + WSM_WIN)};
            pg8::gemm_phase<FoldStore, pg8::FoldOrder>(lds, g, S, E, g_wave); }
        const int tid = fresh_tid(); modulate_rows(P.in[0], P.in[2], (const float*)(ws + WS_MODS), (bf16*)(ws + WS_U), F8_MERGE ? (unsigned char*)(ws + WS_U8) : nullptr, NROW, wg * NWAVES + (tid >> 6), G * NWAVES, tid & 63);
    }
    SEAM(1);
#pragma unroll 1
    for (int l = 0; l < DEPTH; ++l) {
        const int pb = 2 + PH_PER_LAYER * l; const bool last = (l == DEPTH - 1);
        const int nrow = last ? NLAT : NROW;
#define WL(off) (ws + WS_WSM + (size_t)l * WSM_LAYER + (off))
#define MODS(ll) ((const float*)(ws + WS_MODS) + (size_t)(ll) * 9 * 6144)
        if (IN(pb + 0)) FORREP(NREP(2)) { ENTER(); pg8::Gemm g{(const bf16*)(ws + WS_U), (const bf16*)WL(WSM_WIN), 1024, 1024, 1024}; pg8::StaticOrder S; S.init(NROW, ZC, G, wg); epi::In E{(bf16*)(ws + WS_Z), (const f32x2*)(ws + WS_ROPE)};
            pg8::gemm_phase<epi::In, pg8::StaticOrder>(lds, g, S, E, g_wave); }
        SEAM(pb + 0);
        if (IN(pb + 1)) {
            if (SUBM & 1) FORREP((REP2 & 1) ? 2 : 1) { ENTER(); rg::Args RA{(bf16*)(ws + WS_Z), P.in[9] + l * 4096, P.in[10] + l * 1024, (const bf16*)WL(WSM_WG), P.in[12] + l * 2048, P.in[14] + l * 2048, (const float*)(ws + WS_SP) + l * 2048, (f32x2*)(ws + WS_SUM), nullptr, nullptr, 0};
                rg::phase<false>(lds, RA, true, wg, G, g_wave); __syncthreads(); }
            if (SUBM & 2) FORREP((REP2 & 2) ? 2 : 1) { ENTER(); att::attn_phase(lds, (bf16*)(ws + WS_Z), P.in[7] + l * 16, !last, wg, G, g_wave, rep ? (bf16*)(ws + WS_Y) : (bf16*)(ws + WS_Z) + ZQ, rep ? 1024 : ZC); __syncthreads(); }
            if (SUBM & 4) FORREP((REP2 & 4) ? 2 : 1) { ENTER(); fft::pass1_phase(lds, (bf16*)(ws + WS_Z), (bf16*)(ws + WS_T), ws, !last, wg, G, g_wave); } }
        SEAM(pb + 1);
        if (IN(pb + 2)) FORREP(NREP(13)) { ENTER(); rg::carry_phase((const f32x2*)(ws + WS_SUM), (float*)(ws + WS_CARRY), wg, G, g_wave); }
        SEAM(pb + 2);
        if (IN(pb + 3)) {
            if (SUB3 & 1) FORREP((REP3 & 1) ? 2 : 1) { ENTER(); rg::Args RA{(bf16*)(ws + WS_Z), P.in[9] + l * 4096, P.in[10] + l * 1024, (const bf16*)WL(WSM_WG), P.in[12] + l * 2048, P.in[14] + l * 2048, (const float*)(ws + WS_SP) + l * 2048, (f32x2*)(ws + WS_SUM), (const float*)(ws + WS_CARRY),
                  rep ? (bf16*)(ws + WS_Y) : (bf16*)(ws + WS_Z) + ZGR, rep ? 1024 : ZC};
              rg::phase<true>(lds, RA, !last, wg, G, g_wave); __syncthreads(); }
            if (SUB3 & 2) FORREP((REP3 & 2) ? 2 : 1) { ENTER(); fft::pass2_phase(lds, (bf16*)(ws + WS_Z), (const bf16*)(ws + WS_T), ws, wg, G, g_wave); } }
        SEAM(pb + 3);
        if (IN(pb + 4)) FORREP(NREP(5)) {
            { ENTER(); pg8::Gemm g{(const bf16*)(ws + WS_Z) + ZQ, (const bf16*)WL(WSM_WOA), ZC, 1024, 1024}; pg8::StaticOrder S; S.init(nrow, 1024, G, wg); epi::Store E{(bf16*)(ws + WS_Y), 3072, nullptr, 0, 1024}; pg8::gemm_phase<epi::Store, pg8::StaticOrder>(lds, g, S, E, g_wave); }
            { ENTER(); pg8::Gemm g{(const bf16*)(ws + WS_Z) + ZGR, (const bf16*)WL(WSM_WOR), ZC, 1024, 1024}; pg8::StaticOrder S; S.init(nrow, 1024, G, (wg + 88) % G);     epi::Store E{(bf16*)(ws + WS_Y) + 1024, 3072, nullptr, 0, 1024}; pg8::gemm_phase<epi::Store, pg8::StaticOrder>(lds, g, S, E, g_wave); }
            { ENTER(); pg8::Gemm g{(const bf16*)(ws + WS_Z) + ZXC, (const bf16*)WL(WSM_WOF), ZC, 1024, 1024}; pg8::StaticOrder S; S.init(nrow, 1024, G, (wg + 176) % G); epi::Store E{(bf16*)(ws + WS_Y) + 2048, 3072, nullptr, 0, 1024}; pg8::gemm_phase<epi::Store, pg8::StaticOrder>(lds, g, S, E, g_wave); }
        }
        SEAM(pb + 4);
        if (IN(pb + 5)) FORREP(NREP(6)) { ENTER(); pg8::MergeOrder S; S.init(nrow, G, wg);
            if (F8_MERGE) { pg8::Gemm g{(const bf16*)(ws + WS_U8), (const bf16*)WL(WSM_WM8), 512, 512, 512}; epi::Merge E{(bf16*)(ws + WS_M), (const bf16*)(ws + WS_Y), P.in[19] + l * 3072, 127 - F8_WM_SHIFT};
                pg8::gemm_phase<epi::Merge, pg8::MergeOrder, true>(lds, g, S, E, g_wave); }
            else { pg8::Gemm g{(const bf16*)(ws + WS_U), (const bf16*)WL(WSM_WM), 1024, 1024, 1024}; epi::Merge E{(bf16*)(ws + WS_M), (const bf16*)(ws + WS_Y), P.in[19] + l * 3072, 0};
                pg8::gemm_phase<epi::Merge, pg8::MergeOrder, false>(lds, g, S, E, g_wave); } }
        SEAM(pb + 5);
        if (IN(pb + 6)) FORREP(NREP(7)) { ENTER(); pg8::Gemm g{(const bf16*)(ws + WS_M), (const bf16*)WL(WSM_WOUT), 1024, 1024, 1024}; pg8::StaticOrder S; S.init(nrow, 1024, G, wg);
            epi::Out E{(float*)(ws + WS_T), l == 0 ? P.in[0] : (const float*)P.out, l == 0 ? P.in[2] : (const float*)(ws + WS_X2C), MODS(l)};
            pg8::gemm_phase<epi::Out, pg8::StaticOrder>(lds, g, S, E, g_wave); }
        SEAM(pb + 6);
        if (IN(pb + 7)) FORREP(NREP(8)) { ENTER(); rowp::LnArgs A{rep != 0, (bool)((F8_LAYERS >> l) & 1u), (float*)(ws + WS_T), (bf16*)(ws + WS_U), P.in[21] + l * 1024, P.in[22] + l * 1024, MODS(l), (const bf16*)WL(WSM_WRH), (const bf16*)WL(WSM_WRL), P.in[24] + l * 32,
                (int*)(ws + WS_ASGE), (int*)(ws + WS_ASGP), (float*)(ws + WS_ASGG), (int*)(ws + WS_WGC)};
            rowp::ln_router_phase(lds, A, nrow, wg, G, g_wave); }
        SEAM(pb + 7);
        if (IN(pb + 8)) FORREP(NREP(9)) { ENTER(); rowp::moe_tables(lds, (const int*)(ws + WS_WGC), wg, G, g_wave);
            rowp::gather_phase(lds, (bool)((F8_LAYERS >> l) & 1u), (const bf16*)(ws + WS_U), (bf16*)(ws + WS_Z), (const int*)(ws + WS_ASGE), (const int*)(ws + WS_ASGP), (int*)(ws + WS_ASGS), nrow, wg, G, g_wave); }
        SEAM(pb + 8);
        if (IN(pb + 9)) FORREP(NREP(10)) { ENTER(); if (!IN(pb + 8)) rowp::moe_tables(lds, (const int*)(ws + WS_WGC), wg, G, g_wave);
            pg8::MoeOrder<8> S{G, wg, __builtin_amdgcn_readfirstlane(*(const LAS int*)(lds + LM_NT)), (const LAS unsigned short*)(lds + LM_TE)};
            if ((F8_LAYERS >> l) & 1u) { pg8::Gemm g{(const bf16*)(ws + WS_Z), (const bf16*)(ws + WS_WGU), 512, 512, 512};
                epi::Swiglu<true> E{(bf16*)(ws + WS_Y), P.in[26] + (size_t)l * NEXP * 2048, 127 - F8_WGU_SHIFT}; pg8::gemm_phase<epi::Swiglu<true>, pg8::MoeOrder<8>, true>(lds, g, S, E, g_wave); }
            else { pg8::Gemm g{(const bf16*)(ws + WS_Z), (const bf16*)(ws + WS_WGU), 1024, 1024, 1024};
                epi::Swiglu<false> E{(bf16*)(ws + WS_Y), P.in[26] + (size_t)l * NEXP * 2048, 0}; pg8::gemm_phase<epi::Swiglu<false>, pg8::MoeOrder<8>, false>(lds, g, S, E, g_wave); } }
        SEAM(pb + 9);
        if (IN(pb + 10)) FORREP(NREP(11)) { ENTER(); if (!IN(pb + 9)) rowp::moe_tables(lds, (const int*)(ws + WS_WGC), wg, G, g_wave);
            pg8::MoeOrder<4> S{G, wg, __builtin_amdgcn_readfirstlane(*(const LAS int*)(lds + LM_NT)), (const LAS unsigned short*)(lds + LM_TE)};
            if ((F8_LAYERS >> l) & 1u) { pg8::Gemm g{(const bf16*)(ws + WS_Y), (const bf16*)(ws + WS_WDN), 512, 512, 512};
                epi::Store E{(bf16*)(ws + WS_Z), 1024, P.in[28] + (size_t)l * NEXP * 1024, 127 - F8_WDN_SHIFT, 1024}; pg8::gemm_phase<epi::Store, pg8::MoeOrder<4>, true>(lds, g, S, E, g_wave); }
            else { pg8::Gemm g{(const bf16*)(ws + WS_Y), (const bf16*)(ws + WS_WDN), 1024, 1024, 1024};
                epi::Store E{(bf16*)(ws + WS_Z), 1024, P.in[28] + (size_t)l * NEXP * 1024, 0, 1024}; pg8::gemm_phase<epi::Store, pg8::MoeOrder<4>, false>(lds, g, S, E, g_wave); } }
        SEAM(pb + 10);
        if (IN(pb + 11)) FORREP(NREP(12)) { ENTER(); const int tid = fresh_tid(); const int wave = __builtin_amdgcn_readfirstlane(tid >> 6);
            rowp::CombArgs A{(const float*)(ws + WS_T), (const bf16*)(ws + WS_Z), (const int*)(ws + WS_ASGS), (const float*)(ws + WS_ASGG), MODS(l), P.in[29] + l * 1024, P.in[30] + l * 1024, (rep && (REPDUMMY & 1)) ? (float*)(ws + WS_Y) : P.out, (rep && (REPDUMMY & 2)) ? (float*)(ws + WS_Y + 300 * MiB) : (float*)(ws + WS_X2C),
                last ? nullptr : ((rep && (REPDUMMY & 4)) ? (bf16*)(ws + WS_M) : (bf16*)(ws + WS_U)), (F8_MERGE && !last) ? (unsigned char*)(ws + WS_U8) : nullptr, MODS(last ? l : l + 1)};
#ifndef REPSEL
#define REPSEL 3
#endif
#ifndef REPLAYER
#define REPLAYER 3
#endif
            if (rep == 0 || ((REPSEL & 1) && ((REPLAYER >> l) & 1))) rowp::combine_phase(A, nrow, wg * NWAVES + wave, G * NWAVES, tid & 63);
            if (!last && (rep == 0 || (REPSEL & 2))) convert_moe(P, l + 1, lds, wg * NWAVES + wave, G * NWAVES, wave, tid & 63); }
        if (!last) SEAM(pb + 11);
    }
#undef IN
#undef SEAM
}

extern "C" void kernel_launch(void* const* d_in, const int* in_sizes, int n_in, void* d_out, int out_size, void* d_ws, size_t ws_size, hipStream_t stream) {
    static int grid = 0;
    if (grid == 0) {
        if (n_in != 31 || in_sizes[0] != NLAT * D || out_size != NLAT * D || ws_size < WS_END) { fprintf(stderr, "kernel_launch: unexpected shapes / workspace (n_in %d, ws %zu < %zu)\n", n_in, ws_size, (size_t)WS_END); grid = -1; return; }
        int dev = 0, cus = 0, per_cu = 0;
        if (hipGetDevice(&dev) != hipSuccess || hipDeviceGetAttribute(&cus, hipDeviceAttributeMultiprocessorCount, dev) != hipSuccess) { grid = -1; return; }
        if (hipFuncSetAttribute((const void*)mega, hipFuncAttributeMaxDynamicSharedMemorySize, LDS_BYTES) != hipSuccess) { fprintf(stderr, "kernel_launch: hipFuncSetAttribute failed\n"); grid = -1; return; }
        if (hipOccupancyMaxActiveBlocksPerMultiprocessor(&per_cu, (const void*)mega, NTHR, LDS_BYTES) != hipSuccess || per_cu < 1) fprintf(stderr, "kernel_launch: occupancy query says %d\n", per_cu);
        (void)hipGetLastError();
        grid = cus;
    }
    if (grid < 0) return;
    if (hipMemsetAsync((char*)d_ws + WS_CTL, 0, CTL_ZERO_BYTES, stream) != hipSuccess) return;
#ifdef WSFILL
    (void)hipMemsetAsync((char*)d_ws + CTL_ZERO_BYTES, WSFILL, WS_END - CTL_ZERO_BYTES, stream); (void)hipMemsetAsync(d_out, WSFILL, (size_t)out_size * 4, stream);
#endif
    KArgs a{};
    for (int i = 0; i < 31; ++i) a.in[i] = (const float*)d_in[i];
    a.out = (float*)d_out; a.ws = (unsigned char*)d_ws;
#if MK_SINGLE
    a.ph_lo = 0; a.ph_hi = N_PHASES;
    hipLaunchKernelGGL(mega, dim3(grid), dim3(NTHR), LDS_BYTES, stream, a);
#else
    for (int p = 0; p < N_PHASES; ++p) { a.ph_lo = p; a.ph_hi = p + 1; hipLaunchKernelGGL(mega, dim3(grid), dim3(NTHR), LDS_BYTES, stream, a); }
#endif
}
```

```cpp
#include <hip/hip_runtime.h>
#include <cstdio>
#include <cstdint>

#ifndef MK_SINGLE
#define MK_SINGLE 1
#endif

#define GAS __attribute__((address_space(1)))
#define LAS __attribute__((address_space(3)))
typedef unsigned short bf16;
typedef short bf16x8 __attribute__((ext_vector_type(8)));
typedef short s16x4 __attribute__((ext_vector_type(4)));
typedef float f32x2 __attribute__((ext_vector_type(2)));
typedef float f32x4 __attribute__((ext_vector_type(4)));
typedef float f32x16 __attribute__((ext_vector_type(16)));
typedef unsigned u32x2 __attribute__((ext_vector_type(2)));
typedef unsigned u32x4 __attribute__((ext_vector_type(4)));
typedef LAS unsigned char* ldsp;

constexpr int NB = 8, SEQ = 8192, D = 1024, CTXL = 256, DEPTH = 2;
constexpr int NLAT = NB * SEQ, NCTX = NB * CTXL, NROW = NLAT + NCTX;
constexpr int IN_COLS = 4608;
constexpr int ZC = 5632, ZQ = 0, ZK = 1024, ZV = 1280, ZGR = 1536, ZXR = 2560, ZXC = 3584, ZXS = 4608;
constexpr int NEXP = 32, TOPK = 4, DFF = 1024;
constexpr int NSLOT = 278528;
constexpr int NCHUNK = (SEQ + CTXL) / 64;
constexpr float LN_EPS = 1e-5f, DN_ALPHA = 1.41421356237309515f;
constexpr float ATT_C2 = 0.125f * 1.4426950408889634f;
constexpr int NWAVES = 8, NTHR = 512;
#ifndef F8_LAYERS
#define F8_LAYERS 3u
#endif
#ifndef F8_MERGE
#define F8_MERGE 0
#endif
constexpr int F8_WGU_SHIFT = 6, F8_WDN_SHIFT = 7, F8_WM_SHIFT = 6;
typedef int v8i __attribute__((ext_vector_type(8)));

constexpr size_t MiB = 1u << 20;
constexpr size_t WS_CTL = 0, CTL_ZERO_BYTES = 1 * MiB;
constexpr size_t WS_MODS = 1 * MiB;
constexpr size_t WS_ROPE = WS_MODS + 512 * 1024;
constexpr size_t WS_TW   = WS_ROPE + 16 * 1024;
constexpr size_t WS_SP   = WS_TW + 64 * 1024;
constexpr size_t WS_FC   = WS_SP + 16 * 1024;
constexpr size_t WS_F1   = WS_FC + 256 * 1024;
constexpr size_t WS_F2   = WS_F1 + 128 * 1024;
constexpr size_t WS_F256 = WS_F2 + 16 * 1024;
constexpr size_t WS_WGC  = WS_F256 + 256 * 1024;
constexpr size_t WS_ASGE = 3 * MiB;
constexpr size_t WS_ASGP = WS_ASGE + 2 * MiB;
constexpr size_t WS_ASGG = WS_ASGP + 2 * MiB;
constexpr size_t WS_ASGS = WS_ASGG + 2 * MiB;
constexpr size_t WS_SUM  = 12 * MiB;
constexpr size_t WS_X2C  = 30 * MiB;
constexpr size_t WS_U8 = 1980 * MiB;
constexpr size_t WS_CARRY = 1971 * MiB;
constexpr size_t WS_WSM  = 41 * MiB;
constexpr size_t WSM_LAYER = 32 * MiB;
constexpr size_t WSM_WIN = 0;
constexpr size_t WSM_WXF = 11 * MiB;
constexpr size_t WSM_WOA = 13 * MiB, WSM_WOR = 15 * MiB, WSM_WOF = 17 * MiB, WSM_WOUT = 19 * MiB;
constexpr size_t WSM_WM  = 21 * MiB;
constexpr size_t WSM_WRH = 27 * MiB, WSM_WRL = WSM_WRH + 64 * 1024;
constexpr size_t WSM_WM8 = 29 * MiB;
constexpr size_t WSM_WG  = 28 * MiB;
constexpr size_t WS_WGU  = 105 * MiB;
constexpr size_t WS_WDN  = 233 * MiB;
constexpr size_t WS_U    = 297 * MiB;
constexpr size_t WS_T    = 429 * MiB;
constexpr size_t WS_Z    = 693 * MiB;
constexpr size_t WS_Y    = 1419 * MiB;
constexpr size_t WS_M    = WS_Y + 396 * MiB;
constexpr size_t WS_END  = 2046 * MiB;
static_assert((size_t)NROW * ZC * 2 <= 726 * MiB && (size_t)NSLOT * 1024 * 2 <= 544 * MiB && (size_t)NROW * 3072 * 2 <= 396 * MiB && (size_t)NROW * 2048 * 2 <= 264 * MiB, "ws map");
constexpr int CW_TMO = 0, CW_BAR = 4096;

constexpr int RING_BYTES = 131072;
constexpr int LM_XB = RING_BYTES;
constexpr int LM_CNT = RING_BYTES + 64;
constexpr int LM_PST = LM_CNT + 128;
constexpr int LM_MYB = LM_PST + 144;
constexpr int LM_NT  = LM_MYB + 128;
constexpr int LM_TE  = LM_NT + 16;
constexpr int LDS_BYTES = 147456;

#define LDS_WAIT() asm volatile("s_waitcnt lgkmcnt(0)" ::: "memory")
#define VM_WAIT() asm volatile("s_waitcnt vmcnt(0)" ::: "memory")
typedef float f32x2_cv __attribute__((ext_vector_type(2))); typedef __bf16 bf16x2_cv __attribute__((ext_vector_type(2)));
__device__ __forceinline__ unsigned pk2(float lo, float hi) { const f32x2_cv v = {lo, hi}; const bf16x2_cv b = __builtin_convertvector(v, bf16x2_cv); return __builtin_bit_cast(unsigned, b); }
__device__ __forceinline__ unsigned f2bf(float f) { return pk2(f, 0.0f) & 0xffffu; }
__device__ __forceinline__ float bf2f(unsigned h) { return __builtin_bit_cast(float, h << 16); }
__device__ __forceinline__ float wave_sum(float v) {
#pragma unroll
    for (int o = 1; o < 64; o <<= 1) v += __shfl_xor(v, o);
    return v;
}
__device__ __forceinline__ float sigmoidf_(float x) { return __builtin_amdgcn_rcpf(1.0f + __builtin_amdgcn_exp2f(-1.4426950408889634f * x)); }
__device__ __forceinline__ float gelu_tanh(float x) { const float u = 0.7978845608028654f * (x + 0.044715f * x * x * x); return x * sigmoidf_(2.0f * u); }
__device__ __forceinline__ float silu_(float x) { return x * sigmoidf_(x); }

__device__ __forceinline__ int fresh_tid_w(int wave_sgpr) { int w = wave_sgpr; asm volatile("" : "+s"(w)); int t = w * 64 + (int)__builtin_amdgcn_mbcnt_hi(~0u, __builtin_amdgcn_mbcnt_lo(~0u, 0u)); asm volatile("" : "+v"(t)); return t; }
#define fresh_tid() fresh_tid_w(g_wave)
namespace pg8 {
#define PG8_LAS __attribute__((address_space(3)))
typedef unsigned short bf16_t;
constexpr int BM = 256, BK = 64, HALF = 128, HTB = HALF * BK * 2, STAGE_BYTES = 8 * HTB, NXCD = 8, WGM = 8;
__host__ __device__ __forceinline__ int lds_byte(int r, int c) { const int st = (r >> 4) * 2 + (c >> 5), rr = r & 15, cc = c & 31, ob = rr * 64 + cc * 2; return st * 1024 + (ob ^ (((ob >> 9) & 1) << 5)); }
__host__ __device__ __forceinline__ void stage_rc(int b, int& R, int& C) { const int st = b / 1024, sb = b % 1024, swz = sb ^ (((sb >> 9) & 1) << 5); R = (st >> 1) * 16 + swz / 64; C = (st & 1) * 32 + (swz % 64) / 2; }
__host__ __device__ __forceinline__ int perm32(int rho) { const int n = rho >> 4, i = rho & 15; return 8 * (i >> 2) + 4 * n + (i & 3); }

struct Unit { int pm, pn; };
struct Gemm { const bf16_t* A; const bf16_t* Bt; int lda, ldb, K; };

struct StaticOrder {
    int nM, nN, nwg, G, c;
    __device__ void init(int M, int N, int G_, int c_) { nM = M / BM; nN = N / BM; nwg = nM * nN; G = G_; c = c_; }
    __device__ bool next(int i, Unit& u) const {
        const long L = (long)i * G + c; if (L >= nwg) return false;
        int wgid = (int)L; { const int q = nwg / NXCD, r = nwg % NXCD, xcd = wgid % NXCD, off = wgid / NXCD; wgid = (xcd < r ? xcd * (q + 1) : r * (q + 1) + (xcd - r) * q) + off; }
        const int nig = WGM * nN, gid = wgid / nig, fm = gid * WGM, gsz = (nM - fm) < WGM ? (nM - fm) : WGM;
        u.pm = fm + ((wgid % nig) % gsz); u.pn = (wgid % nig) / gsz; return true;
    }
    __device__ __forceinline__ const char* a_ptr(const Gemm& g, const Unit& u) const { return (const char*)g.A + (size_t)u.pm * BM * g.lda * 2; }
    __device__ __forceinline__ const char* b_ptr(const Gemm& g, const Unit& u) const { return (const char*)g.Bt + (size_t)u.pn * BM * g.ldb * 2; }
};
struct MergeOrder {
    StaticOrder s;
    __device__ void init(int M, int G_, int c_) { s.init(M, 1024, G_, c_); }
    __device__ bool next(int i, Unit& u) const { const int j = i / 3, br = i - 3 * j; Unit t; if (!s.next(j, t)) return false; u.pm = t.pm; u.pn = br * 4 + t.pn; return true; }
    __device__ __forceinline__ const char* a_ptr(const Gemm& g, const Unit& u) const { return (const char*)g.A + (size_t)u.pm * BM * g.lda * 2; }
    __device__ __forceinline__ const char* b_ptr(const Gemm& g, const Unit& u) const { return (const char*)g.Bt + (size_t)u.pn * BM * g.ldb * 2; }
};
struct FoldOrder {
    int G, c;
    __device__ bool next(int i, Unit& u) const { const int L = i * G + c; if (L >= 32) return false; u.pm = L & 1; u.pn = L >> 1; return true; }
    __device__ __forceinline__ const char* a_ptr(const Gemm& g, const Unit& u) const { return (const char*)g.A + (size_t)u.pm * BM * g.lda * 2; }
    __device__ __forceinline__ const char* b_ptr(const Gemm& g, const Unit& u) const { const int grp = u.pn >> 2, dn = u.pn & 3; return (const char*)g.Bt + ((size_t)dn * BM * g.ldb + grp * 256) * 2; }
};
template <int NPN> struct MoeOrder {
    int G, c, nt; const PG8_LAS unsigned short* te;
    __device__ bool next(int i, Unit& u) const { const int x = c & 7, slot = c >> 3, per = G >> 3; const int Lx = i * per + slot; const int rl = Lx / NPN, pn = Lx - rl * NPN, rt = rl * 8 + x;
        if (rt >= nt) return false; u.pm = rt; u.pn = __builtin_amdgcn_readfirstlane((int)te[rt]) * NPN + pn; return true; }
    __device__ __forceinline__ const char* a_ptr(const Gemm& g, const Unit& u) const { return (const char*)g.A + (size_t)u.pm * BM * g.lda * 2; }
    __device__ __forceinline__ const char* b_ptr(const Gemm& g, const Unit& u) const { return (const char*)g.Bt + (size_t)u.pn * BM * g.ldb * 2; }
};

typedef float f32x2_c __attribute__((ext_vector_type(2))); typedef __bf16 bf16x2_c __attribute__((ext_vector_type(2)));
__device__ __forceinline__ unsigned cvt_pk_bf16(float lo, float hi) { const f32x2_c v = {lo, hi}; const bf16x2_c b = __builtin_convertvector(v, bf16x2_c); return __builtin_bit_cast(unsigned, b); }

template <class Epi, class Sched, bool F8 = false>
__device__ __forceinline__ void gemm_phase(PG8_LAS unsigned char* lds, const Gemm g, const Sched& S, const Epi& E, int g_wave) {
    const int tid = fresh_tid(), wid = __builtin_amdgcn_readfirstlane(tid >> 6), lane = tid & 63, wr = wid >> 2, wc = wid & 3, fr = lane & 15, fq = lane >> 4;
    const int K = g.K, nt = K / BK;
    unsigned voffA[2], voffB[2];
#pragma unroll
    for (int i = 0; i < 2; ++i) { int R, C; stage_rc(tid * 16 + i * 8192, R, C); const int Rb = Epi::PERM ? ((R & ~31) + perm32(R & 31)) : R;
        voffA[i] = (unsigned)(R * g.lda + C) * 2u; voffB[i] = (unsigned)(Rb * g.ldb + C) * 2u; }
    const size_t kstep = (size_t)(BK * 2);
    const size_t hstepA = (size_t)HALF * g.lda * 2, hstepB = (size_t)HALF * g.ldb * 2;
    const unsigned ldsw = (unsigned)wid * 1024u; const unsigned ldsbase = (unsigned)(uintptr_t)lds;
    const int aoff = lds_byte(wr * 64 + fr, fq * 8), boff = lds_byte(wc * 32 + fr, fq * 8);
#define PG8_SA(b, h) (((b) * 2 + (h)) * HTB)
#define PG8_SB(b, h) ((4 + (b) * 2 + (h)) * HTB)
#define PG8_STAGE(bufoff, gbase, voff) do { _Pragma("unroll") for (int _i = 0; _i < 2; ++_i) { unsigned _keep; \
        asm volatile("s_mov_b32 %0, m0\n\ts_mov_b32 m0, %3\n\ts_nop 3\n\tglobal_load_lds_dwordx4 %1, %2\n\ts_mov_b32 m0, %0" : "=&s"(_keep) : "v"((voff)[_i]), "s"((const char*)(gbase)), \
                     "s"((unsigned)__builtin_amdgcn_readfirstlane((int)(ldsbase + (unsigned)(bufoff) + ldsw + _i * 8192))) : "memory"); } } while (0)
#define PG8_LDA(dst, b, h) do { _Pragma("unroll") for (int m = 0; m < 4; ++m) _Pragma("unroll") for (int k = 0; k < 2; ++k) dst[m][k] = *(const PG8_LAS bf16x8*)(lds + PG8_SA(b, h) + aoff + m * 2048 + k * 1024); } while (0)
#define PG8_LDB(dst, b, h) do { _Pragma("unroll") for (int n = 0; n < 2; ++n) _Pragma("unroll") for (int k = 0; k < 2; ++k) dst[n][k] = *(const PG8_LAS bf16x8*)(lds + PG8_SB(b, h) + boff + n * 2048 + k * 1024); } while (0)
#define PG8_MMA(ai, bj, At, Bt) do { __builtin_amdgcn_s_setprio(1); _Pragma("unroll") for (int m = 0; m < 4; ++m) _Pragma("unroll") for (int n = 0; n < 2; ++n) _Pragma("unroll") for (int k = 0; k < 2; ++k) \
        acc[ai][bj][m][n] = __builtin_amdgcn_mfma_f32_16x16x32_bf16(Bt[n][k], At[m][k], acc[ai][bj][m][n], 0, 0, 0); __builtin_amdgcn_s_setprio(0); } while (0)
#define PG8_CAT(x, y) __builtin_shufflevector(__builtin_bit_cast(u32x4, x), __builtin_bit_cast(u32x4, y), 0, 1, 2, 3, 4, 5, 6, 7)
#define PG8_MMA8(ai, bj, At, Bt) do { __builtin_amdgcn_s_setprio(1); _Pragma("unroll") for (int m = 0; m < 4; ++m) _Pragma("unroll") for (int n = 0; n < 2; ++n) { \
        const v8i _wa = __builtin_bit_cast(v8i, PG8_CAT(Bt[n][0], Bt[n][1])), _xa = __builtin_bit_cast(v8i, PG8_CAT(At[m][0], At[m][1])); \
        asm volatile("v_mfma_scale_f32_16x16x128_f8f6f4 %0, %1, %2, %0, %3, %4 op_sel_hi:[0,0,0]" : "+v"(acc[ai][bj][m][n]) : "v"(_wa), "v"(_xa), "v"(f8sw), "v"(f8s1)); } \
        __builtin_amdgcn_s_setprio(0); } while (0)
#define PG8_MM(ai, bj, At, Bt) do { if constexpr (F8) PG8_MMA8(ai, bj, At, Bt); else PG8_MMA(ai, bj, At, Bt); } while (0)
#define PG8_WAIT_V(n) asm volatile("s_waitcnt vmcnt(" #n ")" ::: "memory")
#define PG8_WAIT_L(n) asm volatile("s_waitcnt lgkmcnt(" #n ")" ::: "memory")
#define PG8_BAR __builtin_amdgcn_s_barrier()
#define PG8_SCHED __builtin_amdgcn_sched_barrier(0)
    Unit cur, nxt; int ui = 0;
    if (!S.next(0, cur)) return;
    f32x4 acc[2][2][4][2];
#pragma unroll
    for (int a = 0; a < 2; ++a)
#pragma unroll
        for (int b = 0; b < 2; ++b)
#pragma unroll
            for (int m = 0; m < 4; ++m)
#pragma unroll
                for (int n = 0; n < 2; ++n) { acc[a][b][m][n] = (f32x4){0.f, 0.f, 0.f, 0.f}; if constexpr (F8) asm volatile("" : "+v"(acc[a][b][m][n])); }
    bf16x8 At[4][2], B0[2][2], B1[2][2];
    int f8sw = 127, f8s1 = 127; if constexpr (F8) { f8sw = E.f8_scale_w; asm volatile("" : "+v"(f8sw), "+v"(f8s1)); }
    const char* cA = S.a_ptr(g, cur); const char* cB = S.b_ptr(g, cur);
    PG8_STAGE(PG8_SB(0, 0), cB, voffB); PG8_STAGE(PG8_SB(0, 1), cB + hstepB, voffB); PG8_STAGE(PG8_SA(0, 0), cA, voffA); PG8_STAGE(PG8_SA(0, 1), cA + hstepA, voffA);
    if (wr == 1) PG8_BAR;
    PG8_WAIT_V(2); PG8_BAR;
    PG8_STAGE(PG8_SB(1, 0), cB + kstep, voffB); PG8_STAGE(PG8_SA(1, 0), cA + kstep, voffA); PG8_STAGE(PG8_SB(1, 1), cB + hstepB + kstep, voffB);
    PG8_WAIT_V(6); PG8_BAR;
    for (;;) {
        const bool has_next = S.next(ui + 1, nxt);
        const char* nA = has_next ? S.a_ptr(g, nxt) : cA; const char* nB = has_next ? S.b_ptr(g, nxt) : cB;
#pragma unroll 1
        for (int t = 0; t < nt; t += 2) {
            const bool last = (t == nt - 2);
            const char* a1 = cA + (size_t)(t + 1) * kstep;
            const char* a2 = last ? nA : cA + (size_t)(t + 2) * kstep; const char* b2 = last ? nB : cB + (size_t)(t + 2) * kstep;
            const char* a3 = a2 + kstep; const char* b3 = b2 + kstep;
            PG8_LDB(B0, 0, 0); PG8_LDB(B1, 0, 1); PG8_SCHED; PG8_LDA(At, 0, 0); PG8_STAGE(PG8_SA(1, 1), a1 + hstepA, voffA);
            PG8_WAIT_V(8); PG8_WAIT_L(0); PG8_BAR; PG8_MM(0, 0, At, B0); PG8_MM(0, 1, At, B1); PG8_BAR; PG8_SCHED;
            PG8_LDA(At, 0, 1); PG8_STAGE(PG8_SB(0, 0), b2, voffB); PG8_STAGE(PG8_SB(0, 1), b2 + hstepB, voffB); PG8_STAGE(PG8_SA(0, 0), a2, voffA);
            PG8_WAIT_V(8); PG8_WAIT_L(0); PG8_BAR; PG8_MM(1, 0, At, B0); PG8_MM(1, 1, At, B1); PG8_BAR; PG8_SCHED;
            PG8_LDB(B0, 1, 0); PG8_LDB(B1, 1, 1); PG8_SCHED; PG8_LDA(At, 1, 0); PG8_STAGE(PG8_SA(0, 1), a2 + hstepA, voffA);
            PG8_WAIT_V(8); PG8_WAIT_L(0); PG8_BAR; PG8_MM(0, 0, At, B0); PG8_MM(0, 1, At, B1); PG8_BAR; PG8_SCHED;
            PG8_LDA(At, 1, 1); PG8_STAGE(PG8_SB(1, 0), b3, voffB); PG8_STAGE(PG8_SB(1, 1), b3 + hstepB, voffB); PG8_STAGE(PG8_SA(1, 0), a3, voffA);
            PG8_WAIT_V(8); PG8_WAIT_L(0); PG8_BAR; PG8_MM(1, 0, At, B0); PG8_MM(1, 1, At, B1); PG8_BAR; PG8_SCHED;
        }
        if (wr == 0) PG8_BAR;
        if constexpr (F8) {
#pragma unroll
            for (int a = 0; a < 2; ++a)
#pragma unroll
                for (int b = 0; b < 2; ++b) { if (a == 0 && b == 0) asm volatile("s_nop 15\n\ts_nop 3" : "+v"(acc[0][0][0][0]), "+v"(acc[0][0][0][1]), "+v"(acc[0][0][1][0]), "+v"(acc[0][0][1][1]), "+v"(acc[0][0][2][0]), "+v"(acc[0][0][2][1]), "+v"(acc[0][0][3][0]), "+v"(acc[0][0][3][1]));
                    else asm volatile("" : "+v"(acc[a][b][0][0]), "+v"(acc[a][b][0][1]), "+v"(acc[a][b][1][0]), "+v"(acc[a][b][1][1]), "+v"(acc[a][b][2][0]), "+v"(acc[a][b][2][1]), "+v"(acc[a][b][3][0]), "+v"(acc[a][b][3][1])); } }
        E(acc, cur, wr, wc, fr, fq);
        if (!has_next) break;
#pragma unroll
        for (int a = 0; a < 2; ++a)
#pragma unroll
            for (int b = 0; b < 2; ++b)
#pragma unroll
                for (int m = 0; m < 4; ++m)
#pragma unroll
                    for (int n = 0; n < 2; ++n) { acc[a][b][m][n] = (f32x4){0.f, 0.f, 0.f, 0.f}; if constexpr (F8) asm volatile("" : "+v"(acc[a][b][m][n])); }
        cur = nxt; cA = nA; cB = nB; ++ui;
        if (wr == 1) PG8_BAR;
    }
    PG8_WAIT_V(0);
    PG8_BAR;
#undef PG8_SA
#undef PG8_SB
#undef PG8_STAGE
#undef PG8_LDA
#undef PG8_LDB
#undef PG8_MMA
#undef PG8_MMA8
#undef PG8_MM
#undef PG8_CAT
#undef PG8_WAIT_V
#undef PG8_WAIT_L
#undef PG8_BAR
#undef PG8_SCHED
}
}
namespace epi {
using pg8::Unit; using pg8::cvt_pk_bf16; constexpr int HALF = 128, BM = 256;
struct Store {
    static constexpr bool PERM = true;
    bf16* O; int ldc; const float* bias;
    int f8_scale_w;
    int ncol_out;
    __device__ __forceinline__ void operator()(const f32x4 (&acc)[2][2][4][2], const Unit& u, int wr, int wc, int fr, int fq) const {
        const int row0 = u.pm * BM + wr * 64 + fr; const int gcol0 = u.pn * BM + wc * 32 + 8 * fq; const int col0 = gcol0 % ncol_out;
        f32x4 bv[2][2];
#pragma unroll
        for (int bj = 0; bj < 2; ++bj)
#pragma unroll
            for (int n = 0; n < 2; ++n) bv[bj][n] = bias ? *(const f32x4*)(bias + gcol0 + bj * HALF + 4 * n) : (f32x4){0.f, 0.f, 0.f, 0.f};
#pragma unroll
        for (int ai = 0; ai < 2; ++ai)
#pragma unroll
            for (int m = 0; m < 4; ++m) { bf16* rowp = O + (size_t)(row0 + ai * HALF + m * 16) * ldc + col0;
#pragma unroll
                for (int bj = 0; bj < 2; ++bj) { const f32x4 v0 = acc[ai][bj][m][0] + bv[bj][0], v1 = acc[ai][bj][m][1] + bv[bj][1];
                    u32x4 w; w.x = cvt_pk_bf16(v0[0], v0[1]); w.y = cvt_pk_bf16(v0[2], v0[3]); w.z = cvt_pk_bf16(v1[0], v1[1]); w.w = cvt_pk_bf16(v1[2], v1[3]);
                    *(u32x4*)(rowp + bj * HALF) = w; } }
    }
};
struct In {
    static constexpr bool PERM = true;
    bf16* Z; const f32x2* rope;
    __device__ __forceinline__ void operator()(const f32x4 (&acc)[2][2][4][2], const Unit& u, int wr, int wc, int fr, int fq) const {
        const int row0 = u.pm * BM + wr * 64 + fr; const int col0 = u.pn * BM + wc * 32 + 8 * fq;
        const bool isq = u.pn < 4, dorope = (u.pn <= 4) && (u.pm * BM < NLAT);
        const float sc = isq ? ATT_C2 : 1.0f;
        if (!dorope) {
#pragma unroll
            for (int ai = 0; ai < 2; ++ai)
#pragma unroll
                for (int m = 0; m < 4; ++m) { bf16* rowp = Z + (size_t)(row0 + ai * HALF + m * 16) * ZC + col0;
#pragma unroll
                    for (int bj = 0; bj < 2; ++bj) { const f32x4 v0 = acc[ai][bj][m][0] * sc, v1 = acc[ai][bj][m][1] * sc;
                        u32x4 w; w.x = cvt_pk_bf16(v0[0], v0[1]); w.y = cvt_pk_bf16(v0[2], v0[3]); w.z = cvt_pk_bf16(v1[0], v1[1]); w.w = cvt_pk_bf16(v1[2], v1[3]);
                        *(u32x4*)(rowp + bj * HALF) = w; } }
            return; }
        const bool second = fq >= 2;
        const int i0 = 8 * (fq & 1);
#pragma unroll
        for (int ai = 0; ai < 2; ++ai)
#pragma unroll
            for (int m = 0; m < 4; ++m) { const int row = row0 + ai * HALF + m * 16; bf16* rowp = Z + (size_t)row * ZC + col0;
                const int t = row & (SEQ - 1); const int pos = (wc & 1) ? (t & 63) : (t >> 6); const f32x4* rp = (const f32x4*)(rope + pos * 16 + i0);
                const f32x4 c01 = rp[0], c23 = rp[1], c45 = rp[2], c67 = rp[3];
                const float cs[8] = {c01[0], c01[2], c23[0], c23[2], c45[0], c45[2], c67[0], c67[2]}, sn[8] = {c01[1], c01[3], c23[1], c23[3], c45[1], c45[3], c67[1], c67[3]};
#pragma unroll
                for (int bj = 0; bj < 2; ++bj) { float o[8];
#pragma unroll
                    for (int q = 0; q < 8; ++q) { const float mine = acc[ai][bj][m][q >> 2][q & 3];
                        const auto rr = __builtin_amdgcn_permlane32_swap(__float_as_uint(mine), __float_as_uint(mine), false, false);
                        const float other = __uint_as_float(second ? rr[0] : rr[1]);
                        o[q] = (mine * cs[q] + (second ? other : -other) * sn[q]) * sc; }
                    u32x4 w; w.x = cvt_pk_bf16(o[0], o[1]); w.y = cvt_pk_bf16(o[2], o[3]); w.z = cvt_pk_bf16(o[4], o[5]); w.w = cvt_pk_bf16(o[6], o[7]);
                    *(u32x4*)(rowp + bj * HALF) = w; } }
    }
};
struct Merge {
    static constexpr bool PERM = true;
    bf16* Mg; const bf16* Y; const float* bm; int f8_scale_w;
    __device__ __forceinline__ void operator()(const f32x4 (&acc)[2][2][4][2], const Unit& u, int wr, int wc, int fr, int fq) const {
        const int br = u.pn >> 2, pn = u.pn & 3;
        const int row0 = u.pm * BM + wr * 64 + fr; const int col0 = pn * BM + wc * 32 + 8 * fq;
        f32x4 bv[2][2];
#pragma unroll
        for (int bj = 0; bj < 2; ++bj)
#pragma unroll
            for (int n = 0; n < 2; ++n) bv[bj][n] = *(const f32x4*)(bm + br * 1024 + col0 + bj * HALF + 4 * n);
        u32x4 yb[2][2], mb[2][2];
#define MG_LOAD(g, p) do { const size_t row_ = (size_t)(row0 + ((g) >> 2) * HALF + ((g) & 3) * 16); _Pragma("unroll") for (int bj = 0; bj < 2; ++bj) { const int col_ = col0 + bj * HALF; \
            yb[p][bj] = *(const u32x4*)(Y + row_ * 3072 + br * 1024 + col_); if (br) { const unsigned long long* mp_ = (const unsigned long long*)(Mg + row_ * 1024 + col_);     \
                const unsigned long long q0_ = __hip_atomic_load(mp_, __ATOMIC_RELAXED, __HIP_MEMORY_SCOPE_AGENT), q1_ = __hip_atomic_load(mp_ + 1, __ATOMIC_RELAXED, __HIP_MEMORY_SCOPE_AGENT); \
                mb[p][bj] = (u32x4){(unsigned)q0_, (unsigned)(q0_ >> 32), (unsigned)q1_, (unsigned)(q1_ >> 32)}; } else mb[p][bj] = (u32x4){0u, 0u, 0u, 0u}; } } while (0)
        MG_LOAD(0, 0);
#pragma unroll
        for (int g = 0; g < 8; ++g) { const int ai = g >> 2, m = g & 3, p = g & 1; const size_t row = (size_t)(row0 + ai * HALF + m * 16);
            if (g < 7) MG_LOAD(g + 1, p ^ 1);
#pragma unroll
            for (int bj = 0; bj < 2; ++bj) { const int col = col0 + bj * HALF; const u32x4 yv = yb[p][bj], mv = mb[p][bj];
                float o[8];
#pragma unroll
                for (int e = 0; e < 8; ++e) { const float a = acc[ai][bj][m][e >> 2][e & 3] + bv[bj][e >> 2][e & 3];
                    const unsigned yw = yv[e >> 1], mw = mv[e >> 1];
                    const float y = (e & 1) ? bf2f(yw >> 16) : bf2f(yw & 0xffffu), mm = (e & 1) ? bf2f(mw >> 16) : bf2f(mw & 0xffffu);
                    o[e] = mm + sigmoidf_(a) * y; }
                u32x4 w; w.x = cvt_pk_bf16(o[0], o[1]); w.y = cvt_pk_bf16(o[2], o[3]); w.z = cvt_pk_bf16(o[4], o[5]); w.w = cvt_pk_bf16(o[6], o[7]);
                *(u32x4*)(Mg + row * 1024 + col) = w; } }
#undef MG_LOAD
    }
};
struct Out {
    static constexpr bool PERM = true;
    float* P; const float* xlat; const float* xctx; const float* mods;
    __device__ __forceinline__ void operator()(const f32x4 (&acc)[2][2][4][2], const Unit& u, int wr, int wc, int fr, int fq) const {
        const int row0 = u.pm * BM + wr * 64 + fr; const int col0 = u.pn * BM + wc * 32 + 8 * fq;
        const int bb = (u.pm * BM < NLAT) ? (u.pm * BM) / SEQ : 8;
        const float* xb = (u.pm * BM < NLAT) ? xlat : (xctx - (size_t)NLAT * D);
        const float* g1 = mods + (size_t)(bb * 6 + 2) * D;
        f32x4 gv[2][2];
#pragma unroll
        for (int bj = 0; bj < 2; ++bj)
#pragma unroll
            for (int n = 0; n < 2; ++n) gv[bj][n] = *(const f32x4*)(g1 + col0 + bj * HALF + 4 * n);
        f32x4 xb2[2][2][2];
#define OUT_LOAD(g, p) do { const size_t off_ = (size_t)(row0 + ((g) >> 2) * HALF + ((g) & 3) * 16) * D + col0; _Pragma("unroll") for (int bj = 0; bj < 2; ++bj) _Pragma("unroll") for (int n = 0; n < 2; ++n) xb2[p][bj][n] = *(const f32x4*)(xb + off_ + bj * HALF + 4 * n); } while (0)
        OUT_LOAD(0, 0);
#pragma unroll
        for (int g = 0; g < 8; ++g) { const int ai = g >> 2, m = g & 3, p = g & 1; const size_t off = (size_t)(row0 + ai * HALF + m * 16) * D + col0;
            if (g < 7) OUT_LOAD(g + 1, p ^ 1);
#pragma unroll
            for (int bj = 0; bj < 2; ++bj)
#pragma unroll
                for (int n = 0; n < 2; ++n) *(f32x4*)(P + off + bj * HALF + 4 * n) = xb2[p][bj][n] * DN_ALPHA + gv[bj][n] * acc[ai][bj][m][n]; }
#undef OUT_LOAD
    }
};
template <bool OUT8> struct Swiglu {
    static constexpr bool PERM = true;
    bf16* ACT; const float* bgu; int f8_scale_w;
    __device__ __forceinline__ void operator()(const f32x4 (&acc)[2][2][4][2], const Unit& u, int wr, int wc, int fr, int fq) const {
        const int e = u.pn >> 3, pn = u.pn & 7;
        const int row0 = u.pm * BM + wr * 64 + fr; const int hc0 = wc * 32 + 8 * fq;
        const float* bg = bgu + e * 2048 + pn * 128 + hc0;
        f32x4 bgl[2], bln[2];
#pragma unroll
        for (int n = 0; n < 2; ++n) { bgl[n] = *(const f32x4*)(bg + 4 * n); bln[n] = *(const f32x4*)(bg + 1024 + 4 * n); }
#pragma unroll
        for (int ai = 0; ai < 2; ++ai)
#pragma unroll
            for (int m = 0; m < 4; ++m) { const size_t eoff = (size_t)(row0 + ai * HALF + m * 16) * DFF + pn * 128 + hc0;
                float o[8];
#pragma unroll
                for (int q = 0; q < 8; ++q) { float gl = acc[ai][0][m][q >> 2][q & 3] + bgl[q >> 2][q & 3], ln = acc[ai][1][m][q >> 2][q & 3] + bln[q >> 2][q & 3];
                    gl = fminf(gl, 7.0f); ln = fminf(fmaxf(ln, -7.0f), 7.0f);
                    o[q] = gl * sigmoidf_(1.702f * gl) * (ln + 1.0f); }
                if constexpr (OUT8) { unsigned w0 = 0u, w1 = 0u;
                    w0 = __builtin_amdgcn_cvt_pk_fp8_f32(o[0], o[1], w0, false); w0 = __builtin_amdgcn_cvt_pk_fp8_f32(o[2], o[3], w0, true);
                    w1 = __builtin_amdgcn_cvt_pk_fp8_f32(o[4], o[5], w1, false); w1 = __builtin_amdgcn_cvt_pk_fp8_f32(o[6], o[7], w1, true);
                    *(u32x2*)((unsigned char*)ACT + eoff) = (u32x2){w0, w1}; }
                else { u32x4 w; w.x = cvt_pk_bf16(o[0], o[1]); w.y = cvt_pk_bf16(o[2], o[3]); w.z = cvt_pk_bf16(o[4], o[5]); w.w = cvt_pk_bf16(o[6], o[7]);
                    *(u32x4*)(ACT + eoff) = w; } }
    }
};
}
#define XB_TMO      128
#define XB_XCNT(j)  (256  + 64 * (j))
#define XB_XSUB(j)  (1280 + 64 * (j))
#define XB_XGEN(j)  (2304 + 64 * (j))
#define XB_TOP      3328
#define XB_TOPGEN   3392
#define XCD_BAR_WORDS 3456
#define XB_SPIN_CAP (1u << 18)
#ifndef XB_LEADER_SLEEP
#define XB_LEADER_SLEEP 0
#endif
__device__ __forceinline__ unsigned xb_ld(unsigned* p)              { return __hip_atomic_load(p, __ATOMIC_RELAXED, __HIP_MEMORY_SCOPE_AGENT); }
__device__ __forceinline__ unsigned xb_add(unsigned* p, unsigned v) { return __hip_atomic_fetch_add(p, v, __ATOMIC_RELAXED, __HIP_MEMORY_SCOPE_AGENT); }
__device__ __forceinline__ unsigned xb_xcc_id() { return (unsigned)__builtin_amdgcn_s_getreg((3 << 11) | 20) & 0xFu; }
#define XB_SPIN(cond, bar) do { unsigned _sp = 0; while (cond) { __builtin_amdgcn_s_sleep(1); \
    if ((++_sp & 255u) == 0u) { if (xb_ld(&(bar)[XB_TMO])) break; if (_sp > XB_SPIN_CAP) { atomicAdd(&(bar)[XB_TMO], 1u); break; } } } } while (0)
struct XcdBarrier { unsigned* bar; unsigned x; volatile LAS unsigned* st; };
__device__ __forceinline__ XcdBarrier xcd_barrier_post(unsigned* bar, volatile LAS unsigned* st) {
    XcdBarrier b; b.bar = bar; b.x = xb_xcc_id(); b.st = st;
    if (threadIdx.x == 0) (void)xb_add(&bar[XB_XCNT(b.x)], 1u);
    return b;
}
__device__ __forceinline__ void xcd_barrier_complete(unsigned* bar, unsigned x, unsigned& nloc, unsigned& nx) {
    const unsigned G = gridDim.x * gridDim.y * gridDim.z;
    unsigned sum, cnt, mine, sp = 0u;
    for (;;) {
        sum = 0u; cnt = 0u; mine = 0u;
#pragma unroll
        for (unsigned j = 0; j < 16; ++j) { const unsigned c = xb_ld(&bar[XB_XCNT(j)]); sum += c; cnt += (c > 0u) ? 1u : 0u; mine = (j == x) ? c : mine; }
        if (sum == G) break;
        __builtin_amdgcn_s_sleep(1);
        if ((++sp & 255u) == 0u) { if (xb_ld(&bar[XB_TMO])) break; if (sp > XB_SPIN_CAP) { atomicAdd(&bar[XB_TMO], 1u); break; } }
    }
    nloc = mine > 0u ? mine : 1u; nx = cnt > 0u ? cnt : 1u;
}
__device__ __forceinline__ void xcd_barrier(const XcdBarrier& b) {
    asm volatile("s_waitcnt vmcnt(0)" ::: "memory");
    __syncthreads();
    if (threadIdx.x == 0) {
        unsigned* bar = b.bar;
        __builtin_amdgcn_s_waitcnt(0);
        unsigned nloc = b.st[0], nx = b.st[1];
        if (nloc == 0u) { xcd_barrier_complete(bar, b.x, nloc, nx); b.st[0] = nloc; b.st[1] = nx; }
        const unsigned old = xb_add(&bar[XB_XSUB(b.x)], 1u);
        const unsigned gen = old / nloc;
        if (old + 1u == (gen + 1u) * nloc) {
#if XB_LEADER_SLEEP
            __builtin_amdgcn_s_sleep(XB_LEADER_SLEEP);
#endif
            __builtin_amdgcn_fence(__ATOMIC_RELEASE, "agent");
            asm volatile("s_waitcnt vmcnt(0)" ::: "memory");
            const unsigned og = xb_add(&bar[XB_TOP], 1u);
            const unsigned tg = og / nx;
            if (og + 1u == (tg + 1u) * nx) xb_add(&bar[XB_TOPGEN], 1u);
            else XB_SPIN(xb_ld(&bar[XB_TOPGEN]) == tg, bar);
            __builtin_amdgcn_fence(__ATOMIC_ACQUIRE, "agent");
            xb_add(&bar[XB_XGEN(b.x)], 1u);
            asm volatile("s_waitcnt vmcnt(0)" ::: "memory");
        } else {
            XB_SPIN(xb_ld(&bar[XB_XGEN(b.x)]) == gen, bar);
            __builtin_amdgcn_fence(__ATOMIC_ACQUIRE, "agent");
            asm volatile("s_waitcnt vmcnt(0)" ::: "memory");
        }
    }
    __syncthreads();
}
struct KArgs { const float* in[31]; float* out; unsigned char* ws; int ph_lo, ph_hi; };
typedef KArgs Ptrs;
__device__ __forceinline__ void tr_item(const float* W, int ldw, int k0, int n0, bf16* WT, int ldt, int dest_row0, LAS float* scr, int lane) {
#pragma unroll 8
    for (int i = 0; i < 32; ++i) { const int kk = 2 * i + (lane >> 5); scr[kk * 33 + (lane & 31)] = W[(size_t)(k0 + kk) * ldw + n0 + (lane & 31)]; }
    LDS_WAIT();
    const int c = lane & 7;
#pragma unroll
    for (int j = 0; j < 4; ++j) { const int n = (lane >> 3) + 8 * j; const LAS float* s = scr + (8 * c) * 33 + n;
        u32x4 o; o.x = pk2(s[0 * 33], s[1 * 33]); o.y = pk2(s[2 * 33], s[3 * 33]); o.z = pk2(s[4 * 33], s[5 * 33]); o.w = pk2(s[6 * 33], s[7 * 33]);
        *(u32x4*)(WT + (size_t)(dest_row0 + n) * ldt + k0 + 8 * c) = o; }
    LDS_WAIT();
}
__device__ __forceinline__ void tr_item8(const float* W, int ldw, int k0, int n0, unsigned char* WT8, int ldt, int dest_row0, float scale, LAS float* scr, int lane) {
#pragma unroll 8
    for (int i = 0; i < 32; ++i) { const int kk = 2 * i + (lane >> 5); scr[kk * 33 + (lane & 31)] = W[(size_t)(k0 + kk) * ldw + n0 + (lane & 31)] * scale; }
    LDS_WAIT();
    const int c = lane & 7;
#pragma unroll
    for (int j = 0; j < 4; ++j) { const int n = (lane >> 3) + 8 * j; const LAS float* s = scr + (8 * c) * 33 + n; unsigned w0 = 0u, w1 = 0u;
        w0 = __builtin_amdgcn_cvt_pk_fp8_f32(s[0 * 33], s[1 * 33], w0, false); w0 = __builtin_amdgcn_cvt_pk_fp8_f32(s[2 * 33], s[3 * 33], w0, true);
        w1 = __builtin_amdgcn_cvt_pk_fp8_f32(s[4 * 33], s[5 * 33], w1, false); w1 = __builtin_amdgcn_cvt_pk_fp8_f32(s[6 * 33], s[7 * 33], w1, true);
        *(u32x2*)(WT8 + (size_t)(dest_row0 + n) * ldt + k0 + 8 * c) = (u32x2){w0, w1}; }
    LDS_WAIT();
}
template <class PT> __device__ __forceinline__ void convert_moe(const PT& P, int l, ldsp lds, int gw, int NGW, int wave, int lane) {
    LAS float* scr = (LAS float*)(lds + 40960 + wave * 8448);
    const float* wgu = P.in[25] + (size_t)l * NEXP * 1024 * 2048; const float* wdn = P.in[27] + (size_t)l * NEXP * 1024 * 1024;
    bf16* WGU = (bf16*)(P.ws + WS_WGU); bf16* WDN = (bf16*)(P.ws + WS_WDN);
    constexpr int I_GU = 16 * 64, I_DN = 16 * 32, I_E = I_GU + I_DN;
    const bool f8 = (F8_LAYERS >> l) & 1u;
    for (int it = gw; it < NEXP * I_E; it += NGW) {
        const int e = it / I_E; int r = it - e * I_E;
        if (f8) {
            if (it >= NEXP * (I_E / 2)) break;
            const int e8 = it / (I_E / 2); int r8 = it - e8 * (I_E / 2);
            if (r8 < I_GU / 2) { const int p = r8 >> 6, nb = r8 & 63, n0 = nb * 32; const int half = n0 >> 10, pn = (n0 & 1023) >> 7, j0 = n0 & 127;
#pragma unroll 1
                for (int kh = 0; kh < 2; ++kh) tr_item8(wgu + (size_t)e8 * 1024 * 2048, 2048, (2 * p + kh) * 64, n0, (unsigned char*)WGU, 1024, e8 * 2048 + 256 * pn + 128 * half + j0, (float)(1 << F8_WGU_SHIFT), scr, lane); }
            else { r8 -= I_GU / 2; const int p = r8 >> 5, nb = r8 & 31;
#pragma unroll 1
                for (int kh = 0; kh < 2; ++kh) tr_item8(wdn + (size_t)e8 * 1024 * 1024, 1024, (2 * p + kh) * 64, nb * 32, (unsigned char*)WDN, 1024, e8 * 1024 + nb * 32, (float)(1 << F8_WDN_SHIFT), scr, lane); }
            continue; }
        if (r < I_GU) { const int kb = r >> 6, nb = r & 63, n0 = nb * 32; const int half = n0 >> 10, pn = (n0 & 1023) >> 7, j0 = n0 & 127;
            tr_item(wgu + (size_t)e * 1024 * 2048, 2048, kb * 64, n0, WGU, 1024, e * 2048 + 256 * pn + 128 * half + j0 - 0, scr, lane); }
        else { r -= I_GU; const int kb = r >> 5, nb = r & 31; tr_item(wdn + (size_t)e * 1024 * 1024, 1024, kb * 64, nb * 32, WDN, 1024, e * 1024 + nb * 32, scr, lane); }
    }
}

template <class PT> __device__ __forceinline__ void phase_pre_a(const PT& P, ldsp lds, int wg, int G, int g_wave) {
    const int tid = fresh_tid(), lane = tid & 63, wave = __builtin_amdgcn_readfirstlane(tid >> 6);
    const int gw = wg * NWAVES + wave, NGW = G * NWAVES, gt = wg * NTHR + tid, NT = G * NTHR;
    unsigned char* ws = P.ws;
    LAS float* sl = (LAS float*)lds;
    for (int i = tid; i < 9 * 1024; i += NTHR) { const int bb = i >> 10, d = i & 1023; const float c = (bb < 8) ? P.in[1][bb * 1024 + d] : P.in[3][d]; sl[i] = silu_(c); }
    __syncthreads();
    if (gw < 192) { const int l = gw / 96, jb = gw % 96, j = jb * 64 + lane; const float* wm = P.in[4] + (size_t)l * 1024 * 6144 + j;
        float acc[9];
#pragma unroll
        for (int b = 0; b < 9; ++b) acc[b] = 0.f;
        for (int d = 0; d < 1024; d += 4) { float w[4];
#pragma unroll
            for (int q = 0; q < 4; ++q) w[q] = wm[(size_t)(d + q) * 6144];
#pragma unroll
            for (int q = 0; q < 4; ++q)
#pragma unroll
                for (int b = 0; b < 9; ++b) acc[b] += sl[b * 1024 + d + q] * w[q]; }
        const float bmv = P.in[5][l * 6144 + j]; float* mo = (float*)(ws + WS_MODS) + (size_t)l * 9 * 6144 + j;
#pragma unroll
        for (int b = 0; b < 9; ++b) mo[b * 6144] = acc[b] + bmv; }
    { f32x2* rope = (f32x2*)(ws + WS_ROPE); for (int i = gt; i < 128 * 16; i += NT) { const int pos = i >> 4, k = i & 15; const float fr = powf(10000.0f, -(float)k / 16.0f); float s, c; sincosf((float)pos * fr, &s, &c); rope[i] = (f32x2){c, s}; }
      f32x2* tw = (f32x2*)(ws + WS_TW); for (int i = gt; i < 8192; i += NT) { float s, c; sincospif((float)i / 4096.0f, &s, &c); tw[i] = (f32x2){c, s}; }
      float* sp = (float*)(ws + WS_SP); for (int i = gt; i < 2 * 2 * 1024; i += NT) { const float lam = P.in[15][i]; sp[i] = log1pf(expf(-lam)); }
      bf16* fc = (bf16*)(ws + WS_FC); for (int i = gt; i < 512 * 256; i += NT) { const int r = i >> 8, c = i & 255, part = r >> 8, m = r & 255; float s, co; sincospif((float)((c * m) & 255) / 128.0f, &s, &co); fc[i] = (bf16)f2bf((part ? s : co) * 0.0625f); }
      bf16* f1 = (bf16*)(ws + WS_F1); for (int i = gt; i < 256 * 256; i += NT) { const int R = i >> 8, kk = i & 255, w = R >> 5, pq = (R >> 4) & 1, k1 = 16 * w + (R & 15), pin = kk >> 7, n1 = kk & 127;
          float s, co; sincospif((float)((n1 * k1) & 127) / 64.0f, &s, &co); const float v = pq == 0 ? (pin == 0 ? co : -s) : (pin == 0 ? s : co); f1[i] = (bf16)f2bf(v * 0.08838834764831845f); }
      bf16* f2 = (bf16*)(ws + WS_F2); for (int i = gt; i < 64 * 128; i += NT) { const int k2 = i >> 7, kk = i & 127, part = kk >> 6, n2 = kk & 63; float s, co; sincospif((float)((n2 * k2) & 63) / 32.0f, &s, &co); f2[i] = (bf16)f2bf((part ? -s : co) * 0.125f); }
      bf16* f3 = (bf16*)(ws + WS_F256); for (int i = gt; i < 256 * 512; i += NT) { const int k = i >> 9, kk = i & 511, part = kk >> 8, t = kk & 255; float s, co; sincospif((float)((k * t) & 255) / 128.0f, &s, &co); f3[i] = (bf16)f2bf((part ? -s : co) * 0.0625f); }
    }
    for (int l = 0; l < DEPTH; ++l) {
        unsigned char* wl = ws + WS_WSM + l * WSM_LAYER;
        const float* win = P.in[6] + (size_t)l * 1024 * IN_COLS;
        bf16* wxf = (bf16*)(wl + WSM_WXF); for (int i = gt; i < 1024 * 1024; i += NT) { const int d = i >> 10, c = i & 1023; wxf[i] = (bf16)f2bf(win[(size_t)d * IN_COLS + 3584 + c]); }
        bf16* wrh = (bf16*)(wl + WSM_WRH); bf16* wrl = (bf16*)(wl + WSM_WRL); const float* wr = P.in[23] + (size_t)l * 1024 * 32;
        for (int i = gt; i < 32 * 1024; i += NT) { const int e = i >> 10, k = i & 1023; const float v = wr[k * 32 + e]; const unsigned h = f2bf(v); wrh[i] = (bf16)h; wrl[i] = (bf16)f2bf(v - bf2f(h)); }
        bf16* wg = (bf16*)(wl + WSM_WG);
        for (int i = gt; i < 4 * 16 * 64 * 64; i += NT) { const int in_ = i & 63, out_ = (i >> 6) & 63, hb = (i >> 12) & 15, gm = i >> 16; const int dir = gm >> 1;
            const float* src = ((gm & 1) ? P.in[13] : P.in[11]) + (size_t)l * 2 * 16 * 4096 + (size_t)dir * 16 * 4096 + hb * 4096; wg[i] = (bf16)f2bf(src[in_ * 64 + out_]); }
    }
    LAS float* scr = (LAS float*)(lds + 40960 + wave * 8448);
    constexpr int I_IN = 16 * 112, I_SQ = 16 * 32, I_MG = 16 * 96, I_L = I_IN + 4 * I_SQ + I_MG;
    for (int it = gw; it < DEPTH * I_L; it += NGW) {
        const int l = it / I_L; int r = it - l * I_L; unsigned char* wl = ws + WS_WSM + l * WSM_LAYER;
        if (r < I_IN) { const int kb = r / 112, nb = r % 112, n0 = nb * 32; const int dr = n0 < 1536 ? n0 : (n0 < 2560 ? n0 + 1024 : n0 - 1024);
            tr_item(P.in[6] + (size_t)l * 1024 * IN_COLS, IN_COLS, kb * 64, n0, (bf16*)(wl + WSM_WIN), 1024, dr, scr, lane); continue; }
        r -= I_IN;
        if (r < 4 * I_SQ) { const int which = r / I_SQ; r -= which * I_SQ; const int kb = r >> 5, nb = r & 31;
            const float* src = (which == 0 ? P.in[8] : which == 1 ? P.in[16] : which == 2 ? P.in[17] : P.in[20]) + (size_t)l * 1024 * 1024;
            const size_t dst = which == 0 ? WSM_WOA : which == 1 ? WSM_WOR : which == 2 ? WSM_WOF : WSM_WOUT;
            tr_item(src, 1024, kb * 64, nb * 32, (bf16*)(wl + dst), 1024, nb * 32, scr, lane); continue; }
        r -= 4 * I_SQ;
        { const int kb = r / 96, nb = r % 96;
          if (F8_MERGE) { if (kb & 1) continue; for (int kh = 0; kh < 2; ++kh) tr_item8(P.in[18] + (size_t)l * 1024 * 3072, 3072, (kb + kh) * 64, nb * 32, (unsigned char*)(wl + WSM_WM8), 1024, nb * 32, (float)(1 << F8_WM_SHIFT), scr, lane); }
          else tr_item(P.in[18] + (size_t)l * 1024 * 3072, 3072, kb * 64, nb * 32, (bf16*)(wl + WSM_WM), 1024, nb * 32, scr, lane); }
    }
    convert_moe(P, 0, lds, gw, NGW, wave, lane);
}

struct FoldStore {
    static constexpr bool PERM = true;
    bf16* O;
    __device__ __forceinline__ void operator()(const f32x4 (&acc)[2][2][4][2], const pg8::Unit& u, int wr, int wc, int fr, int fq) const {
        const int row0 = 3584 + u.pm * 1024 + (u.pn >> 2) * 256 + wr * 64 + fr; const int col0 = (u.pn & 3) * 256 + wc * 32 + 8 * fq;
#pragma unroll
        for (int ai = 0; ai < 2; ++ai)
#pragma unroll
            for (int m = 0; m < 4; ++m) { bf16* rowp = O + (size_t)(row0 + ai * 128 + m * 16) * 1024 + col0;
#pragma unroll
                for (int bj = 0; bj < 2; ++bj) { const f32x4 v0 = acc[ai][bj][m][0], v1 = acc[ai][bj][m][1];
                    u32x4 w; w.x = pg8::cvt_pk_bf16(v0[0], v0[1]); w.y = pg8::cvt_pk_bf16(v0[2], v0[3]); w.z = pg8::cvt_pk_bf16(v1[0], v1[1]); w.w = pg8::cvt_pk_bf16(v1[2], v1[3]);
                    *(u32x4*)(rowp + bj * 128) = w; } }
    }
};
__device__ __forceinline__ void modulate_rows(const float* xlat, const float* xctx, const float* mods  , bf16* U, unsigned char* U8, int nrow, int gw, int NGW, int lane) {
    for (int r0 = gw; r0 < nrow; r0 += 4 * NGW) {
        f32x4 xv[4][4];
#pragma unroll
        for (int h = 0; h < 4; ++h) { const int r = r0 + h * NGW < nrow ? r0 + h * NGW : r0; const float* xr = r < NLAT ? xlat + (size_t)r * D : xctx + (size_t)(r - NLAT) * D;
#pragma unroll
            for (int j = 0; j < 4; ++j) xv[h][j] = *(const f32x4*)(xr + 4 * lane + 256 * j); }
#pragma unroll
        for (int h = 0; h < 4; ++h) { const int r = r0 + h * NGW; if (r >= nrow) break;
            const int bb = r < NLAT ? (r >> 13) : 8; const float* sh = mods + (size_t)(bb * 6 + 0) * D; const float* sc = mods + (size_t)(bb * 6 + 1) * D;
            u32x2* o = (u32x2*)(U + (size_t)r * D);
#pragma unroll
            for (int j = 0; j < 4; ++j) { const int c = 4 * lane + 256 * j; const f32x4 s = *(const f32x4*)(sc + c), hh = *(const f32x4*)(sh + c);
                const f32x4 uu = xv[h][j] * (s + 1.0f) + hh; u32x2 w; w.x = pk2(uu[0], uu[1]); w.y = pk2(uu[2], uu[3]); o[lane + 64 * j] = w;
                if (U8) { unsigned w8 = 0u; w8 = __builtin_amdgcn_cvt_pk_fp8_f32(uu[0], uu[1], w8, false); w8 = __builtin_amdgcn_cvt_pk_fp8_f32(uu[2], uu[3], w8, true); *(unsigned*)(U8 + (size_t)r * D + c) = w8; } } }
    }
}
namespace att {
__device__ __forceinline__ int crow(int r, int hi) { return (r & 3) + 8 * (r >> 2) + 4 * hi; }
__device__ __forceinline__ void qk_tile(f32x16& p0, f32x16& p1, ldsp kb, const bf16x8 (&qr)[4], const f32x16& negm) {
    p0 = negm; p1 = negm;
#pragma unroll
    for (int d0 = 0; d0 < 4; ++d0) { const bf16x8 b0 = *(const LAS bf16x8*)(kb + d0 * 2048), b1 = *(const LAS bf16x8*)(kb + d0 * 2048 + 512);
        p0 = __builtin_amdgcn_mfma_f32_32x32x16_bf16(b0, qr[d0], p0, 0, 0, 0); p1 = __builtin_amdgcn_mfma_f32_32x32x16_bf16(b1, qr[d0], p1, 0, 0, 0); }
}
__device__ __forceinline__ void band_mask(f32x16& p0, f32x16& p1, int j, int qi, int hi) {
    if (j == 0) {
#pragma unroll
        for (int r = 0; r < 16; ++r) { const int kk = crow(r, hi); if (kk < qi) p0[r] = -INFINITY; if (kk + 32 < qi) p1[r] = -INFINITY; } }
    if (j == 4) {
#pragma unroll
        for (int r = 0; r < 16; ++r) { const int kk = crow(r, hi); if (kk > qi) p0[r] = -INFINITY; if (kk + 32 > qi) p1[r] = -INFINITY; } }
}
__device__ __forceinline__ float max32(const f32x16& p0, const f32x16& p1) {
    float rm = __builtin_fmaxf(p0[0], p1[0]);
#pragma unroll
    for (int r = 1; r < 16; ++r) rm = __builtin_fmaxf(__builtin_fmaxf(rm, p0[r]), p1[r]);
    return rm;
}
__device__ __forceinline__ float exp32(f32x16& p0, f32x16& p1) { float s = 0.f;
#pragma unroll
    for (int r = 0; r < 16; ++r) { p0[r] = __builtin_amdgcn_exp2f(p0[r]); p1[r] = __builtin_amdgcn_exp2f(p1[r]); s += p0[r] + p1[r]; }
    return s; }
__device__ __forceinline__ void pv_tile(f32x16 (&o)[2], const f32x16& p0, const f32x16& p1, const LAS unsigned char* vp) {
    u32x4 pw[4];
    pw[0] = (u32x4){pk2(p0[0], p0[1]), pk2(p0[2], p0[3]), pk2(p0[4], p0[5]), pk2(p0[6], p0[7])};
    pw[1] = (u32x4){pk2(p0[8], p0[9]), pk2(p0[10], p0[11]), pk2(p0[12], p0[13]), pk2(p0[14], p0[15])};
    pw[2] = (u32x4){pk2(p1[0], p1[1]), pk2(p1[2], p1[3]), pk2(p1[4], p1[5]), pk2(p1[6], p1[7])};
    pw[3] = (u32x4){pk2(p1[8], p1[9]), pk2(p1[10], p1[11]), pk2(p1[12], p1[13]), pk2(p1[14], p1[15])};
#pragma unroll
    for (int d0 = 0; d0 < 2; ++d0)
#pragma unroll
        for (int ks = 0; ks < 4; ++ks) {
            const s16x4 lo = __builtin_bit_cast(s16x4, __builtin_amdgcn_ds_read_tr16_b64_v4i16((LAS s16x4*)(vp + d0 * 4096 + ks * 1024)));
            const s16x4 hh_ = __builtin_bit_cast(s16x4, __builtin_amdgcn_ds_read_tr16_b64_v4i16((LAS s16x4*)(vp + d0 * 4096 + ks * 1024 + 512)));
            const bf16x8 vf = (bf16x8){lo[0], lo[1], lo[2], lo[3], hh_[0], hh_[1], hh_[2], hh_[3]};
            o[d0] = __builtin_amdgcn_mfma_f32_32x32x16_bf16(__builtin_bit_cast(bf16x8, pw[ks]), vf, o[d0], 0, 0, 0); }
}
__device__ __forceinline__ void attn_unit(ldsp lds, bf16* Z, const float* sink  , int qrow0, int g, int nloc, int krow_loc0, int jlo, int krow_ctx0, int tid, bf16* Ob, int opitch) {
    const int lane = tid & 63, r32 = lane & 31, hi = lane >> 5; const int wid = __builtin_amdgcn_readfirstlane(tid >> 6);
    const int hh = wid >> 1, ts = wid & 1, head = 4 * g + hh;
    const int nt = nloc + 4, nsteps = (nt + 1) >> 1;
    LAS float* wsf = (LAS float*)(lds + 65536) + wid * 64;
    const int krow_l = lane, kch = wid;
    const int vrow_l = 16 * (wid & 3) + (lane >> 2), vdh = wid >> 2, vch = lane & 3;
#define TILE_ROW(t) ((t) < nloc ? krow_loc0 + 64 * (t) : krow_ctx0 + 64 * ((t) - nloc))
#define DMA_SUB(t, bo, i) do { const int tr_ = TILE_ROW(t); \
        __builtin_amdgcn_global_load_lds((const unsigned*)(Z + (size_t)(tr_ + krow_l) * ZC + ZK + g * 64 + kch * 8), (LAS unsigned*)(lds + (bo) + (i) * 8192 + kch * 1024), 16, 0, 0); \
        __builtin_amdgcn_global_load_lds((const unsigned*)(Z + (size_t)(tr_ + vrow_l) * ZC + ZV + g * 64 + vdh * 32 + vch * 8), (LAS unsigned*)(lds + 32768 + (bo) + (i) * 8192 + vdh * 4096 + (wid & 3) * 1024), 16, 0, 0); } while (0)
    bf16x8 qr[4];
    { const bf16* Qw = Z + (size_t)(qrow0 + 32 * ts + r32) * ZC + ZQ + head * 64;
#pragma unroll
      for (int d0 = 0; d0 < 4; ++d0) qr[d0] = *(const bf16x8*)(Qw + d0 * 16 + hi * 8); }
    DMA_SUB(0, 0u, 0); DMA_SUB(1, 0u, 1);
    float m_run = sink[head] * 1.4426950408889634f, l_run = 1.0f;
    f32x16 o[2]; o[0] = f32x16{}; o[1] = f32x16{};
    f32x16 negm;
#pragma unroll
    for (int r = 0; r < 16; ++r) negm[r] = -m_run;
    const int qi = 32 * ts + r32;
    __syncthreads();
    for (int s = 0; s < nsteps; ++s) {
        const unsigned boff = (unsigned)(s & 1) * 16384u; const int ta = 2 * s, tb = 2 * s + 1; const bool hasb = tb < nt;
        const bool more = s + 1 < nsteps, moreb = 2 * s + 3 < nt;
        if (more) { DMA_SUB(ta + 2, boff ^ 16384u, 0); if (moreb) DMA_SUB(tb + 2, boff ^ 16384u, 1); }
        const LAS unsigned char* vp = lds + 32768 + boff + ((lane >> 4) & 1) * 32 + (lane & 3) * 8 + (4 * hi + ((lane & 15) >> 2)) * 64;
        float sm = 0.f;
#pragma unroll
        for (int sub = 0; sub < 2; ++sub) { const int tt = 2 * s + sub;
            if (sub == 0 || hasb) {
                f32x16 a0, a1;
                qk_tile(a0, a1, lds + boff + sub * 8192 + hi * 1024 + r32 * 16, qr, negm);
                if (tt < nloc) band_mask(a0, a1, jlo + tt, qi, hi);
                float rm = max32(a0, a1);
                { const auto rr = __builtin_amdgcn_permlane32_swap(__float_as_uint(rm), __float_as_uint(rm), false, false); rm = fmaxf(__uint_as_float(rr[0]), __uint_as_float(rr[1])); }
                if (__builtin_expect(__any(rm > 8.0f), 0)) {
                    const float dl = __builtin_fmaxf(rm, 0.f), f = __builtin_amdgcn_exp2f(-dl); m_run += dl; l_run *= f; sm *= f;
#pragma unroll
                    for (int r = 0; r < 16; ++r) { a0[r] -= dl; a1[r] -= dl; negm[r] = -m_run; }
                    if (hi == 0) wsf[r32] = f;
                    LDS_WAIT();
#pragma unroll
                    for (int r = 0; r < 16; ++r) { const float fr_ = wsf[crow(r, hi)]; o[0][r] *= fr_; o[1][r] *= fr_; }
                }
                sm += exp32(a0, a1);
                pv_tile(o, a0, a1, vp + sub * 8192);
                __builtin_amdgcn_sched_barrier(0);
            } }
        { const auto rr = __builtin_amdgcn_permlane32_swap(__float_as_uint(sm), __float_as_uint(sm), false, false); sm = __uint_as_float(rr[0]) + __uint_as_float(rr[1]); }
        l_run += sm;
        __syncthreads();
    }
#undef TILE_ROW
#undef DMA_SUB
    if (hi == 0) wsf[32 + r32] = l_run;
    LDS_WAIT();
    bf16* Ow = Ob + (size_t)(qrow0 + 32 * ts) * opitch + head * 64;
    { ldsp stg = lds + 67584 + wid * 4608;
#pragma unroll
      for (int r = 0; r < 16; ++r) { const int q = crow(r, hi); const float rl = __builtin_amdgcn_rcpf(wsf[32 + q]);
#pragma unroll
          for (int d0 = 0; d0 < 2; ++d0) *(LAS unsigned short*)(stg + q * 144 + (d0 * 32 + r32) * 2) = (unsigned short)f2bf(o[d0][r] * rl); }
      LDS_WAIT();
#pragma unroll
      for (int i = 0; i < 4; ++i) { const int row = i * 8 + (lane >> 3), ch = lane & 7; *(u32x4*)(Ow + (size_t)row * opitch + ch * 8) = *(const LAS u32x4*)(stg + row * 144 + ch * 16); } }
    LDS_WAIT();
}
__device__ __forceinline__ void attn_phase(ldsp lds, bf16* Z, const float* sink, bool with_ctx, int wg, int G, int g_wave, bf16* Ob, int opitch) {
    const int tid = fresh_tid();
    const int nlat = NB * 4 * (SEQ / 64), nctx = with_ctx ? NB * 4 * (CTXL / 64) : 0;
    for (int u = wg; u < nlat + nctx; u += G) {
        if (u < nlat) { const int qb = u & 127, g = (u >> 7) & 3, b = u >> 9; const int qpos0 = qb * 64;
            const int jlo = qpos0 == 0 ? 2 : (qpos0 == 64 ? 1 : 0); const int jhi = qpos0 == SEQ - 64 ? 2 : (qpos0 == SEQ - 128 ? 3 : 4);
            attn_unit(lds, Z, sink, b * SEQ + qpos0, g, jhi - jlo + 1, b * SEQ + qpos0 - 128 + 64 * jlo, jlo, NLAT + b * CTXL, tid, Ob, opitch);
        } else { const int v = u - nlat; const int qb = v & 3, g = (v >> 2) & 3, b = v >> 4;
            attn_unit(lds, Z, sink, NLAT + b * CTXL + qb * 64, g, 0, 0, 0, NLAT + b * CTXL, tid, Ob, opitch); }
    }
}
}
namespace fft {
constexpr int RS = 144;
constexpr int OUT_OFF = 73728;
template <int K> struct Tile { u32x4 v[K / 64]; };
template <int K> __device__ __forceinline__ void tile_load(Tile<K>& t, const bf16* base, size_t rstride, size_t pstride, int tid) {
    constexpr int KH = K / 2;
#pragma unroll
    for (int i = 0; i < K / 64; ++i) { const int c = tid + NTHR * i, kk = c >> 3, ch = c & 7; const int part = kk / KH, n = kk % KH;
        t.v[i] = *(const u32x4*)(base + (size_t)n * rstride + (size_t)part * pstride + ch * 8); }
}
template <int K> __device__ __forceinline__ void tile_put(const Tile<K>& t, ldsp lds, int tid) {
#pragma unroll
    for (int i = 0; i < K / 64; ++i) { const int c = tid + NTHR * i, kk = c >> 3, ch = c & 7; *(LAS u32x4*)(lds + kk * RS + ch * 16) = t.v[i]; }
}
__device__ __forceinline__ bf16x8 tile_frag(const LAS unsigned char* bp, int ks, int nt) {
    const s16x4 lo = __builtin_bit_cast(s16x4, __builtin_amdgcn_ds_read_tr16_b64_v4i16((LAS s16x4*)(bp + (32 * ks) * RS + nt * 32)));
    const s16x4 hi = __builtin_bit_cast(s16x4, __builtin_amdgcn_ds_read_tr16_b64_v4i16((LAS s16x4*)(bp + (32 * ks + 4) * RS + nt * 32)));
    return (bf16x8){lo[0], lo[1], lo[2], lo[3], hi[0], hi[1], hi[2], hi[3]};
}
template <int KS, int MTW, int NTW>
__device__ __forceinline__ void mma_reg(ldsp lds, const bf16x8 (&af)[MTW][KS], int nt0, f32x4 (&acc)[MTW][NTW], int tid) {
    const int lane = tid & 63, fr = lane & 15, kq = lane >> 4;
#pragma unroll
    for (int i = 0; i < MTW; ++i)
#pragma unroll
        for (int j = 0; j < NTW; ++j) acc[i][j] = (f32x4){0.f, 0.f, 0.f, 0.f};
    const LAS unsigned char* bp = lds + (8 * kq + (fr >> 2)) * RS + (4 * (fr & 3)) * 2;
#pragma unroll
    for (int ks = 0; ks < KS; ++ks)
#pragma unroll
        for (int j = 0; j < NTW; ++j) { const bf16x8 bfrag = tile_frag(bp, ks, nt0 + j);
#pragma unroll
            for (int i = 0; i < MTW; ++i) acc[i][j] = __builtin_amdgcn_mfma_f32_16x16x32_bf16(bfrag, af[i][ks], acc[i][j], 0, 0, 0); }
}
__device__ __forceinline__ void put4(ldsp p, float a, float b, float c, float d) { *(LAS u32x2*)p = (u32x2){pg8::cvt_pk_bf16(a, b), pg8::cvt_pk_bf16(c, d)}; }

__device__ __forceinline__ void pass1_phase(ldsp lds, bf16* Z, bf16* T, const unsigned char* ws, bool with_ctx, int wg, int G, int g_wave) {
    const bf16* F1 = (const bf16*)(ws + WS_F1); const bf16* F3 = (const bf16*)(ws + WS_F256); const f32x2* TW = (const f32x2*)(ws + WS_TW);
    const int tid = fresh_tid(); const int lane = tid & 63, fr = lane & 15, kq = lane >> 4; const int w = __builtin_amdgcn_readfirstlane(tid >> 6);
    bf16x8 af[2][8];
#pragma unroll
    for (int i = 0; i < 2; ++i)
#pragma unroll
        for (int ks = 0; ks < 8; ++ks) af[i][ks] = *(const bf16x8*)(F1 + (size_t)(16 * (2 * w + i) + fr) * 256 + 32 * ks + 8 * kq);
    const int NU = NB * 64 * 16;
    Tile<256> tl;
    if (wg < NU) { const int ct = wg & 15, n2 = (wg >> 4) & 63, b = wg >> 10; tile_load<256>(tl, Z + (size_t)(b * SEQ + n2) * ZC + ZXC + ct * 64, (size_t)64 * ZC, 1024, tid); }
    for (int u = wg; u < NU; u += G) { const int ct = u & 15, n2 = (u >> 4) & 63, b = u >> 10;
        tile_put<256>(tl, lds, tid);
        __syncthreads();
        { const int un = u + G; if (un < NU) { const int ct2 = un & 15, n22 = (un >> 4) & 63, b2 = un >> 10; tile_load<256>(tl, Z + (size_t)(b2 * SEQ + n22) * ZC + ZXC + ct2 * 64, (size_t)64 * ZC, 1024, tid); } }
        f32x4 acc[2][4];
        mma_reg<8, 2, 4>(lds, af, 0, acc, tid);
        { const int k1 = 16 * w + fr; const f32x2 cs = TW[(n2 * k1) & 8191]; ldsp o = lds + OUT_OFF + (k1 * 2) * RS + (4 * kq) * 2;
#pragma unroll
          for (int j = 0; j < 4; ++j) { const f32x4 p = acc[0][j], q = acc[1][j];
              put4(o + j * 32, p[0] * cs.x - q[0] * cs.y, p[1] * cs.x - q[1] * cs.y, p[2] * cs.x - q[2] * cs.y, p[3] * cs.x - q[3] * cs.y);
              put4(o + RS + j * 32, q[0] * cs.x + p[0] * cs.y, q[1] * cs.x + p[1] * cs.y, q[2] * cs.x + p[2] * cs.y, q[3] * cs.x + p[3] * cs.y); } }
        __syncthreads();
#pragma unroll
        for (int i = 0; i < 4; ++i) { const int c = tid + NTHR * i, row = c >> 3, ch = c & 7, k1 = row >> 1, part = row & 1;
            *(u32x4*)(T + (size_t)(b * SEQ + k1 * 64 + n2) * 2048 + part * 1024 + ct * 64 + ch * 8) = *(const LAS u32x4*)(lds + OUT_OFF + row * RS + ch * 16); }
    }
    __syncthreads();
    if (with_ctx) for (int u = wg; u < NB * 16; u += G) { const int b = u >> 4, ct = u & 15;
        Tile<512> tc; tile_load<512>(tc, Z + (size_t)(NLAT + b * CTXL) * ZC + ZXC + ct * 64, ZC, 1024, tid); tile_put<512>(tc, lds, tid);
        __syncthreads();
        f32x4 acc[2][4];
#pragma unroll
        for (int i = 0; i < 2; ++i)
#pragma unroll
            for (int j = 0; j < 4; ++j) acc[i][j] = (f32x4){0.f, 0.f, 0.f, 0.f};
        const LAS unsigned char* bp = lds + (8 * kq + (fr >> 2)) * RS + (4 * (fr & 3)) * 2;
#pragma unroll 2
        for (int ks = 0; ks < 16; ++ks) { bf16x8 a2[2];
#pragma unroll
            for (int i = 0; i < 2; ++i) a2[i] = *(const bf16x8*)(F3 + (size_t)(16 * (2 * w + i) + fr) * 512 + 32 * ks + 8 * kq);
#pragma unroll
            for (int j = 0; j < 4; ++j) { const bf16x8 bfrag = tile_frag(bp, ks, j);
#pragma unroll
                for (int i = 0; i < 2; ++i) acc[i][j] = __builtin_amdgcn_mfma_f32_16x16x32_bf16(bfrag, a2[i], acc[i][j], 0, 0, 0); } }
        __syncthreads();
#pragma unroll
        for (int i = 0; i < 2; ++i) { const int k = 16 * (2 * w + i) + fr; bf16* o = Z + (size_t)(NLAT + b * CTXL + k) * ZC + ZXC + ct * 64 + 4 * kq;
#pragma unroll
            for (int j = 0; j < 4; ++j) *(u32x2*)(o + 16 * j) = (u32x2){pg8::cvt_pk_bf16(acc[i][j][0], acc[i][j][1]), pg8::cvt_pk_bf16(acc[i][j][2], acc[i][j][3])}; }
    }
}
__device__ __forceinline__ void pass2_phase(ldsp lds, bf16* Z, const bf16* T, const unsigned char* ws, int wg, int G, int g_wave) {
    const bf16* F2 = (const bf16*)(ws + WS_F2);
    const int tid = fresh_tid(); const int lane = tid & 63, fr = lane & 15, kq = lane >> 4; const int w = __builtin_amdgcn_readfirstlane(tid >> 6);
    bf16x8 af[1][4];
#pragma unroll
    for (int ks = 0; ks < 4; ++ks) af[0][ks] = *(const bf16x8*)(F2 + (size_t)(16 * (w >> 1) + fr) * 128 + 32 * ks + 8 * kq);
    const int NU = NB * 128 * 16;
    Tile<128> tl;
    if (wg < NU) { const int ct = wg & 15, k1 = (wg >> 4) & 127, b = wg >> 11; tile_load<128>(tl, T + (size_t)(b * SEQ + k1 * 64) * 2048 + ct * 64, 2048, 1024, tid); }
    for (int u = wg; u < NU; u += G) { const int ct = u & 15, k1 = (u >> 4) & 127, b = u >> 11;
        tile_put<128>(tl, lds, tid);
        __syncthreads();
        { const int un = u + G; if (un < NU) { const int ct2 = un & 15, k12 = (un >> 4) & 127, b2 = un >> 11; tile_load<128>(tl, T + (size_t)(b2 * SEQ + k12 * 64) * 2048 + ct2 * 64, 2048, 1024, tid); } }
        f32x4 acc[1][2];
        mma_reg<4, 1, 2>(lds, af, 2 * (w & 1), acc, tid);
        { const int k2 = 16 * (w >> 1) + fr; ldsp o = lds + OUT_OFF + k2 * RS + (32 * (w & 1) + 4 * kq) * 2;
#pragma unroll
          for (int j = 0; j < 2; ++j) put4(o + j * 32, acc[0][j][0], acc[0][j][1], acc[0][j][2], acc[0][j][3]); }
        __syncthreads();
        { const int row = tid >> 3, ch = tid & 7;
          *(u32x4*)(Z + (size_t)(b * SEQ + k1 + 128 * row) * ZC + ZXC + ct * 64 + ch * 8) = *(const LAS u32x4*)(lds + OUT_OFF + row * RS + ch * 16); }
    }
    __syncthreads();
}
}
namespace rg {
constexpr int XRS = 144;
constexpr int WAVE_LDS = 68 * XRS;
struct Args {
    bf16* Z; const float* conv_w; const float* conv_b;
    const bf16* Wg;
    const float* b_a; const float* b_i; const float* sp;
    f32x2* SUM;
    const float* CARRY;
    bf16* Gout; int gpitch;
};
template <bool FINAL>
__device__ __forceinline__ void wave_unit(LAS unsigned char* xt, const LAS unsigned char* wgl, const LAS float* cst, const Args& A, int bb, int cid, int hb, int tid) {
    const int lane = tid & 63, fr = lane & 15, kq = lane >> 4;
    const bool isctx = cid < 4; const int rowbase = isctx ? NLAT + bb * CTXL : bb * SEQ, len = isctx ? CTXL : SEQ, t0 = isctx ? cid * 64 : (cid - 4) * 64;
#pragma unroll
    for (int i = 0; i < 9; ++i) { const int rr = i * 8 + (lane >> 3), ch = lane & 7, t = t0 - 2 + rr;
        u32x4 v = {0u, 0u, 0u, 0u};
        if (rr < 68 && t >= 0 && t < len) v = *(const u32x4*)(A.Z + (size_t)(rowbase + t) * ZC + ZXR + hb * 64 + ch * 8);
        if (rr < 68) *(LAS u32x4*)(xt + rr * XRS + ch * 16) = v; }
    LDS_WAIT();
    bf16x8 af[4][2];
#pragma unroll
    for (int ks = 0; ks < 2; ++ks) { const int c0 = 32 * ks + 8 * kq;
        float cw[4][8], cb[8];
#pragma unroll
        for (int tap = 0; tap < 4; ++tap) { const f32x4 a = *(const LAS f32x4*)(cst + tap * 64 + c0), b = *(const LAS f32x4*)(cst + tap * 64 + c0 + 4);
#pragma unroll
            for (int j = 0; j < 4; ++j) { cw[tap][j] = a[j]; cw[tap][4 + j] = b[j]; } }
        { const f32x4 a = *(const LAS f32x4*)(cst + 256 + c0), b = *(const LAS f32x4*)(cst + 256 + c0 + 4);
#pragma unroll
          for (int j = 0; j < 4; ++j) { cb[j] = a[j]; cb[4 + j] = b[j]; } }
#pragma unroll
        for (int mt = 0; mt < 4; ++mt) { float xc[8];
#pragma unroll
            for (int j = 0; j < 8; ++j) xc[j] = cb[j];
#pragma unroll
            for (int tap = 0; tap < 4; ++tap) { const u32x4 xv = *(const LAS u32x4*)(xt + (16 * mt + fr + tap) * XRS + (32 * ks + 8 * kq) * 2);
#pragma unroll
                for (int j = 0; j < 8; ++j) { const unsigned w = xv[j >> 1]; const float x = (j & 1) ? bf2f(w >> 16) : bf2f(w & 0xffffu); xc[j] += cw[tap][j] * x; } }
            u32x4 p; p.x = pg8::cvt_pk_bf16(xc[0], xc[1]); p.y = pg8::cvt_pk_bf16(xc[2], xc[3]); p.z = pg8::cvt_pk_bf16(xc[4], xc[5]); p.w = pg8::cvt_pk_bf16(xc[6], xc[7]);
            af[mt][ks] = __builtin_bit_cast(bf16x8, p); } }
    const int bsum = bb * NCHUNK + cid;
#pragma unroll 1
    for (int nt = 0; nt < 4; ++nt) {
        const int cch = hb * 64 + 16 * nt + fr;
        float xd[4][4];
        { float cwd[4];
#pragma unroll
          for (int tap = 0; tap < 4; ++tap) cwd[tap] = cst[tap * 64 + 16 * nt + fr];
          const float cbd = cst[256 + 16 * nt + fr];
#pragma unroll
          for (int mt = 0; mt < 4; ++mt) { float xs[7];
#pragma unroll
              for (int q = 0; q < 7; ++q) xs[q] = bf2f(*(const LAS unsigned short*)(xt + (16 * mt + 4 * kq + q) * XRS + (16 * nt + fr) * 2));
#pragma unroll
              for (int r = 0; r < 4; ++r) xd[mt][r] = cbd + cwd[0] * xs[r] + cwd[1] * xs[r + 1] + cwd[2] * xs[r + 2] + cwd[3] * xs[r + 3]; } }
        float hsum[4][4];
#pragma unroll
        for (int dir = 0; dir < 2; ++dir) {
            f32x4 g[2][4];
#pragma unroll
            for (int gi = 0; gi < 2; ++gi) { const int gm = 2 * dir + gi; bf16x8 bw[2];
#pragma unroll
                for (int ks = 0; ks < 2; ++ks) bw[ks] = *(const LAS bf16x8*)(wgl + (gm * 64 + 16 * nt + fr) * 144 + (32 * ks + 8 * kq) * 2);
#pragma unroll
                for (int mt = 0; mt < 4; ++mt) { f32x4 c = {0.f, 0.f, 0.f, 0.f};
                    c = __builtin_amdgcn_mfma_f32_16x16x32_bf16(af[mt][0], bw[0], c, 0, 0, 0); c = __builtin_amdgcn_mfma_f32_16x16x32_bf16(af[mt][1], bw[1], c, 0, 0, 0); g[gi][mt] = c; } }
            const float ba = cst[(5 + dir) * 64 + 16 * nt + fr], bi = cst[(7 + dir) * 64 + 16 * nt + fr], spv = cst[(9 + dir) * 64 + 16 * nt + fr];
            float carry = 0.f;
            if (FINAL) carry = A.CARRY[(((size_t)dir * NB + bb) * NCHUNK + cid) * 1024 + cch];
            float ptot = 1.f;
#pragma unroll
            for (int mi = 0; mi < 4; ++mi) { const int mt = dir == 0 ? mi : 3 - mi;
                float a[4], bv[4];
#pragma unroll
                for (int r = 0; r < 4; ++r) {
                    const float rr = __builtin_amdgcn_rcpf(1.0f + __builtin_amdgcn_exp2f(__builtin_fmaf(g[0][mt][r], -1.4426950408889634f, ba)));
                    const float ii = __builtin_amdgcn_rcpf(1.0f + __builtin_amdgcn_exp2f(__builtin_fmaf(g[1][mt][r], -1.4426950408889634f, bi)));
                    a[r] = __builtin_amdgcn_exp2f(-rr * spv);
                    const float om = __builtin_fmaf(-a[r], a[r], 1.0f);
                    bv[r] = __builtin_amdgcn_sqrtf(om) * ii * xd[mt][r]; }
                float s[4], p[4];
                if (dir == 0) { s[0] = bv[0]; p[0] = a[0];
#pragma unroll
                    for (int r = 1; r < 4; ++r) { s[r] = a[r] * s[r - 1] + bv[r]; p[r] = a[r] * p[r - 1]; } }
                else { s[3] = bv[3]; p[3] = a[3];
#pragma unroll
                    for (int r = 2; r >= 0; --r) { s[r] = a[r] * s[r + 1] + bv[r]; p[r] = a[r] * p[r + 1]; } }
                const float pe = dir == 0 ? p[3] : p[0], se = dir == 0 ? s[3] : s[0];
                float pa[4], sa[4];
#pragma unroll
                for (int q = 0; q < 4; ++q) { pa[q] = __shfl(pe, fr + 16 * q); sa[q] = __shfl(se, fr + 16 * q); }
                float cin = carry, mine = carry;
#pragma unroll
                for (int qi = 0; qi < 4; ++qi) { const int q = dir == 0 ? qi : 3 - qi; if (q == kq) mine = cin; cin = pa[q] * cin + sa[q]; ptot *= pa[q]; }
                carry = cin;
                if (FINAL) {
#pragma unroll
                    for (int r = 0; r < 4; ++r) { const float h = s[r] + p[r] * mine; hsum[mt][r] = dir == 0 ? h : hsum[mt][r] + h; } }
                __builtin_amdgcn_sched_barrier(0);
            }
            if (!FINAL) { if (kq == 0) A.SUM[(((size_t)dir * NB + bb) * NCHUNK + cid) * 1024 + cch] = (f32x2){ptot, carry}; }
        }
        if (FINAL) {
#pragma unroll
            for (int mt = 0; mt < 4; ++mt)
#pragma unroll
                for (int r = 0; r < 4; ++r) *(LAS unsigned short*)(xt + (16 * mt + 4 * kq + r + 2) * XRS + (16 * nt + fr) * 2) = (unsigned short)f2bf(hsum[mt][r]);
        }
    }
    if (FINAL) {
        LDS_WAIT();
#pragma unroll
        for (int i = 0; i < 8; ++i) { const int row = i * 8 + (lane >> 3), ch = lane & 7; const size_t grow = (size_t)(rowbase + t0 + row);
            const u32x4 hv = *(const LAS u32x4*)(xt + (row + 2) * XRS + ch * 16); const u32x4 gv = *(const u32x4*)(A.Z + grow * ZC + ZGR + hb * 64 + ch * 8);
            u32x4 ov;
#pragma unroll
            for (int q = 0; q < 4; ++q) { const float h0 = bf2f(hv[q] & 0xffffu), h1 = bf2f(hv[q] >> 16), g0 = bf2f(gv[q] & 0xffffu), g1 = bf2f(gv[q] >> 16);
                ov[q] = pg8::cvt_pk_bf16(gelu_tanh(g0) * h0, gelu_tanh(g1) * h1); }
            *(u32x4*)(A.Gout + grow * A.gpitch + hb * 64 + ch * 8) = ov; }
    }
    (void)bsum;
    LDS_WAIT();
}
template <bool FINAL>
__device__ __forceinline__ void phase(ldsp lds, const Args& A, bool ctx_too, int wg, int G, int g_wave) {
    const int tid = fresh_tid(); const int wave = __builtin_amdgcn_readfirstlane(tid >> 6); LAS unsigned char* xt = lds + wave * WAVE_LDS;
    LAS unsigned char* wgl = lds + NWAVES * WAVE_LDS; LAS float* cst = (LAS float*)(lds + NWAVES * WAVE_LDS + 4 * 64 * 144);
    const int hb = wg & 15;
    for (int c = tid; c < 4 * 64 * 8; c += NTHR) { const int row = c >> 3, ch = c & 7, gm = row >> 6, o = row & 63;
        *(LAS u32x4*)(wgl + row * 144 + ch * 16) = *(const u32x4*)(A.Wg + ((size_t)((gm * 16 + hb) * 64 + o)) * 64 + ch * 8); }
    for (int c = tid; c < 11 * 64; c += NTHR) { const int k = c >> 6, ch = hb * 64 + (c & 63);
        cst[c] = k < 4 ? A.conv_w[k * 1024 + ch] : k == 4 ? A.conv_b[ch] : k < 7 ? -1.4426950408889634f * A.b_a[(k - 5) * 1024 + ch] : k < 9 ? -1.4426950408889634f * A.b_i[(k - 7) * 1024 + ch] : 8.0f * 1.4426950408889634f * A.sp[(k - 9) * 1024 + ch]; }
    __syncthreads();
    const int c_lo = ctx_too ? 0 : 4, nch = NCHUNK - c_lo, total = NB * nch;
    const int per = G >> 4;
    for (int u = (wg >> 4) * NWAVES + wave; u < total; u += per * NWAVES) { const int cid = c_lo + u % nch, bb = u / nch; wave_unit<FINAL>(xt, wgl, cst, A, bb, cid, hb, tid); }
    __syncthreads();
}
__device__ __forceinline__ void carry_phase(const f32x2* SUM, float* CARRY, int wg, int G, int g_wave) {
    const int tid = fresh_tid(); const int lane = tid & 63, wave = __builtin_amdgcn_readfirstlane(tid >> 6);
    for (int u = wg + G * wave; u < 2 * NB * 16; u += G * NWAVES) { const int cb = u & 15, bb = (u >> 4) & 7, dir = u >> 7;
        const f32x2* S = SUM + ((size_t)dir * NB + bb) * NCHUNK * 1024 + cb * 64 + lane; float* C = CARRY + ((size_t)dir * NB + bb) * NCHUNK * 1024 + cb * 64 + lane;
        float state = 0.f;
        for (int i0 = 0; i0 < NCHUNK; i0 += 12) { f32x2 v[12]; int id[12];
#pragma unroll
            for (int j = 0; j < 12; ++j) { const int i = i0 + j; id[j] = dir == 0 ? i : (i < 4 ? 3 - i : NCHUNK + 3 - i); v[j] = S[(size_t)id[j] * 1024]; }
#pragma unroll
            for (int j = 0; j < 12; ++j) { C[(size_t)id[j] * 1024] = state; state = v[j].x * state + v[j].y; } }
    }
}
}
namespace rowp {
struct LnArgs { bool dry; bool f8; float* X1; bf16* U2; const float* lng; const float* lnb; const float* mods; const bf16* wrh; const bf16* wrl; const float* brt; int* asg_e; int* asg_p; float* asg_g; int* wgc; };
__device__ __forceinline__ void ln_router_phase(ldsp lds, const LnArgs& A, int nrow, int wg, int G, int g_wave) {
    const int tid = fresh_tid(), lane = tid & 63, fr = lane & 15, kq = lane >> 4; const int wave = __builtin_amdgcn_readfirstlane(tid >> 6);
    LAS int* cnt = (LAS int*)(lds + LM_CNT);
    if (tid < 32 && !A.dry) cnt[tid] = 0;
    __syncthreads();
    constexpr int ARS = 2064;
    LAS float* part = (LAS float*)(lds + 66048); LAS float* lg = (LAS float*)(lds + 82432);
    const int ngrp = nrow / 16;
    for (int grp = wg; grp < ngrp; grp += G) {
        f32x4 vin[2][4];
#pragma unroll
        for (int rr = 0; rr < 2; ++rr)
#pragma unroll
            for (int j = 0; j < 4; ++j) vin[rr][j] = *(const f32x4*)(A.X1 + (size_t)(grp * 16 + 2 * wave + rr) * D + 4 * lane + 256 * j);
#pragma unroll
        for (int rr = 0; rr < 2; ++rr) { const int lr = 2 * wave + rr, row = grp * 16 + lr; const int bb = row < NLAT ? (row >> 13) : 8;
            f32x4 v[4]; float s = 0.f;
#pragma unroll
            for (int j = 0; j < 4; ++j) { v[j] = vin[rr][j]; s += (v[j][0] + v[j][1]) + (v[j][2] + v[j][3]); }
            const float mean = wave_sum(s) * (1.0f / D); float s2 = 0.f;
#pragma unroll
            for (int j = 0; j < 4; ++j) { v[j] = v[j] - mean; s2 += (v[j][0] * v[j][0] + v[j][1] * v[j][1]) + (v[j][2] * v[j][2] + v[j][3] * v[j][3]); }
            const float rstd = 1.0f / sqrtf(wave_sum(s2) * (1.0f / D) + LN_EPS);
            const float* sh = A.mods + (size_t)(bb * 6 + 3) * D; const float* sc = A.mods + (size_t)(bb * 6 + 4) * D;
#pragma unroll
            for (int j = 0; j < 4; ++j) { const int c = 4 * lane + 256 * j; const f32x4 gg = *(const f32x4*)(A.lng + c), bbv = *(const f32x4*)(A.lnb + c);
                const f32x4 x1 = v[j] * rstd * gg + bbv;
                const f32x4 u = x1 * (*(const f32x4*)(sc + c) + 1.0f) + *(const f32x4*)(sh + c);
                unsigned h[4], lo[4];
#pragma unroll
                for (int e = 0; e < 4; ++e) { h[e] = f2bf(u[e]); lo[e] = f2bf(u[e] - bf2f(h[e])); }
                const u32x2 hw = {h[0] | (h[1] << 16), h[2] | (h[3] << 16)}, lw = {lo[0] | (lo[1] << 16), lo[2] | (lo[3] << 16)};
                if (A.dry) {} else if (A.f8) { unsigned w8 = 0u; w8 = __builtin_amdgcn_cvt_pk_fp8_f32(u[0], u[1], w8, false); w8 = __builtin_amdgcn_cvt_pk_fp8_f32(u[2], u[3], w8, true); *(unsigned*)((unsigned char*)A.U2 + (size_t)row * D + c) = w8; }
                else *(u32x2*)(A.U2 + (size_t)row * D + c) = hw;
                *(LAS u32x2*)(lds + lr * ARS + c * 2) = hw; *(LAS u32x2*)(lds + 33024 + lr * ARS + c * 2) = lw; } }
        __syncthreads();
        { f32x4 acc[2] = {{0.f, 0.f, 0.f, 0.f}, {0.f, 0.f, 0.f, 0.f}};
#pragma unroll
          for (int ks = 0; ks < 4; ++ks) { const int k0 = 128 * wave + 32 * ks + 8 * kq;
              const bf16x8 ah = *(const LAS bf16x8*)(lds + fr * ARS + k0 * 2), al = *(const LAS bf16x8*)(lds + 33024 + fr * ARS + k0 * 2);
#pragma unroll
              for (int nt = 0; nt < 2; ++nt) { const bf16x8 bh = *(const bf16x8*)(A.wrh + (size_t)(16 * nt + fr) * D + k0), bl = *(const bf16x8*)(A.wrl + (size_t)(16 * nt + fr) * D + k0);
                  acc[nt] = __builtin_amdgcn_mfma_f32_16x16x32_bf16(ah, bh, acc[nt], 0, 0, 0);
                  acc[nt] = __builtin_amdgcn_mfma_f32_16x16x32_bf16(al, bh, acc[nt], 0, 0, 0);
                  acc[nt] = __builtin_amdgcn_mfma_f32_16x16x32_bf16(ah, bl, acc[nt], 0, 0, 0); } }
#pragma unroll
          for (int nt = 0; nt < 2; ++nt)
#pragma unroll
              for (int r = 0; r < 4; ++r) part[(wave * 16 + 4 * kq + r) * 32 + 16 * nt + fr] = acc[nt][r]; }
        __syncthreads();
        { const int row = tid >> 5, e = tid & 31; float s = A.brt[e];
#pragma unroll
          for (int w = 0; w < 8; ++w) s += part[(w * 16 + row) * 32 + e];
          lg[row * 32 + e] = s; }
        __syncthreads();
        if (tid < 16) { const int row = grp * 16 + tid; float v[32];
#pragma unroll
            for (int e = 0; e < 32; ++e) v[e] = lg[tid * 32 + e];
            int be[4]; float bv[4];
#pragma unroll
            for (int k = 0; k < 4; ++k) { float best = -INFINITY; int bi = 0;
#pragma unroll
                for (int e = 0; e < 32; ++e) { const bool taken = (k > 0 && be[0] == e) || (k > 1 && be[1] == e) || (k > 2 && be[2] == e); if (!taken && v[e] > best) { best = v[e]; bi = e; } }
                be[k] = bi; bv[k] = best; }
            float ex[4], se = 0.f;
#pragma unroll
            for (int k = 0; k < 4; ++k) { ex[k] = __expf(bv[k] - bv[0]); se += ex[k]; }
            const float inv = 1.0f / se;
#pragma unroll
            for (int k = 0; k < 4; ++k) { if (A.dry) { if (ex[k] * inv < -1.0f) A.asg_g[row * 4 + k] = (float)be[k]; } else { const int pos = __hip_atomic_fetch_add(&cnt[be[k]], 1, __ATOMIC_RELAXED, __HIP_MEMORY_SCOPE_WORKGROUP); A.asg_e[row * 4 + k] = be[k]; A.asg_p[row * 4 + k] = pos; A.asg_g[row * 4 + k] = ex[k] * inv; } } }
        __syncthreads();
    }
    __syncthreads();
    if (tid < 32 && !A.dry) A.wgc[wg * 32 + tid] = cnt[tid];
}
__device__ __forceinline__ void moe_tables(ldsp lds, const int* wgc, int wg, int G, int g_wave) {
    const int tid = fresh_tid();
    LAS int* pst = (LAS int*)(lds + LM_PST); LAS int* myb = (LAS int*)(lds + LM_MYB); LAS int* ntl = (LAS int*)(lds + LM_NT); LAS unsigned short* te = (LAS unsigned short*)(lds + LM_TE);
    LAS int* tmp = (LAS int*)lds;
    { const int e = tid & 31, p = tid >> 5; int tot = 0, below = 0;
#pragma unroll 1
      for (int w = p; w < G; w += 16) { const int c = wgc[w * 32 + e]; tot += c; if (w < wg) below += c; }
      tmp[p * 32 + e] = tot; tmp[512 + p * 32 + e] = below; }
    __syncthreads();
    if (tid < 32) { int tot = 0, below = 0;
#pragma unroll
        for (int p = 0; p < 16; ++p) { tot += tmp[p * 32 + tid]; below += tmp[512 + p * 32 + tid]; }
        myb[tid] = below; tmp[1024 + tid] = (tot + 255) & ~255; }
    __syncthreads();
    if (tid == 0) { int acc = 0;
#pragma unroll 1
        for (int e = 0; e < 32; ++e) { pst[e] = acc; const int nt_e = tmp[1024 + e] >> 8;
#pragma unroll 1
            for (int i = 0; i < nt_e; ++i) te[(acc >> 8) + i] = (unsigned short)e; acc += tmp[1024 + e]; } pst[32] = acc; ntl[0] = acc >> 8; }
    __syncthreads();
}
__device__ __forceinline__ void gather_phase(ldsp lds, bool f8, const bf16* U2, bf16* XS, const int* asg_e, const int* asg_p, int* asg_s, int nrow, int wg, int G, int g_wave) {
    const int tid = fresh_tid(), lane = tid & 63; const int wave = __builtin_amdgcn_readfirstlane(tid >> 6);
    const LAS int* pst = (const LAS int*)(lds + LM_PST); const LAS int* myb = (const LAS int*)(lds + LM_MYB);
    const int ngrp = nrow / 16;
    for (int grp = wg; grp < ngrp; grp += G) {
#pragma unroll
        for (int rr = 0; rr < 2; ++rr) { const int row = grp * 16 + 2 * wave + rr;
            if (f8) { if (rr == 1) continue;
                const unsigned char* u8 = (const unsigned char*)U2; unsigned char* x8 = (unsigned char*)XS;
                const int r0 = grp * 16 + 2 * wave; int ee[8], pp[8];
#pragma unroll
                for (int q = 0; q < 8; ++q) { ee[q] = asg_e[r0 * 4 + q]; pp[q] = asg_p[r0 * 4 + q]; }
                const u32x4 va = *(const u32x4*)(u8 + (size_t)r0 * D + lane * 16), vb = *(const u32x4*)(u8 + (size_t)(r0 + 1) * D + lane * 16);
#pragma unroll
                for (int q = 0; q < 8; ++q) { const int slot = pst[ee[q]] + myb[ee[q]] + pp[q];
                    if (lane == 0) asg_s[r0 * 4 + q] = slot;
                    *(u32x4*)(x8 + (size_t)slot * D + lane * 16) = q < 4 ? va : vb; } }
            else {
            const u32x4 v0 = *(const u32x4*)(U2 + (size_t)row * D + lane * 8), v1 = *(const u32x4*)(U2 + (size_t)row * D + 512 + lane * 8);
#pragma unroll
            for (int k = 0; k < 4; ++k) { const int e = asg_e[row * 4 + k], slot = pst[e] + myb[e] + asg_p[row * 4 + k];
                if (lane == 0) asg_s[row * 4 + k] = slot;
                *(u32x4*)(XS + (size_t)slot * D + lane * 8) = v0; *(u32x4*)(XS + (size_t)slot * D + 512 + lane * 8) = v1; } } }
    }
}
struct CombArgs { const float* ln1g; const float* ln1b; const float* X1; const bf16* YS; const int* asg_s; const float* asg_g; const float* mods; const float* lng; const float* lnb; float* out_lat; float* out_ctx; bf16* Unext; unsigned char* U8next; const float* mods_next; bool check; };
__device__ __forceinline__ void combine_phase(const CombArgs& A, int nrow, int gw, int NGW, int lane) {
    for (int row0 = gw; row0 < nrow; row0 += 2 * NGW) {
        int rows[2] = {row0, row0 + NGW < nrow ? row0 + NGW : row0}; const bool two = row0 + NGW < nrow;
        f32x4 pv[2][4]; u32x2 yv[2][4][4]; float gt[2][4];
#pragma unroll
        for (int h = 0; h < 2; ++h) { const int row = rows[h]; int sl[4];
#pragma unroll
            for (int k = 0; k < 4; ++k) { sl[k] = A.asg_s[row * 4 + k]; gt[h][k] = A.asg_g[row * 4 + k]; }
#pragma unroll
            for (int j = 0; j < 4; ++j) { const int c = 4 * lane + 256 * j; pv[h][j] = *(const f32x4*)(A.X1 + (size_t)row * D + c);
#pragma unroll
                for (int k = 0; k < 4; ++k) yv[h][j][k] = *(const u32x2*)(A.YS + (size_t)sl[k] * D + c); } }
#pragma unroll
        for (int h = 0; h < 2; ++h) { if (h == 1 && !two) break;
            const int row = rows[h]; const bool lat = row < NLAT; const int bb = lat ? (row >> 13) : 8;
            const float* g2 = A.mods + (size_t)(bb * 6 + 5) * D; f32x4 v[4]; float s = 0.f;
            f32x4 x1v[4];
            { float s1 = 0.f;
#pragma unroll
              for (int j = 0; j < 4; ++j) { x1v[j] = pv[h][j]; s1 += (x1v[j][0] + x1v[j][1]) + (x1v[j][2] + x1v[j][3]); }
              const float mean1 = wave_sum(s1) * (1.0f / D); float q1 = 0.f;
#pragma unroll
              for (int j = 0; j < 4; ++j) { x1v[j] = x1v[j] - mean1; q1 += (x1v[j][0] * x1v[j][0] + x1v[j][1] * x1v[j][1]) + (x1v[j][2] * x1v[j][2] + x1v[j][3] * x1v[j][3]); }
              const float rstd1 = 1.0f / sqrtf(wave_sum(q1) * (1.0f / D) + LN_EPS);
#pragma unroll
              for (int j = 0; j < 4; ++j) { const int c = 4 * lane + 256 * j; x1v[j] = x1v[j] * rstd1 * *(const f32x4*)(A.ln1g + c) + *(const f32x4*)(A.ln1b + c); } }
#pragma unroll
            for (int j = 0; j < 4; ++j) { const int c = 4 * lane + 256 * j; f32x4 f = {0.f, 0.f, 0.f, 0.f};
#pragma unroll
                for (int k = 0; k < 4; ++k) { const u32x2 y = yv[h][j][k]; const float g = gt[h][k]; f[0] += g * bf2f(y.x & 0xffffu); f[1] += g * bf2f(y.x >> 16); f[2] += g * bf2f(y.y & 0xffffu); f[3] += g * bf2f(y.y >> 16); }
                v[j] = x1v[j] * DN_ALPHA + *(const f32x4*)(g2 + c) * f; s += (v[j][0] + v[j][1]) + (v[j][2] + v[j][3]); }
            const float mean = wave_sum(s) * (1.0f / D); float s2 = 0.f;
#pragma unroll
            for (int j = 0; j < 4; ++j) { v[j] = v[j] - mean; s2 += (v[j][0] * v[j][0] + v[j][1] * v[j][1]) + (v[j][2] * v[j][2] + v[j][3] * v[j][3]); }
            const float rstd = 1.0f / sqrtf(wave_sum(s2) * (1.0f / D) + LN_EPS);
            float* op = lat ? A.out_lat + (size_t)row * D : A.out_ctx + (size_t)(row - NLAT) * D;
            const float* sh = A.mods_next + (size_t)(bb * 6 + 0) * D; const float* sc = A.mods_next + (size_t)(bb * 6 + 1) * D;
#pragma unroll
            for (int j = 0; j < 4; ++j) { const int c = 4 * lane + 256 * j; const f32x4 x2 = v[j] * rstd * *(const f32x4*)(A.lng + c) + *(const f32x4*)(A.lnb + c);
                if (A.check) { const f32x4 old = __builtin_nontemporal_load((const f32x4*)(op + c)); const bool same = old[0] == x2[0] && old[1] == x2[1] && old[2] == x2[2] && old[3] == x2[3]; if (!same) *(f32x4*)(op + c) = (f32x4){__builtin_nanf(""), 0.f, 0.f, 0.f}; continue; }
                *(f32x4*)(op + c) = x2;
                if (A.Unext) { const f32x4 u = x2 * (*(const f32x4*)(sc + c) + 1.0f) + *(const f32x4*)(sh + c); u32x2 w; w.x = pk2(u[0], u[1]); w.y = pk2(u[2], u[3]); *(u32x2*)(A.Unext + (size_t)row * D + c) = w;
                    if (A.U8next) { unsigned w8 = 0u; w8 = __builtin_amdgcn_cvt_pk_fp8_f32(u[0], u[1], w8, false); w8 = __builtin_amdgcn_cvt_pk_fp8_f32(u[2], u[3], w8, true); *(unsigned*)(A.U8next + (size_t)row * D + c) = w8; } } }
        }
    }
}
}
constexpr int PH_PER_LAYER = 12, N_PHASES = 2 + DEPTH * PH_PER_LAYER;
static_assert(sizeof(KArgs) == 31 * 8 + 8 + 8 + 8, "no padding in the argument struct");
#ifndef PHMASK
#define PHMASK 0xffffffu
#endif
#ifndef SUBM
#define SUBM 7
#endif
#ifndef SUB3
#define SUB3 3
#endif
#ifndef REPCHECK
#define REPCHECK 0
#endif
#ifndef REPMASK
#define REPMASK 0
#endif
#ifndef REP2
#define REP2 0
#endif
#ifndef REP3
#define REP3 0
#endif
#define NREP(slot) ((((REPMASK) >> (slot)) & 1) ? 2 : 1)
#ifndef REPDUMMY
#define REPDUMMY 0
#endif
#ifndef REPBAR
#define REPBAR 0
#endif
__device__ __forceinline__ void rep_sync(int mode, const XcdBarrier& bar, bool multi) { if (mode == 1 && multi) xcd_barrier(bar); else if (mode == 2) { asm volatile("s_waitcnt vmcnt(0)" ::: "memory"); __syncthreads(); } else if (mode == 3) { asm volatile("s_waitcnt vmcnt(0)" ::: "memory"); } else if (mode == 4) { __builtin_amdgcn_s_barrier(); } }
#define FORREP(n) for (int rep = 0; rep < (n); ((rep + 1 < (n)) ? rep_sync(REPBAR, bar, hi - lo > 1) : (void)0), ++rep)
typedef const __attribute__((address_space(4))) KArgs CKArgs;
__device__ __forceinline__ CKArgs* fresh_args() { CKArgs* p = (CKArgs*)__builtin_amdgcn_kernarg_segment_ptr(); asm volatile("" : "+s"(p)); return p; }

__global__ void __launch_bounds__(NTHR, 2) mega(KArgs args) {
    extern __shared__ __attribute__((aligned(16))) unsigned char lds_raw[];
    const ldsp lds = (ldsp)lds_raw;
    const int G = gridDim.x, wg = blockIdx.x; const int g_wave = __builtin_amdgcn_readfirstlane((int)threadIdx.x >> 6);
#ifndef LDSZ_LO
#define LDSZ_LO 0
#endif
#ifndef LDSZ_HI
#define LDSZ_HI LDS_BYTES
#endif
    { const int tid0 = threadIdx.x; for (int u = tid0; u < (LDS_BYTES - RING_BYTES) / 4; u += NTHR) ((LAS unsigned*)(lds + RING_BYTES))[u] = 0u;
      if (LDSZ_LO < RING_BYTES) for (int u = tid0 + LDSZ_LO / 4; u < LDSZ_HI / 4; u += NTHR) ((LAS unsigned*)lds)[u] = 0u; }
    __syncthreads();
    const int lo = args.ph_lo, hi = args.ph_hi;
    XcdBarrier bar; bar.bar = (unsigned*)(args.ws + WS_CTL) + CW_BAR; bar.x = 0; bar.st = nullptr;
    if (hi - lo > 1) bar = xcd_barrier_post((unsigned*)(args.ws + WS_CTL) + CW_BAR, (volatile LAS unsigned*)(lds + LM_XB));
#define PHM(k) (((PHMASK) >> ((k) < 2 ? (k) : 2 + ((k) - 2) % PH_PER_LAYER)) & 1u)
#define IN(k) (PHM(k) && lo <= (k) && (k) < hi)
#ifndef BAR2
#define BAR2 0
#endif
#ifndef BARPRE
#define BARPRE 0
#endif
#ifndef BARPOST
#define BARPOST 0
#endif
#define SEAM(k) do { if (lo <= (k) && (k) + 1 < hi) { if (BARPRE) { asm volatile("s_waitcnt vmcnt(0)" ::: "memory"); __builtin_amdgcn_s_sleep(127); } xcd_barrier(bar); if (BAR2) xcd_barrier(bar); if (BARPOST) { __builtin_amdgcn_s_sleep(127); __syncthreads(); } } } while (0)
#ifndef ZPHASE
#define ZPHASE -1
#endif
#define ZERO_RING_AT(k) do { if ((k) == ZPHASE) { for (int u_ = (int)threadIdx.x; u_ < RING_BYTES / 4; u_ += NTHR) ((LAS unsigned*)lds)[u_] = 0u; __syncthreads(); } } while (0)
#define ENTER() CKArgs& P = *fresh_args(); unsigned char* const ws = P.ws; (void)ws

    ZERO_RING_AT(0);
    if (IN(0)) FORREP(NREP(0)) { ENTER(); phase_pre_a(P, lds, wg, G, g_wave); __syncthreads(); }
    SEAM(0);
    ZERO_RING_AT(1);
    if (IN(1)) FORREP(NREP(1)) { ENTER();
#pragma unroll
        for (int l = 0; l < DEPTH; ++l) { unsigned char* wl = ws + WS_WSM + l * WSM_LAYER;
            pg8::Gemm g{(const bf16*)(ws + WS_FC), (const bf16*)(wl + WSM_WXF), 256, 1024, 256}; pg8::FoldOrder S{G, wg}; FoldStore E{(bf16*)(wl + WSM_WIN)};
            pg8::gemm_phase<FoldStore, pg8::FoldOrder>(lds, g, S, E, g_wave); }
        const int tid = fresh_tid(); modulate_rows(P.in[0], P.in[2], (const float*)(ws + WS_MODS), (bf16*)(ws + WS_U), F8_MERGE ? (unsigned char*)(ws + WS_U8) : nullptr, NROW, wg * NWAVES + (tid >> 6), G * NWAVES, tid & 63);
    }
    SEAM(1);
#pragma unroll 1
    for (int l = 0; l < DEPTH; ++l) {
        const int pb = 2 + PH_PER_LAYER * l; const bool last = (l == DEPTH - 1);
        const int nrow = last ? NLAT : NROW;
#define WL(off) (ws + WS_WSM + (size_t)l * WSM_LAYER + (off))
#define MODS(ll) ((const float*)(ws + WS_MODS) + (size_t)(ll) * 9 * 6144)
        ZERO_RING_AT(pb + 0);
        if (IN(pb + 0)) FORREP(NREP(2)) { ENTER(); pg8::Gemm g{(const bf16*)(ws + WS_U), (const bf16*)WL(WSM_WIN), 1024, 1024, 1024}; pg8::StaticOrder S; S.init(NROW, ZC, G, wg); epi::In E{(bf16*)(ws + WS_Z), (const f32x2*)(ws + WS_ROPE)};
            pg8::gemm_phase<epi::In, pg8::StaticOrder>(lds, g, S, E, g_wave); }
        SEAM(pb + 0);
        ZERO_RING_AT(pb + 1);
        if (IN(pb + 1)) {
            if (SUBM & 1) FORREP((REP2 & 1) ? 2 : 1) { ENTER(); rg::Args RA{(bf16*)(ws + WS_Z), P.in[9] + l * 4096, P.in[10] + l * 1024, (const bf16*)WL(WSM_WG), P.in[12] + l * 2048, P.in[14] + l * 2048, (const float*)(ws + WS_SP) + l * 2048, (f32x2*)(ws + WS_SUM), nullptr, nullptr, 0};
                rg::phase<false>(lds, RA, true, wg, G, g_wave); __syncthreads(); }
            if (SUBM & 2) FORREP((REP2 & 2) ? 2 : 1) { ENTER(); att::attn_phase(lds, (bf16*)(ws + WS_Z), P.in[7] + l * 16, !last, wg, G, g_wave, rep ? (bf16*)(ws + WS_Y) : (bf16*)(ws + WS_Z) + ZQ, rep ? 1024 : ZC); __syncthreads(); }
            if (SUBM & 4) FORREP((REP2 & 4) ? 2 : 1) { ENTER(); fft::pass1_phase(lds, (bf16*)(ws + WS_Z), (bf16*)(ws + WS_T), ws, !last, wg, G, g_wave); } }
        SEAM(pb + 1);
        ZERO_RING_AT(pb + 2);
        if (IN(pb + 2)) FORREP(NREP(13)) { ENTER(); rg::carry_phase((const f32x2*)(ws + WS_SUM), (float*)(ws + WS_CARRY), wg, G, g_wave); }
        SEAM(pb + 2);
        ZERO_RING_AT(pb + 3);
        if (IN(pb + 3)) {
            if (SUB3 & 1) FORREP((REP3 & 1) ? 2 : 1) { ENTER(); rg::Args RA{(bf16*)(ws + WS_Z), P.in[9] + l * 4096, P.in[10] + l * 1024, (const bf16*)WL(WSM_WG), P.in[12] + l * 2048, P.in[14] + l * 2048, (const float*)(ws + WS_SP) + l * 2048, (f32x2*)(ws + WS_SUM), (const float*)(ws + WS_CARRY),
                  rep ? (bf16*)(ws + WS_Y) : (bf16*)(ws + WS_Z) + ZGR, rep ? 1024 : ZC};
              rg::phase<true>(lds, RA, !last, wg, G, g_wave); __syncthreads(); }
            if (SUB3 & 2) FORREP((REP3 & 2) ? 2 : 1) { ENTER(); fft::pass2_phase(lds, (bf16*)(ws + WS_Z), (const bf16*)(ws + WS_T), ws, wg, G, g_wave); } }
        SEAM(pb + 3);
        ZERO_RING_AT(pb + 4);
        if (IN(pb + 4)) FORREP(NREP(5)) {
            { ENTER(); pg8::Gemm g{(const bf16*)(ws + WS_Z) + ZQ, (const bf16*)WL(WSM_WOA), ZC, 1024, 1024}; pg8::StaticOrder S; S.init(nrow, 1024, G, wg); epi::Store E{(bf16*)(ws + WS_Y), 3072, nullptr, 0, 1024}; pg8::gemm_phase<epi::Store, pg8::StaticOrder>(lds, g, S, E, g_wave); }
            { ENTER(); pg8::Gemm g{(const bf16*)(ws + WS_Z) + ZGR, (const bf16*)WL(WSM_WOR), ZC, 1024, 1024}; pg8::StaticOrder S; S.init(nrow, 1024, G, (wg + 88) % G);     epi::Store E{(bf16*)(ws + WS_Y) + 1024, 3072, nullptr, 0, 1024}; pg8::gemm_phase<epi::Store, pg8::StaticOrder>(lds, g, S, E, g_wave); }
            { ENTER(); pg8::Gemm g{(const bf16*)(ws + WS_Z) + ZXC, (const bf16*)WL(WSM_WOF), ZC, 1024, 1024}; pg8::StaticOrder S; S.init(nrow, 1024, G, (wg + 176) % G); epi::Store E{(bf16*)(ws + WS_Y) + 2048, 3072, nullptr, 0, 1024}; pg8::gemm_phase<epi::Store, pg8::StaticOrder>(lds, g, S, E, g_wave); }
        }
        SEAM(pb + 4);
        ZERO_RING_AT(pb + 5);
        if (IN(pb + 5)) FORREP(NREP(6)) { ENTER(); pg8::MergeOrder S; S.init(nrow, G, wg);
            if (F8_MERGE) { pg8::Gemm g{(const bf16*)(ws + WS_U8), (const bf16*)WL(WSM_WM8), 512, 512, 512}; epi::Merge E{(bf16*)(ws + WS_M), (const bf16*)(ws + WS_Y), P.in[19] + l * 3072, 127 - F8_WM_SHIFT};
                pg8::gemm_phase<epi::Merge, pg8::MergeOrder, true>(lds, g, S, E, g_wave); }
            else { pg8::Gemm g{(const bf16*)(ws + WS_U), (const bf16*)WL(WSM_WM), 1024, 1024, 1024}; epi::Merge E{(bf16*)(ws + WS_M), (const bf16*)(ws + WS_Y), P.in[19] + l * 3072, 0};
                pg8::gemm_phase<epi::Merge, pg8::MergeOrder, false>(lds, g, S, E, g_wave); } }
        SEAM(pb + 5);
        ZERO_RING_AT(pb + 6);
        if (IN(pb + 6)) FORREP(NREP(7)) { ENTER(); pg8::Gemm g{(const bf16*)(ws + WS_M), (const bf16*)WL(WSM_WOUT), 1024, 1024, 1024}; pg8::StaticOrder S; S.init(nrow, 1024, G, wg);
            epi::Out E{(float*)(ws + WS_T), l == 0 ? P.in[0] : (const float*)P.out, l == 0 ? P.in[2] : (const float*)(ws + WS_X2C), MODS(l)};
            pg8::gemm_phase<epi::Out, pg8::StaticOrder>(lds, g, S, E, g_wave); }
        SEAM(pb + 6);
        ZERO_RING_AT(pb + 7);
        if (IN(pb + 7)) FORREP(NREP(8)) { ENTER(); rowp::LnArgs A{rep != 0, (bool)((F8_LAYERS >> l) & 1u), (float*)(ws + WS_T), (bf16*)(ws + WS_U), P.in[21] + l * 1024, P.in[22] + l * 1024, MODS(l), (const bf16*)WL(WSM_WRH), (const bf16*)WL(WSM_WRL), P.in[24] + l * 32,
                (int*)(ws + WS_ASGE), (int*)(ws + WS_ASGP), (float*)(ws + WS_ASGG), (int*)(ws + WS_WGC)};
            rowp::ln_router_phase(lds, A, nrow, wg, G, g_wave); }
        SEAM(pb + 7);
        ZERO_RING_AT(pb + 8);
        if (IN(pb + 8)) FORREP(NREP(9)) { ENTER(); rowp::moe_tables(lds, (const int*)(ws + WS_WGC), wg, G, g_wave);
            rowp::gather_phase(lds, (bool)((F8_LAYERS >> l) & 1u), (const bf16*)(ws + WS_U), (bf16*)(ws + WS_Z), (const int*)(ws + WS_ASGE), (const int*)(ws + WS_ASGP), (int*)(ws + WS_ASGS), nrow, wg, G, g_wave); }
        SEAM(pb + 8);
        ZERO_RING_AT(pb + 9);
        if (IN(pb + 9)) FORREP(NREP(10)) { ENTER(); if (!IN(pb + 8)) rowp::moe_tables(lds, (const int*)(ws + WS_WGC), wg, G, g_wave);
            pg8::MoeOrder<8> S{G, wg, __builtin_amdgcn_readfirstlane(*(const LAS int*)(lds + LM_NT)), (const LAS unsigned short*)(lds + LM_TE)};
            if ((F8_LAYERS >> l) & 1u) { pg8::Gemm g{(const bf16*)(ws + WS_Z), (const bf16*)(ws + WS_WGU), 512, 512, 512};
                epi::Swiglu<true> E{(bf16*)(ws + WS_Y), P.in[26] + (size_t)l * NEXP * 2048, 127 - F8_WGU_SHIFT}; pg8::gemm_phase<epi::Swiglu<true>, pg8::MoeOrder<8>, true>(lds, g, S, E, g_wave); }
            else { pg8::Gemm g{(const bf16*)(ws + WS_Z), (const bf16*)(ws + WS_WGU), 1024, 1024, 1024};
                epi::Swiglu<false> E{(bf16*)(ws + WS_Y), P.in[26] + (size_t)l * NEXP * 2048, 0}; pg8::gemm_phase<epi::Swiglu<false>, pg8::MoeOrder<8>, false>(lds, g, S, E, g_wave); } }
        SEAM(pb + 9);
        ZERO_RING_AT(pb + 10);
        if (IN(pb + 10)) FORREP(NREP(11)) { ENTER(); if (!IN(pb + 9)) rowp::moe_tables(lds, (const int*)(ws + WS_WGC), wg, G, g_wave);
            pg8::MoeOrder<4> S{G, wg, __builtin_amdgcn_readfirstlane(*(const LAS int*)(lds + LM_NT)), (const LAS unsigned short*)(lds + LM_TE)};
            if ((F8_LAYERS >> l) & 1u) { pg8::Gemm g{(const bf16*)(ws + WS_Y), (const bf16*)(ws + WS_WDN), 512, 512, 512};
                epi::Store E{(bf16*)(ws + WS_Z), 1024, P.in[28] + (size_t)l * NEXP * 1024, 127 - F8_WDN_SHIFT, 1024}; pg8::gemm_phase<epi::Store, pg8::MoeOrder<4>, true>(lds, g, S, E, g_wave); }
            else { pg8::Gemm g{(const bf16*)(ws + WS_Y), (const bf16*)(ws + WS_WDN), 1024, 1024, 1024};
                epi::Store E{(bf16*)(ws + WS_Z), 1024, P.in[28] + (size_t)l * NEXP * 1024, 0, 1024}; pg8::gemm_phase<epi::Store, pg8::MoeOrder<4>, false>(lds, g, S, E, g_wave); } }
        SEAM(pb + 10);
        ZERO_RING_AT(pb + 11);
        if (IN(pb + 11)) FORREP(NREP(12)) { ENTER(); const int tid = fresh_tid(); const int wave = __builtin_amdgcn_readfirstlane(tid >> 6);
            rowp::CombArgs A{P.in[21] + l * 1024, P.in[22] + l * 1024, (const float*)(ws + WS_T), (const bf16*)(ws + WS_Z), (const int*)(ws + WS_ASGS), (const float*)(ws + WS_ASGG), MODS(l), P.in[29] + l * 1024, P.in[30] + l * 1024, (rep && (REPDUMMY & 1)) ? (float*)(ws + WS_Y) : P.out, (rep && (REPDUMMY & 2)) ? (float*)(ws + WS_Y + 300 * MiB) : (float*)(ws + WS_X2C),
                last ? nullptr : ((rep && (REPDUMMY & 4)) ? (bf16*)(ws + WS_M) : (bf16*)(ws + WS_U)), (F8_MERGE && !last) ? (unsigned char*)(ws + WS_U8) : nullptr, MODS(last ? l : l + 1), (bool)(rep && REPCHECK)};
#ifndef REPSEL
#define REPSEL 3
#endif
#ifndef REPLAYER
#define REPLAYER 3
#endif
#ifndef REPCOPY
#define REPCOPY 0
#endif
            if (rep && REPCOPY) {
                const int gw_ = wg * NWAVES + wave, ln_ = tid & 63;
                for (int row = gw_; row < nrow; row += G * NWAVES) { float* op = row < NLAT ? P.out + (size_t)row * D : (float*)(ws + WS_X2C) + (size_t)(row - NLAT) * D;
                    for (int j = 0; j < 4; ++j) { const f32x4 v = __builtin_nontemporal_load((const f32x4*)(op + 4 * ln_ + 256 * j)); *(f32x4*)(op + 4 * ln_ + 256 * j) = v; }
                    if (!last) { bf16* up = (bf16*)(ws + WS_U) + (size_t)row * D; for (int j = 0; j < 4; ++j) { const u32x2 v = *(const u32x2*)(up + 4 * ln_ + 256 * j); *(u32x2*)(up + 4 * ln_ + 256 * j) = v; } } }
            } else
            if (rep == 0 || ((REPSEL & 1) && ((REPLAYER >> l) & 1))) rowp::combine_phase(A, nrow, wg * NWAVES + wave, G * NWAVES, tid & 63);
            if (!last && (rep == 0 || (REPSEL & 2))) convert_moe(P, l + 1, lds, wg * NWAVES + wave, G * NWAVES, wave, tid & 63); }
        if (!last) SEAM(pb + 11);
    }
#undef IN
#undef SEAM
}

extern "C" void kernel_launch(void* const* d_in, const int* in_sizes, int n_in, void* d_out, int out_size, void* d_ws, size_t ws_size, hipStream_t stream) {
    static int grid = 0;
    if (grid == 0) {
        if (n_in != 31 || in_sizes[0] != NLAT * D || out_size != NLAT * D || ws_size < WS_END) { fprintf(stderr, "kernel_launch: unexpected shapes / workspace (n_in %d, ws %zu < %zu)\n", n_in, ws_size, (size_t)WS_END); grid = -1; return; }
        int dev = 0, cus = 0, per_cu = 0;
        if (hipGetDevice(&dev) != hipSuccess || hipDeviceGetAttribute(&cus, hipDeviceAttributeMultiprocessorCount, dev) != hipSuccess) { grid = -1; return; }
        if (hipFuncSetAttribute((const void*)mega, hipFuncAttributeMaxDynamicSharedMemorySize, LDS_BYTES) != hipSuccess) { fprintf(stderr, "kernel_launch: hipFuncSetAttribute failed\n"); grid = -1; return; }
        if (hipOccupancyMaxActiveBlocksPerMultiprocessor(&per_cu, (const void*)mega, NTHR, LDS_BYTES) != hipSuccess || per_cu < 1) fprintf(stderr, "kernel_launch: occupancy query says %d\n", per_cu);
        (void)hipGetLastError();
        grid = cus;
    }
    if (grid < 0) return;
    if (hipMemsetAsync((char*)d_ws + WS_CTL, 0, CTL_ZERO_BYTES, stream) != hipSuccess) return;
#ifdef WSFILL
    (void)hipMemsetAsync((char*)d_ws + CTL_ZERO_BYTES, WSFILL, WS_END - CTL_ZERO_BYTES, stream); (void)hipMemsetAsync(d_out, WSFILL, (size_t)out_size * 4, stream);
#endif
    KArgs a{};
    for (int i = 0; i < 31; ++i) a.in[i] = (const float*)d_in[i];
    a.out = (float*)d_out; a.ws = (unsigned char*)d_ws;
#if MK_SINGLE
    a.ph_lo = 0; a.ph_hi = N_PHASES;
    hipLaunchKernelGGL(mega, dim3(grid), dim3(NTHR), LDS_BYTES, stream, a);
#else
    for (int p = 0; p < N_PHASES; ++p) { a.ph_lo = p; a.ph_hi = p + 1; hipLaunchKernelGGL(mega, dim3(grid), dim3(NTHR), LDS_BYTES, stream, a); }
#endif
}
```
